# Optimizing an MI355X kernel written in HIP

```python
import math
import jax
import jax.numpy as jnp
from jax import lax
import numpy as np

D_MODEL = 2048
BATCH = 4
SEQ = 8192
DEPTH = 1

N_META = 16
BLOCK = 128
PAD = BLOCK - N_META

ATT_HEADS = 8
ATT_HD = D_MODEL // (2 * ATT_HEADS)
ATT_VD = 2 * ATT_HD
ATT_QK = ATT_HEADS * 2 * ATT_HD
ATT_V = ATT_HEADS * ATT_VD

HG_HEADS = 16
HG_DK = D_MODEL // HG_HEADS
HG_DV = D_MODEL // HG_HEADS
HG_W = HG_HEADS * HG_DK
HG_WV = HG_HEADS * HG_DV
HG_CHUNK = 64
HG_SUB = 16

REL_BUCKETS = 32
REL_MAX_DIST = 128

N_EXPERTS = 32
TOP_K = 4
D_FF = D_MODEL
SWIGLU_LIMIT = 7.0
SWIGLU_ALPHA = 1.702
MOE_BLOCK = 128

IN_SPLITS = (ATT_QK, ATT_QK, ATT_V, HG_W, HG_W, HG_WV, HG_WV, D_MODEL, D_MODEL)
D_IN = 2 * ATT_QK + ATT_V + 2 * HG_W + 2 * HG_WV + 2 * D_MODEL

RMS_EPS = 1e-6
NEG_INF = -1e30

kernel_name = 'hybrid_diffattn_hgrn2_moe'


def rms_norm(x, gain):
    xf = x.astype(jnp.float32)
    y = xf * lax.rsqrt(jnp.mean(xf * xf, axis=-1, keepdims=True) + RMS_EPS)
    return (y * gain.astype(jnp.float32)).astype(x.dtype)


def pad_seq(t, axis):
    widths = [(0, 0)] * t.ndim
    widths[axis] = (PAD, 0)
    return jnp.pad(t, widths)


def t5_causal_bucket(rel):
    n = jnp.maximum(rel, 0)
    max_exact = REL_BUCKETS // 2
    nf = jnp.maximum(n, 1).astype(jnp.float32)
    large = max_exact + (jnp.log(nf / max_exact) / math.log(REL_MAX_DIST / max_exact)
                         * (REL_BUCKETS - max_exact)).astype(jnp.int32)
    large = jnp.minimum(large, REL_BUCKETS - 1)
    return jnp.where(n < max_exact, n, large)


def diff_attention(q, k, v, lam, rel_bias):
    B, H, _, Lp, d = q.shape
    nqb = Lp // BLOCK
    scale = d ** -0.5
    kpos = jnp.arange(Lp, dtype=jnp.int32)
    key_valid = kpos >= PAD
    q_blocks = jnp.moveaxis(q.reshape(B, H, 2, nqb, BLOCK, d), 3, 0)

    def one_block(args):
        q_blk, start = args
        qpos = start + jnp.arange(BLOCK, dtype=jnp.int32)
        rel = qpos[:, None] - kpos[None, :]
        bias = jnp.moveaxis(rel_bias[t5_causal_bucket(rel)], -1, 0).astype(jnp.float32)
        mask = (rel >= 0) & key_valid[None, :]
        s = jnp.einsum('bhmqd,bhmkd->bhmqk', q_blk, k).astype(jnp.float32) * scale + bias[None, :, None]
        s = jnp.where(mask, s, NEG_INF)
        p = jax.nn.softmax(s, axis=-1)
        a = p[:, :, 0] - lam * p[:, :, 1]
        return jnp.einsum('bhqk,bhkv->bhqv', a.astype(v.dtype), v)

    starts = jnp.arange(nqb, dtype=jnp.int32) * BLOCK
    o = lax.map(one_block, (q_blocks, starts))
    return jnp.moveaxis(o, 0, 2).reshape(B, H, Lp, v.shape[-1])


def hgrn2_chunk_scan(q, k, g, v):
    B, H, Lp, dk = q.shape
    dv = v.shape[-1]
    n_chunks = Lp // HG_CHUNK
    n_sub = HG_CHUNK // HG_SUB
    c = HG_SUB

    def to_chunks(t):
        return jnp.moveaxis(t.reshape(B, H, n_chunks, HG_CHUNK, t.shape[-1]), 2, 0)

    sub_lower = jnp.tril(jnp.ones((n_sub, n_sub), dtype=bool), -1)
    tok_lower = jnp.tril(jnp.ones((c, c), dtype=bool))

    def step(S, xs):
        qc, kc, gc, vc = xs
        b = jnp.cumsum(gc, axis=-2)
        b_end = b[..., -1, :]
        o_inter = jnp.einsum('bhtk,bhkv->bhtv', qc * jnp.exp(b), S)
        S_new = jnp.exp(b_end)[..., None] * S + jnp.einsum(
            'bhsk,bhsv->bhkv', kc * jnp.exp(b_end[..., None, :] - b), vc)
        qs = qc.reshape(B, H, n_sub, c, dk)
        ks = kc.reshape(B, H, n_sub, c, dk)
        bs = b.reshape(B, H, n_sub, c, dk)
        vs = vc.reshape(B, H, n_sub, c, dv)
        e = bs[..., -1, :]
        q_rel = qs[:, :, :, None] * jnp.exp(jnp.minimum(bs[:, :, :, None] - e[:, :, None, :, None, :], 0.0))
        k_rel = ks * jnp.exp(e[:, :, :, None, :] - bs)
        a_off = jnp.einsum('bhijtk,bhjsk->bhijts', q_rel, k_rel)
        a_off = jnp.where(sub_lower[:, :, None, None], a_off, 0.0)
        decay = jnp.exp(jnp.minimum(bs[..., :, None, :] - bs[..., None, :, :], 0.0))
        a_diag = jnp.sum(qs[..., :, None, :] * ks[..., None, :, :] * decay, axis=-1)
        a_diag = jnp.where(tok_lower, a_diag, 0.0)
        o_intra = (jnp.einsum('bhijts,bhjsv->bhitv', a_off, vs)
                   + jnp.einsum('bhits,bhisv->bhitv', a_diag, vs))
        return S_new, o_inter + o_intra.reshape(B, H, HG_CHUNK, dv)

    S0 = jnp.zeros((B, H, dk, dv), jnp.float32)
    _, o = lax.scan(step, S0, (to_chunks(q), to_chunks(k), to_chunks(g), to_chunks(v)))
    return jnp.moveaxis(o, 0, 2).reshape(B, H, Lp, dv)


def token_mixers(u, w_in, q_norm_g, k_norm_g, lam_vecs, lambda_init, subln_g, lb, hg_norm_g, w_out, rel_bias):
    B, L, _ = u.shape
    proj = jnp.einsum('bld,de->ble', u, w_in)
    q, k, v, hq, hf, hi, hog, ga, gh = jnp.split(proj, np.cumsum(IN_SPLITS)[:-1].tolist(), axis=-1)

    q = rms_norm(q.reshape(B, L, ATT_HEADS, 2, ATT_HD), q_norm_g).transpose(0, 2, 3, 1, 4)
    k = rms_norm(k.reshape(B, L, ATT_HEADS, 2, ATT_HD), k_norm_g).transpose(0, 2, 3, 1, 4)
    v = v.reshape(B, L, ATT_HEADS, ATT_VD).transpose(0, 2, 1, 3)
    lv = lam_vecs.astype(jnp.float32)
    lam = jnp.exp(jnp.sum(lv[0] * lv[1])) - jnp.exp(jnp.sum(lv[2] * lv[3])) + lambda_init
    o = diff_attention(pad_seq(q, 3), pad_seq(k, 3), pad_seq(v, 2), lam, rel_bias)[:, :, PAD:]
    o = rms_norm(o, subln_g) * (1.0 - lambda_init)
    o_att = o.transpose(0, 2, 1, 3).reshape(B, L, ATT_V).astype(u.dtype)

    def heads(t, d):
        return t.reshape(B, L, HG_HEADS, d).transpose(0, 2, 1, 3)
    hf32 = hf.astype(jnp.float32)
    lb32 = lb.astype(jnp.float32)
    forget = lb32 + (1.0 - lb32) * jax.nn.sigmoid(hf32)
    g = heads(jnp.log(forget), HG_DK)
    kk = heads((1.0 - lb32) * jax.nn.sigmoid(-hf32), HG_DK)
    qq = heads(jax.nn.silu(hq.astype(jnp.float32)), HG_DK)
    vv = heads(hi.astype(jnp.float32), HG_DV)
    oh = hgrn2_chunk_scan(pad_seq(qq, 2), pad_seq(kk, 2), pad_seq(g, 2), pad_seq(vv, 2))[:, :, PAD:]
    oh = rms_norm(oh, hg_norm_g).transpose(0, 2, 1, 3).reshape(B, L, HG_WV)
    o_hg = oh.astype(u.dtype) * jax.nn.silu(hog)

    y = jax.nn.sigmoid(ga) * o_att + jax.nn.sigmoid(gh) * o_hg
    return jnp.einsum('ble,ed->bld', y, w_out)


def moe(h, router_w, router_b, w_gu, b_gu, w_dn, b_dn):
    B, L, D = h.shape
    T = B * L
    ht = h.reshape(T, D)
    logits = (ht @ router_w + router_b).astype(jnp.float32)
    top_val, top_idx = lax.top_k(logits, TOP_K)
    gate = jax.nn.softmax(top_val, axis=-1)
    A = T * TOP_K
    exp_flat = top_idx.reshape(A)
    tok_flat = jnp.arange(A, dtype=jnp.int32) // TOP_K
    gate_flat = gate.reshape(A)
    order = jnp.argsort(exp_flat)
    exp_sorted = exp_flat[order]
    counts = jnp.bincount(exp_flat, length=N_EXPERTS)
    padded = (counts + MOE_BLOCK - 1) // MOE_BLOCK * MOE_BLOCK
    pend = jnp.cumsum(padded)
    pstart = pend - padded
    ustart = jnp.cumsum(counts) - counts
    dest = pstart[exp_sorted] + (jnp.arange(A, dtype=jnp.int32) - ustart[exp_sorted])
    n_blocks = -(-A // MOE_BLOCK) + N_EXPERTS
    R = n_blocks * MOE_BLOCK
    slot_tok = jnp.full((R,), T, jnp.int32).at[dest].set(tok_flat[order])
    slot_gate = jnp.zeros((R,), jnp.float32).at[dest].set(gate_flat[order])
    block_exp = jnp.minimum(jnp.searchsorted(pend, jnp.arange(n_blocks) * MOE_BLOCK, side='right'), N_EXPERTS - 1)
    h_ext = jnp.concatenate([ht, jnp.zeros((1, D), ht.dtype)], axis=0)

    def expert_block(args):
        toks, e = args
        xb = h_ext[toks]
        gu = xb @ w_gu[e] + b_gu[e]
        x_glu = jnp.minimum(gu[:, :D_FF], SWIGLU_LIMIT)
        x_lin = jnp.clip(gu[:, D_FF:], -SWIGLU_LIMIT, SWIGLU_LIMIT)
        act = x_glu * jax.nn.sigmoid(SWIGLU_ALPHA * x_glu) * (x_lin + 1.0)
        return act @ w_dn[e] + b_dn[e]

    y = lax.map(expert_block, (slot_tok.reshape(n_blocks, MOE_BLOCK), block_exp))
    y = y.reshape(R, D) * slot_gate[:, None].astype(y.dtype)
    out = jnp.zeros((T + 1, D), y.dtype).at[slot_tok].add(y)[:T]
    return out.reshape(B, L, D)


def setup_inputs(seed: int = 0) -> dict:
    key = jax.random.key(seed)
    ks = jax.random.split(key, 20)
    f32 = jnp.float32

    def nrm(k, shape, scale):
        return jax.random.normal(k, shape, f32) * scale

    return {
        'x': nrm(ks[0], (BATCH, SEQ, D_MODEL), 1.0),
        'meta_tokens': nrm(ks[1], (N_META, D_MODEL), 1.0),
        'rel_bias': nrm(ks[2], (REL_BUCKETS, ATT_HEADS), 0.5),
        'lb_logits': 1.0 + nrm(ks[3], (DEPTH + 1, HG_W), 0.1),
        'norm1': 1.0 + nrm(ks[4], (DEPTH, D_MODEL), 0.05),
        'w_in': nrm(ks[5], (DEPTH, D_MODEL, D_IN), D_MODEL ** -0.5),
        'q_norm': 1.0 + nrm(ks[6], (DEPTH, ATT_HD), 0.05),
        'k_norm': 1.0 + nrm(ks[7], (DEPTH, ATT_HD), 0.05),
        'diff_lambda': nrm(ks[8], (DEPTH, 4, ATT_HD), 0.1),
        'diff_subln': 1.0 + nrm(ks[9], (DEPTH, ATT_VD), 0.05),
        'hgrn_norm': 1.0 + nrm(ks[10], (DEPTH, HG_DV), 0.05),
        'w_out': nrm(ks[11], (DEPTH, D_MODEL, D_MODEL), D_MODEL ** -0.5),
        'norm2': 1.0 + nrm(ks[12], (DEPTH, D_MODEL), 0.05),
        'router_w': nrm(ks[13], (DEPTH, D_MODEL, N_EXPERTS), D_MODEL ** -0.5),
        'router_b': nrm(ks[14], (DEPTH, N_EXPERTS), 0.01),
        'w_gate_up': nrm(ks[15], (DEPTH, N_EXPERTS, D_MODEL, 2 * D_FF), D_MODEL ** -0.5),
        'b_gate_up': nrm(ks[16], (DEPTH, N_EXPERTS, 2 * D_FF), 0.01),
        'w_down': nrm(ks[17], (DEPTH, N_EXPERTS, D_FF, D_MODEL), D_FF ** -0.5),
        'b_down': nrm(ks[18], (DEPTH, N_EXPERTS, D_MODEL), 0.01),
    }


def reference(x, meta_tokens, rel_bias, lb_logits, norm1, w_in, q_norm, k_norm, diff_lambda, diff_subln,
              hgrn_norm, w_out, norm2, router_w, router_b, w_gate_up, b_gate_up, w_down, b_down):
    B = x.shape[0]
    meta = jnp.broadcast_to(meta_tokens[None].astype(x.dtype), (B, N_META, D_MODEL))
    h = jnp.concatenate([meta, x], axis=1)
    lower_bounds = jnp.cumsum(jax.nn.softmax(lb_logits.astype(jnp.float32), axis=0), axis=0)
    for l in range(DEPTH):
        lambda_init = 0.8 - 0.6 * math.exp(-0.3 * l)
        h = h + token_mixers(rms_norm(h, norm1[l]), w_in[l], q_norm[l], k_norm[l], diff_lambda[l],
                             lambda_init, diff_subln[l], lower_bounds[l], hgrn_norm[l], w_out[l], rel_bias)
        h = h + moe(rms_norm(h, norm2[l]), router_w[l], router_b[l], w_gate_up[l], b_gate_up[l],
                    w_down[l], b_down[l])
    return h[:, N_META:]
```

```cpp
#include <hip/hip_runtime.h>
#include <cstdio>
#include <cstdint>

namespace pg8 {
#define PG8_LAS __attribute__((address_space(3)))
typedef unsigned short bf16_t;
typedef short bf16x8 __attribute__((ext_vector_type(8)));
typedef float f32x4 __attribute__((ext_vector_type(4)));
typedef unsigned u32x4 __attribute__((ext_vector_type(4)));
constexpr int BM = 256, BK = 64, HALF = 128, HTB = HALF * BK * 2  , STAGE_BYTES = 8 * HTB;

__host__ __device__ __forceinline__ int lds_byte(int r, int c) { const int st = (r >> 4) * 2 + (c >> 5), rr = r & 15, cc = c & 31, ob = rr * 64 + cc * 2; return st * 1024 + (ob ^ (((ob >> 9) & 1) << 5)); }
__host__ __device__ __forceinline__ void stage_rc(int b, int& R, int& C) { const int st = b / 1024, sb = b % 1024, swz = sb ^ (((sb >> 9) & 1) << 5); R = (st >> 1) * 16 + swz / 64; C = (st & 1) * 32 + (swz % 64) / 2; }
__host__ __device__ __forceinline__ int perm32(int rho) { const int n = rho >> 4, i = rho & 15; return 8 * (i >> 2) + 4 * n + (i & 3); }

struct Unit { int pm, pn, e, aux; };

__device__ __forceinline__ unsigned cvt_pk_bf16(float lo, float hi) { unsigned r; asm volatile("v_cvt_pk_bf16_f32 %0, %1, %2" : "=v"(r) : "v"(lo), "v"(hi)); return r; }

template <class Epi, class Sched, bool GATHER>
__device__ __forceinline__ void gemm_phase(PG8_LAS unsigned char* lds, const bf16_t* Abase, const int K, const Sched& S, const Epi& E) {
    const int tid = threadIdx.x, wid = __builtin_amdgcn_readfirstlane(tid >> 6), lane = tid & 63, wr = wid >> 2, wc = wid & 3, fr = lane & 15, fq = lane >> 4;
    const int nt = K / BK;
    int Rr[2]; unsigned cb[2], voffB[2], voffA[2];
#pragma unroll
    for (int i = 0; i < 2; ++i) { int R, C; stage_rc(tid * 16 + i * 8192, R, C); const int Rb = Epi::PERM ? ((R & ~31) + perm32(R & 31)) : R;
        Rr[i] = R; cb[i] = (unsigned)C * 2u; voffB[i] = (unsigned)(Rb * K + C) * 2u; voffA[i] = (unsigned)(R * K + C) * 2u; }
    const unsigned rowB = (unsigned)K * 2u;
    const size_t kstep = (size_t)(BK * 2);
    const size_t hstep = (size_t)HALF * K * 2;
    const unsigned ldsw = (unsigned)wid * 1024u;
    const int aoff = lds_byte(wr * 64 + fr, fq * 8), boff = lds_byte(wc * 32 + fr, fq * 8);
#define PG8_SA(b, h) (((b) * 2 + (h)) * HTB)
#define PG8_SB(b, h) ((4 + (b) * 2 + (h)) * HTB)
#define PG8_STAGE(bufoff, gbase, voff) do { _Pragma("unroll") for (int _i = 0; _i < 2; ++_i) \
        __builtin_amdgcn_global_load_lds((const unsigned*)((const char*)(gbase) + (voff)[_i]), (PG8_LAS unsigned*)(lds + (bufoff) + ldsw + _i * 8192), 16, 0, 0); } while (0)
#define PG8_LDA(dst, b, h) do { _Pragma("unroll") for (int m = 0; m < 4; ++m) _Pragma("unroll") for (int k = 0; k < 2; ++k) dst[m][k] = *(const PG8_LAS bf16x8*)(lds + PG8_SA(b, h) + aoff + m * 2048 + k * 1024); } while (0)
#define PG8_LDB(dst, b, h) do { _Pragma("unroll") for (int n = 0; n < 2; ++n) _Pragma("unroll") for (int k = 0; k < 2; ++k) dst[n][k] = *(const PG8_LAS bf16x8*)(lds + PG8_SB(b, h) + boff + n * 2048 + k * 1024); } while (0)
#define PG8_MMA(ai, bj, At, Bt) do { __builtin_amdgcn_s_setprio(1); _Pragma("unroll") for (int m = 0; m < 4; ++m) _Pragma("unroll") for (int n = 0; n < 2; ++n) _Pragma("unroll") for (int k = 0; k < 2; ++k) \
        acc[ai][bj][m][n] = __builtin_amdgcn_mfma_f32_16x16x32_bf16(Bt[n][k], At[m][k], acc[ai][bj][m][n], 0, 0, 0); __builtin_amdgcn_s_setprio(0); } while (0)
#define PG8_WAIT_V(n) asm volatile("s_waitcnt vmcnt(" #n ")" ::: "memory")
#define PG8_WAIT_L(n) asm volatile("s_waitcnt lgkmcnt(" #n ")" ::: "memory")
#define PG8_BAR __builtin_amdgcn_s_barrier()
#define PG8_SCHED __builtin_amdgcn_sched_barrier(0)
#define PG8_VA(dst, u) do { if constexpr (GATHER) { _Pragma("unroll") for (int _h = 0; _h < 2; ++_h) _Pragma("unroll") for (int _i = 0; _i < 2; ++_i) dst[_h][_i] = S.arow(u, _h * HALF + Rr[_i]) * rowB + cb[_i]; } } while (0)
#define PG8_STAGE_A(bufoff, h, base, vsel) do { if constexpr (GATHER) PG8_STAGE(bufoff, base, vsel[h]); else PG8_STAGE(bufoff, (base) + (h) * hstep, voffA); } while (0)
    Unit cur, nxt; int ui = 0;
    if (!S.next(0, cur)) return;
    f32x4 acc[2][2][4][2];
#pragma unroll
    for (int a = 0; a < 2; ++a)
#pragma unroll
        for (int b = 0; b < 2; ++b)
#pragma unroll
            for (int m = 0; m < 4; ++m)
#pragma unroll
                for (int n = 0; n < 2; ++n) acc[a][b][m][n] = (f32x4){0.f, 0.f, 0.f, 0.f};
    bf16x8 At[4][2], B0[2][2], B1[2][2];
    unsigned vAc[2][2], vAn[2][2];
    PG8_VA(vAc, cur);
    const char* cA = GATHER ? (const char*)Abase : (const char*)Abase + (size_t)S.arow(cur, 0) * rowB; const char* cB = S.bptr(cur);
    PG8_STAGE(PG8_SB(0, 0), cB, voffB); PG8_STAGE(PG8_SB(0, 1), cB + hstep, voffB); PG8_STAGE_A(PG8_SA(0, 0), 0, cA, vAc); PG8_STAGE_A(PG8_SA(0, 1), 1, cA, vAc);
    if (wr == 1) PG8_BAR;
    PG8_WAIT_V(2); PG8_BAR;
    PG8_STAGE(PG8_SB(1, 0), cB + kstep, voffB); PG8_STAGE_A(PG8_SA(1, 0), 0, cA + kstep, vAc); PG8_STAGE(PG8_SB(1, 1), cB + hstep + kstep, voffB);
    PG8_WAIT_V(6); PG8_BAR;
    for (;;) {
        const bool has_next = S.next(ui + 1, nxt);
        const char* nB = cB; const char* nA = cA;
        if (has_next) { nB = S.bptr(nxt); PG8_VA(vAn, nxt); if constexpr (!GATHER) nA = (const char*)Abase + (size_t)S.arow(nxt, 0) * rowB; }
        else if constexpr (GATHER) {
#pragma unroll
            for (int h = 0; h < 2; ++h)
#pragma unroll
                for (int i = 0; i < 2; ++i) vAn[h][i] = vAc[h][i];
        }
        for (int t = 0; t < nt; t += 2) {
            const bool last = (t == nt - 2);
            const char* a1 = cA + (size_t)(t + 1) * kstep;
            const char* a2 = last ? nA : cA + (size_t)(t + 2) * kstep; const char* b2 = last ? nB : cB + (size_t)(t + 2) * kstep;
            const char* a3 = a2 + kstep; const char* b3 = b2 + kstep;
            unsigned v2[2][2];
            if constexpr (GATHER) {
#pragma unroll
            for (int h = 0; h < 2; ++h)
#pragma unroll
                for (int i = 0; i < 2; ++i) v2[h][i] = last ? vAn[h][i] : vAc[h][i]; }
            PG8_LDB(B0, 0, 0); PG8_LDB(B1, 0, 1); PG8_SCHED; PG8_LDA(At, 0, 0); PG8_STAGE_A(PG8_SA(1, 1), 1, a1, vAc);
            PG8_WAIT_V(8); PG8_WAIT_L(0); PG8_BAR; PG8_MMA(0, 0, At, B0); PG8_MMA(0, 1, At, B1); PG8_BAR; PG8_SCHED;
            PG8_LDA(At, 0, 1); PG8_STAGE(PG8_SB(0, 0), b2, voffB); PG8_STAGE(PG8_SB(0, 1), b2 + hstep, voffB); PG8_STAGE_A(PG8_SA(0, 0), 0, a2, v2);
            PG8_WAIT_V(8); PG8_WAIT_L(0); PG8_BAR; PG8_MMA(1, 0, At, B0); PG8_MMA(1, 1, At, B1); PG8_BAR; PG8_SCHED;
            PG8_LDB(B0, 1, 0); PG8_LDB(B1, 1, 1); PG8_SCHED; PG8_LDA(At, 1, 0); PG8_STAGE_A(PG8_SA(0, 1), 1, a2, v2);
            PG8_WAIT_V(8); PG8_WAIT_L(0); PG8_BAR; PG8_MMA(0, 0, At, B0); PG8_MMA(0, 1, At, B1); PG8_BAR; PG8_SCHED;
            PG8_LDA(At, 1, 1); PG8_STAGE(PG8_SB(1, 0), b3, voffB); PG8_STAGE(PG8_SB(1, 1), b3 + hstep, voffB); PG8_STAGE_A(PG8_SA(1, 0), 0, a3, v2);
            PG8_WAIT_V(8); PG8_WAIT_L(0); PG8_BAR; PG8_MMA(1, 0, At, B0); PG8_MMA(1, 1, At, B1); PG8_BAR; PG8_SCHED;
        }
        if (wr == 0) PG8_BAR;
        E(acc, cur, wr, wc, fr, fq, wid, lane);
        if (!has_next) break;
#pragma unroll
        for (int a = 0; a < 2; ++a)
#pragma unroll
            for (int b = 0; b < 2; ++b)
#pragma unroll
                for (int m = 0; m < 4; ++m)
#pragma unroll
                    for (int n = 0; n < 2; ++n) acc[a][b][m][n] = (f32x4){0.f, 0.f, 0.f, 0.f};
        cur = nxt; cB = nB; cA = nA; ++ui;
        if constexpr (GATHER) {
#pragma unroll
        for (int h = 0; h < 2; ++h)
#pragma unroll
            for (int i = 0; i < 2; ++i) vAc[h][i] = vAn[h][i]; }
        if (wr == 1) PG8_BAR;
    }
    PG8_WAIT_V(0);
    PG8_BAR;
#undef PG8_SA
#undef PG8_SB
#undef PG8_STAGE
#undef PG8_LDA
#undef PG8_LDB
#undef PG8_MMA
#undef PG8_WAIT_V
#undef PG8_WAIT_L
#undef PG8_BAR
#undef PG8_SCHED
#undef PG8_VA
#undef PG8_STAGE_A
}
}

namespace att {
constexpr int D = 128, SEQ_ = 8192, PKV_ = 8256;
constexpr float THR = 8.f;
constexpr bool WSKIP = false;
constexpr float SCALE = 0.08838834764831845f;
constexpr int NW = 8, QBLK = 32, KVBLK = 64, QB = NW * QBLK;
constexpr int SHM_V = KVBLK * D * 2, SHM_K = KVBLK * D * 2;
constexpr int LDS_BYTES = 2 * SHM_V + 2 * SHM_K + NW * 64 * 4;
constexpr int BT_LEN = 352, BT_OFF = 96;
typedef unsigned short bf16;
typedef short bf16x8 __attribute__((ext_vector_type(8)));
typedef short s16x4 __attribute__((ext_vector_type(4)));
typedef float f32x16 __attribute__((ext_vector_type(16)));
typedef float f32x4 __attribute__((ext_vector_type(4)));
typedef unsigned u32x4 __attribute__((ext_vector_type(4)));
template <class A, class Bt> struct same_t { static constexpr bool v = false; };
template <class A> struct same_t<A, A> { static constexpr bool v = true; };

#define KSWZ(row, colB) ((row) * 256 + ((colB) ^ (((row) & 7) << 4)))
#define SBAR() __builtin_amdgcn_sched_barrier(0)
__device__ __forceinline__ int v_st(int k, int c) { const int kk = (k & ~0xC) | ((k & 4) << 1) | ((k & 8) >> 1); return ((kk >> 3) * 4 + (c >> 5)) * 512 + ((kk & 7) * 32 + (c & 31)) * 2; }
__device__ __forceinline__ int v_rd_base(int lane) { return ((lane & 3) << 3) | (((lane >> 2) & 3) << 6) | (((lane >> 4) & 1) << 5) | (((lane >> 5) & 1) << 8); }
constexpr int v_rd_off(int d0, int ks, int half) { return d0 * 512 + ks * 4096 + half * 2048; }
__device__ __forceinline__ int crow(int r, int hi) { return (r & 3) + 8 * (r >> 2) + 4 * hi; }
__device__ __forceinline__ unsigned cvtpk(float lo, float hi) {
    unsigned r; asm volatile("v_cvt_pk_bf16_f32 %0, %1, %2" : "=v"(r) : "v"(lo), "v"(hi)); return r;
}
__device__ __forceinline__ bf16x8 pack8(f32x4 a, f32x4 b) {
    u32x4 w = {cvtpk(a[0], a[1]), cvtpk(a[2], a[3]), cvtpk(b[0], b[1]), cvtpk(b[2], b[3])};
    return *reinterpret_cast<bf16x8*>(&w);
}
template <class T> __device__ __forceinline__ bf16x8 load8(const T* p) {
    if constexpr (same_t<T, float>::v) { return pack8(*(const f32x4*)p, *(const f32x4*)(p + 4)); }
    else { return *reinterpret_cast<const bf16x8*>(p); }
}
__device__ __forceinline__ void mask_tile(f32x16& p0, f32x16& p1, int dq, unsigned W) {
    const float NEG = -__builtin_inff();
#pragma unroll
    for (int r = 0; r < 16; ++r) {
        const int c = (r & 3) + 8 * (r >> 2);
        if ((unsigned)(dq - c) >= W) p0[r] = NEG;
        if ((unsigned)(dq - c - 32) >= W) p1[r] = NEG;
    }
}
__device__ __forceinline__ void bias_tile(f32x16& p0, f32x16& p1, int dq, const float* __restrict__ tab) {
    const float* tb = tab + (dq + 96);
#pragma unroll
    for (int r = 0; r < 16; ++r) {
        const int c = (r & 3) + 8 * (r >> 2);
        p0[r] += tb[-c];
        p1[r] += tb[-c - 32];
    }
}
__device__ __forceinline__ void padmask_tile(f32x16& p0, f32x16& p1) {
    const float NEG = -__builtin_inff();
#pragma unroll
    for (int r = 0; r < 16; ++r) p0[r] = NEG;
#pragma unroll
    for (int r = 0; r < 8; ++r) p1[r] = NEG;
}
__device__ __forceinline__ void partialSM(f32x16& p0, f32x16& p1, float& m_reg, float& mn, float& alpha) {
    float pmax = p0[0]; for (int r = 1; r < 16; ++r) pmax = fmaxf(pmax, p0[r]); for (int r = 0; r < 16; ++r) pmax = fmaxf(pmax, p1[r]);
    { auto rr = __builtin_amdgcn_permlane32_swap(__float_as_uint(pmax), __float_as_uint(pmax), false, false);
      pmax = fmaxf(__uint_as_float(rr[0]), __uint_as_float(rr[1])); }
    constexpr float C2 = 1.4426950408889634f * SCALE;
    if (__builtin_expect(__all((pmax - m_reg) * SCALE <= THR), 1)) { mn = m_reg; alpha = 1.f; }
    else { mn = fmaxf(m_reg, pmax); alpha = __builtin_amdgcn_exp2f((m_reg - mn) * C2); m_reg = mn; }
    const float mnL = -mn * C2;
    for (int r = 0; r < 16; ++r) p0[r] = fmaf(p0[r], C2, mnL); for (int r = 0; r < 16; ++r) p1[r] = fmaf(p1[r], C2, mnL);
    for (int r = 0; r < 16; ++r) p0[r] = __builtin_amdgcn_exp2f(p0[r]);
}
__device__ __forceinline__ void finishSM(f32x16& p0, f32x16& p1, float alpha, float& l_reg, bf16x8& pa0, bf16x8& pa1, bf16x8& pa2, bf16x8& pa3) {
    for (int r = 0; r < 16; ++r) p1[r] = __builtin_amdgcn_exp2f(p1[r]);
    float ps = 0; for (int r = 0; r < 16; ++r) ps += p0[r]; for (int r = 0; r < 16; ++r) ps += p1[r];
    { auto rr = __builtin_amdgcn_permlane32_swap(__float_as_uint(ps), __float_as_uint(ps), false, false);
      ps = __uint_as_float(rr[0]) + __uint_as_float(rr[1]); }
    l_reg = l_reg * alpha + ps;
#define PK4(P, B_, OUT) do { unsigned a0 = cvtpk(P[B_+0], P[B_+1]), a1 = cvtpk(P[B_+2], P[B_+3]);                          \
        unsigned b0 = cvtpk(P[B_+4], P[B_+5]), b1 = cvtpk(P[B_+6], P[B_+7]);                                             \
        auto r0 = __builtin_amdgcn_permlane32_swap(a0, b0, false, false); auto r1 = __builtin_amdgcn_permlane32_swap(a1, b1, false, false); \
        u32x4 w = {r0[0], r1[0], r0[1], r1[1]}; OUT = *reinterpret_cast<bf16x8*>(&w); } while (0)
    PK4(p0, 0, pa0); PK4(p0, 8, pa1); PK4(p1, 0, pa2); PK4(p1, 8, pa3);
#undef PK4
}
template <int KB, bool SK>
__device__ __forceinline__ void qkt(f32x16& p0, f32x16& p1, const char* K_lds, int r32, int hi, const bf16x8* qr, bool act) {
    if (SK && !act) { const float NEG = -__builtin_inff();
#pragma unroll
        for (int r = 0; r < 16; ++r) { p0[r] = NEG; p1[r] = NEG; } return; }
    p0 = f32x16{}; p1 = f32x16{};
    const char* kb[4];
#pragma unroll
    for (int dd = 0; dd < 4; ++dd) kb[dd] = K_lds + KB * SHM_K + KSWZ(r32, (dd * 16 + hi * 8) * 2);
#pragma unroll
    for (int d0 = 0; d0 < 8; ++d0) { const char* a = kb[d0 & 3] + (d0 >> 2) * 128;
        bf16x8 b0 = *reinterpret_cast<const bf16x8*>(a);
        bf16x8 b1 = *reinterpret_cast<const bf16x8*>(a + 32 * 256);
        p0 = __builtin_amdgcn_mfma_f32_32x32x16_bf16(b0, qr[d0], p0, 0, 0, 0);
        p1 = __builtin_amdgcn_mfma_f32_32x32x16_bf16(b1, qr[d0], p1, 0, 0, 0); }
}
template <int VB, bool SK>
__device__ __forceinline__ void pv_tile(f32x16* o, int vb0, bf16x8 pa0, bf16x8 pa1, bf16x8 pa2, bf16x8 pa3, bool act) {
    if (SK && !act) return;
#define TRRD(dst, off) asm volatile("ds_read_b64_tr_b16 %0, %1 offset:%2" : "=&v"(dst) : "v"(vb0), "i"(off) : "memory")
#define PV_D0(d0) do { s16x4 l0, l1, l2, l3, h0, h1, h2, h3; constexpr int b_ = VB * SHM_V + v_rd_off(d0, 0, 0);     \
        TRRD(l0, b_); TRRD(h0, b_ + 2048); TRRD(l1, b_ + 4096); TRRD(h1, b_ + 6144); TRRD(l2, b_ + 8192); TRRD(h2, b_ + 10240); TRRD(l3, b_ + 12288); TRRD(h3, b_ + 14336); \
        asm volatile("s_waitcnt lgkmcnt(0)" ::: "memory"); SBAR();                 \
        o[d0] = __builtin_amdgcn_mfma_f32_32x32x16_bf16(pa0, (bf16x8){l0[0], l0[1], l0[2], l0[3], h0[0], h0[1], h0[2], h0[3]}, o[d0], 0, 0, 0);   \
        o[d0] = __builtin_amdgcn_mfma_f32_32x32x16_bf16(pa1, (bf16x8){l1[0], l1[1], l1[2], l1[3], h1[0], h1[1], h1[2], h1[3]}, o[d0], 0, 0, 0);   \
        o[d0] = __builtin_amdgcn_mfma_f32_32x32x16_bf16(pa2, (bf16x8){l2[0], l2[1], l2[2], l2[3], h2[0], h2[1], h2[2], h2[3]}, o[d0], 0, 0, 0);   \
        o[d0] = __builtin_amdgcn_mfma_f32_32x32x16_bf16(pa3, (bf16x8){l3[0], l3[1], l3[2], l3[3], h3[0], h3[1], h3[2], h3[3]}, o[d0], 0, 0, 0); } while (0)
    PV_D0(0); PV_D0(1); PV_D0(2); PV_D0(3);
#undef PV_D0
#undef TRRD
}

template <class TIn, class TOut> struct BlockRef { const TIn* Q; const TIn* K; const TIn* V; TOut* O; int P0; const float* bt; };
template <class TIn> struct Seam {
    bf16x8 qr[8];
    bf16x8 st_v0, st_v1, st_k0, st_k1; f32x4 sf0, sf1, sf2, sf3;
    f32x4 tq[16];
};
__device__ __forceinline__ int swa_jlo(int P0, int W) { const int lowk = P0 - W + 1; return lowk > 0 ? lowk / KVBLK : 0; }
#define ROW(p, k0, rr) ((p) + (size_t)((k0) + (rr)) * D + sc)
#define VMW() asm volatile("s_waitcnt vmcnt(0)" ::: "memory")
#define VMWN(n) asm volatile("s_waitcnt vmcnt(%0)" :: "i"(n) : "memory")
#define SLOAD_H(Kp, Vp, k0) do { S.st_v0 = load8<TIn>(ROW(Vp, k0, sr)); S.st_v1 = load8<TIn>(ROW(Vp, k0, 32 + sr));              \
                         S.st_k0 = load8<TIn>(ROW(Kp, k0, sr)); S.st_k1 = load8<TIn>(ROW(Kp, k0, 32 + sr)); } while (0)
#define SWRITE_HK(bf) do { *(bf16x8*)(K_lds + (bf) * SHM_K + kws) = S.st_k0; *(bf16x8*)(K_lds + (bf) * SHM_K + kws + 32 * 256) = S.st_k1; } while (0)
#define SWRITE_HV(bf) do { *(bf16x8*)(V_lds + (bf) * SHM_V + vst0) = S.st_v0; *(bf16x8*)(V_lds + (bf) * SHM_V + vst1) = S.st_v1; } while (0)
#define SWRITE_H(bf) do { SWRITE_HV(bf); SWRITE_HK(bf); } while (0)
#define SLOAD_F(p, k0) do { S.sf0 = *(const f32x4*)ROW(p, k0, sr); S.sf1 = *(const f32x4*)(ROW(p, k0, sr) + 4);                \
                            S.sf2 = *(const f32x4*)ROW(p, k0, 32 + sr); S.sf3 = *(const f32x4*)(ROW(p, k0, 32 + sr) + 4); } while (0)
#define SWRITE_KF(bf) do { *(bf16x8*)(K_lds + (bf) * SHM_K + kws) = pack8(S.sf0, S.sf1); *(bf16x8*)(K_lds + (bf) * SHM_K + kws + 32 * 256) = pack8(S.sf2, S.sf3); } while (0)
#define SWRITE_VF(bf) do { *(bf16x8*)(V_lds + (bf) * SHM_V + vst0) = pack8(S.sf0, S.sf1); *(bf16x8*)(V_lds + (bf) * SHM_V + vst1) = pack8(S.sf2, S.sf3); } while (0)
template <class TIn, class TOut>
__device__ __forceinline__ void causal_swa_prime(const BlockRef<TIn, TOut>& cur, int W, char* lds, Seam<TIn>& S) {
    constexpr bool F32 = same_t<TIn, float>::v;
    const int tid = threadIdx.x, wid = __builtin_amdgcn_readfirstlane(tid >> 6), lane = tid & 63, r32 = lane & 31, hi = lane >> 5;
    const int sr = tid >> 4, sc = (tid & 15) * 8, kws = KSWZ(sr, sc * 2); char* K_lds = lds + 2 * SHM_V;
    const int kb0 = swa_jlo(cur.P0, W) * KVBLK;
    for (int d0 = 0; d0 < 8; ++d0) S.qr[d0] = load8<TIn>(cur.Q + (size_t)(wid * QBLK + r32) * D + d0 * 16 + hi * 8);
    if constexpr (F32) { SLOAD_F((const float*)cur.K, kb0); VMW(); SWRITE_KF(0); SBAR(); SLOAD_F((const float*)cur.V, kb0); }
    else { SLOAD_H(cur.K, cur.V, kb0); VMW(); SWRITE_HK(0); }
    __syncthreads();
}
template <class TIn, class TOut>
__device__ __forceinline__ void causal_swa_block(const BlockRef<TIn, TOut>& cur, const BlockRef<TIn, TOut>& nxt, int skv, int W, char* lds, Seam<TIn>& S) {
    constexpr bool F32 = same_t<TIn, float>::v;
    const int tid = threadIdx.x, wid = __builtin_amdgcn_readfirstlane(tid >> 6), lane = tid & 63, r32 = lane & 31, hi = lane >> 5;
    const int j_lo = swa_jlo(cur.P0, W);
    int j_hi = (cur.P0 + QB - 1) / KVBLK + 1; if (j_hi > skv / KVBLK) j_hi = skv / KVBLK;
    const int NT = j_hi - j_lo;
    const int kbn = swa_jlo(nxt.P0, W) * KVBLK;
    const int qlo = cur.P0 + wid * QBLK, qm = qlo + r32 - 4 * hi;
    char* V_lds = lds; char* K_lds = lds + 2 * SHM_V;
    float* ws = (float*)(lds + 2 * SHM_V + 2 * SHM_K) + wid * 64; float* li_l = ws, * al_l = ws + 32;
    float m_reg = -1e30f, l_reg = 0; f32x16 o[4] = {};
    const int sr = tid >> 4, sc = (tid & 15) * 8, vst0 = v_st(sr, sc), vst1 = v_st(32 + sr, sc), kws = KSWZ(sr, sc * 2);
    const int vb0 = (int)(uintptr_t)V_lds + v_rd_base(lane);
    const TIn* Kh = cur.K; const TIn* Vh = cur.V;
#define RESC(a) do { if (__any((a) < 1.f)) { if (hi == 0) al_l[r32] = (a); asm volatile("s_waitcnt lgkmcnt(0)" ::: "memory");              \
                     for (int d_ = 0; d_ < 4; ++d_) for (int r = 0; r < 16; ++r) o[d_][r] *= al_l[crow(r, hi)]; } } while (0)
#define KBASE(t) ((j_lo + (t)) * KVBLK)
#define ACT(t) (KBASE(t) <= qlo + QBLK - 1 && KBASE(t) + KVBLK - 1 >= qlo - W + 1)
#define MASKT(P0_, P1_, t) do { const int kb_ = KBASE(t); \
        if (kb_ <= qlo + QBLK - 1 && qlo - kb_ <= 190) bias_tile(P0_, P1_, qm - kb_, cur.bt);            \
        if (kb_ == 0) padmask_tile(P0_, P1_);                                                         \
        if ((!SK || ACT(t)) && (kb_ + KVBLK - 1 > qlo || kb_ <= qlo + QBLK - 1 - W)) mask_tile(P0_, P1_, qm - kb_, (unsigned)W); } while (0)
    constexpr int NQL = F32 ? 16 : 8;
    constexpr bool SK = WSKIP && !F32;
#define SEAM_K0() do { VMWN(NQL); if constexpr (F32) { SWRITE_KF(0); SBAR(); SLOAD_F((const float*)nxt.V, kbn); } else { SWRITE_HK(0); } SBAR(); } while (0)
    f32x16 pA0, pA1, pB0, pB1; float mnA, mnB, alA, alB; bf16x8 pa0, pa1, pa2, pa3;
    if constexpr (F32) { VMW(); SWRITE_VF(0); SBAR(); } else { SWRITE_HV(0); SBAR(); }
    if (NT > 1) { if constexpr (F32) SLOAD_F((const float*)Kh, KBASE(1)); else SLOAD_H(Kh, Vh, KBASE(1)); }
    SBAR(); qkt<0, SK>(pA0, pA1, K_lds, r32, hi, S.qr, ACT(0));
    if constexpr (F32) { if (NT > 1) { VMW(); SWRITE_KF(1); SBAR(); SLOAD_F((const float*)Vh, KBASE(1)); } }
    MASKT(pA0, pA1, 0); partialSM(pA0, pA1, m_reg, mnA, alA);
    if (NT > 1) { VMW(); if constexpr (F32) { SWRITE_VF(1); SBAR(); if (NT > 2) SLOAD_F((const float*)Kh, KBASE(2)); } else SWRITE_H(1); }
    __syncthreads();
#define HALF_STEP(PX0, PX1, mnX, alX, PY0, PY1, alY, t, KB, VB, SB) do {                                                      \
        SBAR(); qkt<KB, SK>(PX0, PX1, K_lds, r32, hi, S.qr, ACT(t));                                             \
        finishSM(PY0, PY1, alY, l_reg, pa0, pa1, pa2, pa3); SBAR();                                                           \
        if ((t) + 1 < NT) { if constexpr (F32) { VMW(); SWRITE_KF(SB); SBAR(); SLOAD_F((const float*)Vh, KBASE((t) + 1)); }  \
                            else { SLOAD_H(Kh, Vh, KBASE((t) + 1)); } SBAR(); }                                               \
        pv_tile<VB, SK>(o, vb0, pa0, pa1, pa2, pa3, ACT((t) - 1)); MASKT(PX0, PX1, (t)); partialSM(PX0, PX1, m_reg, mnX, alX);                                        \
        __syncthreads();                                                                                                      \
        if ((t) + 1 < NT) { VMW(); if constexpr (F32) { SWRITE_VF(SB); SBAR(); if ((t) + 2 < NT) SLOAD_F((const float*)Kh, KBASE((t) + 2)); } \
                            else { SWRITE_H(SB); } }                                                                          \
        RESC(alX); __syncthreads(); } while (0)
    for (int t = 1; t + 1 < NT; t += 2) {
        HALF_STEP(pB0, pB1, mnB, alB, pA0, pA1, alA, t, 1, 0, 0);
        HALF_STEP(pA0, pA1, mnA, alA, pB0, pB1, alB, t + 1, 0, 1, 1);
    }
    const bool even = (NT & 1) == 0;
    if (even) { SBAR(); qkt<1, SK>(pB0, pB1, K_lds, r32, hi, S.qr, ACT(NT - 1)); SBAR(); }
#define QROW(e) (nxt.Q + (size_t)(wid * QBLK + r32) * D + ((e) >> 1) * 16 + hi * 8 + ((e) & 1) * 4)
    if constexpr (F32) { SLOAD_F((const float*)nxt.K, kbn); SBAR();
#pragma unroll
        for (int e = 0; e < 8; ++e) S.tq[e] = *(const f32x4*)QROW(e); }
    else { SLOAD_H(nxt.K, nxt.V, kbn); SBAR();
#pragma unroll
        for (int d0 = 0; d0 < 8; ++d0) S.qr[d0] = load8<TIn>(nxt.Q + (size_t)(wid * QBLK + r32) * D + d0 * 16 + hi * 8); }
    SBAR();
    finishSM(pA0, pA1, alA, l_reg, pa0, pa1, pa2, pa3); SBAR();
    if constexpr (F32) {
#pragma unroll
        for (int e = 8; e < 16; ++e) S.tq[e] = *(const f32x4*)QROW(e); SBAR(); }
#undef QROW
    pv_tile<0, SK>(o, vb0, pa0, pa1, pa2, pa3, ACT(even ? NT - 2 : NT - 1));
    if (even) { MASKT(pB0, pB1, NT - 1); partialSM(pB0, pB1, m_reg, mnB, alB); __syncthreads(); RESC(alB);
        finishSM(pB0, pB1, alB, l_reg, pa0, pa1, pa2, pa3); SBAR(); pv_tile<1, SK>(o, vb0, pa0, pa1, pa2, pa3, ACT(NT - 1)); }
    SBAR(); SEAM_K0();
    if (hi == 0) li_l[r32] = l_reg; asm volatile("s_waitcnt lgkmcnt(0)" ::: "memory");
    float rli[16];
#pragma unroll
    for (int r = 0; r < 16; ++r) rli[r] = __builtin_amdgcn_rcpf(li_l[crow(r, hi)]);
    TOut* Ow = cur.O + (size_t)(wid * QBLK) * D;
#pragma unroll
    for (int r = 0; r < 16; ++r) { const int orow = crow(r, hi);
#pragma unroll
        for (int d0 = 0; d0 < 4; ++d0) { const float v = o[d0][r] * rli[r];
            if constexpr (same_t<TOut, float>::v) { Ow[(size_t)orow * D + d0 * 32 + r32] = v; }
            else { const float vn = __shfl_xor(v, 1);
                   if ((r32 & 1) == 0) *(unsigned*)(Ow + (size_t)orow * D + d0 * 32 + r32) = cvtpk(v, vn); } } }
    if constexpr (F32) {
#pragma unroll
        for (int d0 = 0; d0 < 8; ++d0) S.qr[d0] = pack8(S.tq[2 * d0], S.tq[2 * d0 + 1]); }
    __syncthreads();
#undef RESC
#undef KBASE
#undef ACT
#undef MASKT
#undef SEAM_K0
#undef HALF_STEP
}
#undef ROW
#undef VMW
#undef VMWN
#undef SLOAD_H
#undef SWRITE_HK
#undef SWRITE_HV
#undef SWRITE_H
#undef SLOAD_F
#undef SWRITE_KF
#undef SWRITE_VF
#undef KSWZ
#undef SBAR
}

constexpr int NWAVES = 8, NTHR = NWAVES * 64;
constexpr int DM = 2048, NB = 4, SEQ = 8192, NMETA = 16;
constexpr int MTOK = NB * SEQ;
constexpr int MROWS = MTOK + 256;
constexpr int DIN = 9 * DM;
constexpr int PKV = 64 + SEQ;
constexpr int NCHK = SEQ / 64;
constexpr int NE = 32, TOPK = 4, DFF = 2048;
constexpr int NASSIGN = MTOK * TOPK;
constexpr int RSLOT = NASSIGN + NE * 256;
constexpr float RMS_EPS = 1e-6f;
constexpr float LAMBDA_INIT = 0.2f;

constexpr size_t MiB = 1u << 20, KiB = 1u << 10;
constexpr size_t WS_CTL = 0, CTL_ZERO_BYTES = 1 * MiB;
constexpr size_t WS_SM = 1 * MiB;
constexpr size_t SM_LB = WS_SM, SM_LAM = WS_SM + 8 * KiB, SM_BT = WS_SM + 9 * KiB, SM_RSTD = WS_SM + 32 * KiB;
constexpr size_t SM_AE = WS_SM + 256 * KiB, SM_AR = WS_SM + 768 * KiB, SM_AG = WS_SM + 1280 * KiB, SM_TS = WS_SM + 1792 * KiB;
constexpr size_t SM_ST = WS_SM + 2304 * KiB, SM_SR = WS_SM + 2848 * KiB, SM_SG = WS_SM + 3392 * KiB;
static_assert(SM_SG + (size_t)RSLOT * 4 <= 5 * MiB && SM_RSTD + (size_t)MTOK * 4 <= SM_AE && SM_BT + 8 * 352 * 4 <= SM_RSTD, "small tables");
constexpr size_t WS_WOUT = 5 * MiB, WS_WR = 13 * MiB, WS_WGU = 14 * MiB, WS_WDN = 526 * MiB;
constexpr size_t WS_WIN = 782 * MiB, WS_U = 854 * MiB;
constexpr size_t WS_Y = WS_U, WS_HG2 = WS_U;
constexpr size_t WS_QH = 983 * MiB, WS_KH = 1111 * MiB, WS_VH = 1240 * MiB, WS_HQ = 1369 * MiB, WS_HK = 1498 * MiB, WS_HGT = 1627 * MiB, WS_HV = 1756 * MiB;
constexpr size_t WS_OG = 1885 * MiB, WS_GA = 2013 * MiB, WS_GH = 2141 * MiB;
constexpr size_t WS_OP = 2269 * MiB, WS_DS = 2525 * MiB, WS_DEC = 2781 * MiB, WS_END = 2785 * MiB;
constexpr size_t WS_ACT = WS_QH, WS_YS = WS_HGT;
static_assert(WS_ACT + (size_t)RSLOT * DM * 2 <= WS_HGT && WS_YS + (size_t)RSLOT * DM * 2 <= WS_OP, "MoE overlays");
static_assert(WS_KH + (size_t)NB * 16 * PKV * 128 * 2 <= WS_VH && WS_U + (size_t)MROWS * DM * 2 <= WS_QH && WS_WIN + (size_t)DIN * DM * 2 <= WS_U, "d_ws map");
constexpr int CW_CNT = 64;
constexpr int CW_BAR = 4096;

constexpr int RING_BYTES = 131072;
constexpr int XCH_OFF = 131072;
constexpr int CTRL_OFF = 147456;
constexpr int LDS_BYTES = 151552;
constexpr int NPHASE = 11;
#ifndef MK_N_LAUNCHES
#define MK_N_LAUNCHES 1
#endif
constexpr int N_LAUNCHES = MK_N_LAUNCHES;
static_assert(N_LAUNCHES == 1 || N_LAUNCHES == NPHASE, "launch cuts");

#define GAS __attribute__((address_space(1)))
#define LAS __attribute__((address_space(3)))
typedef unsigned short bf16;
typedef unsigned v4u __attribute__((ext_vector_type(4)));
typedef unsigned v2u __attribute__((ext_vector_type(2)));
typedef float f32x4 __attribute__((ext_vector_type(4)));
typedef float f32x16 __attribute__((ext_vector_type(16)));
typedef short bf16x8 __attribute__((ext_vector_type(8)));
#define LDS_WAIT() asm volatile("s_waitcnt lgkmcnt(0)" ::: "memory")
#define VM_WAIT() asm volatile("s_waitcnt vmcnt(0)" ::: "memory")
__device__ __forceinline__ unsigned f2bf(float f) { unsigned u = __builtin_bit_cast(unsigned, f); return (u + 0x7fffu + ((u >> 16) & 1u)) >> 16; }
typedef float f32x2_t __attribute__((ext_vector_type(2))); typedef __bf16 bf16x2_t __attribute__((ext_vector_type(2)));
__device__ __forceinline__ unsigned pk2(float lo, float hi) { f32x2_t v = {lo, hi}; bf16x2_t b = __builtin_convertvector(v, bf16x2_t); return __builtin_bit_cast(unsigned, b); }
__device__ __forceinline__ float bf_lo(unsigned u) { return __builtin_bit_cast(float, u << 16); }
__device__ __forceinline__ float bf_hi(unsigned u) { return __builtin_bit_cast(float, u & 0xffff0000u); }
__device__ __forceinline__ float bf2f(bf16 h) { return __builtin_bit_cast(float, (unsigned)h << 16); }
__device__ __forceinline__ float sigmoidf_(float x) { return __builtin_amdgcn_rcpf(1.f + __expf(-x)); }
__device__ __forceinline__ float wave_sum(float v) {
#pragma unroll
    for (int o = 1; o < 64; o <<= 1) v += __shfl_xor(v, o);
    return v;
}
#define XB_TMO      128
#define XB_XCNT(j)  (256  + 64 * (j))
#define XB_XSUB(j)  (1280 + 64 * (j))
#define XB_XGEN(j)  (2304 + 64 * (j))
#define XB_TOP      3328
#define XB_TOPGEN   3392
#define XCD_BAR_WORDS 3456
#define XB_SPIN_CAP (1u << 18)

__device__ __forceinline__ unsigned xb_ld(unsigned* p)              { return __hip_atomic_load(p, __ATOMIC_RELAXED, __HIP_MEMORY_SCOPE_AGENT); }
__device__ __forceinline__ unsigned xb_add(unsigned* p, unsigned v) { return __hip_atomic_fetch_add(p, v, __ATOMIC_RELAXED, __HIP_MEMORY_SCOPE_AGENT); }
__device__ __forceinline__ unsigned xb_xcc_id() { return (unsigned)__builtin_amdgcn_s_getreg((3 << 11) | 20) & 0xFu; }
#define XB_SPIN(cond, bar) do { unsigned _sp = 0; while (cond) { __builtin_amdgcn_s_sleep(1); \
    if ((++_sp & 255u) == 0u) { if (xb_ld(&(bar)[XB_TMO])) break; if (_sp > XB_SPIN_CAP) { atomicAdd(&(bar)[XB_TMO], 1u); break; } } } } while (0)

struct XcdBarrier {
    unsigned* bar; unsigned x;
    volatile LAS unsigned* st;
};

__device__ __forceinline__ XcdBarrier xcd_barrier_post(unsigned* bar, volatile LAS unsigned* st) {
    XcdBarrier b; b.bar = bar; b.x = xb_xcc_id(); b.st = st;
    if (threadIdx.x == 0) (void)xb_add(&bar[XB_XCNT(b.x)], 1u);
    return b;
}
__device__ __forceinline__ void xcd_barrier_complete(unsigned* bar, unsigned x, unsigned& nloc, unsigned& nx) {
    const unsigned G = gridDim.x * gridDim.y * gridDim.z;
    unsigned sum, cnt, mine, sp = 0u;
    for (;;) {
        sum = 0u; cnt = 0u; mine = 0u;
#pragma unroll
        for (unsigned j = 0; j < 16; ++j) { const unsigned c = xb_ld(&bar[XB_XCNT(j)]); sum += c; cnt += (c > 0u) ? 1u : 0u; mine = (j == x) ? c : mine; }
        if (sum == G) break;
        __builtin_amdgcn_s_sleep(1);
        if ((++sp & 255u) == 0u) { if (xb_ld(&bar[XB_TMO])) break; if (sp > XB_SPIN_CAP) { atomicAdd(&bar[XB_TMO], 1u); break; } }
    }
    nloc = mine > 0u ? mine : 1u; nx = cnt > 0u ? cnt : 1u;
}

__device__ __forceinline__ void xcd_barrier(const XcdBarrier& b) {
    asm volatile("s_waitcnt vmcnt(0)" ::: "memory");
    __syncthreads();
    if (threadIdx.x == 0) {
        unsigned* bar = b.bar;
        __builtin_amdgcn_s_waitcnt(0);
        unsigned nloc = b.st[0], nx = b.st[1];
        if (nloc == 0u) { xcd_barrier_complete(bar, b.x, nloc, nx); b.st[0] = nloc; b.st[1] = nx; }
        const unsigned old = xb_add(&bar[XB_XSUB(b.x)], 1u);
        const unsigned gen = old / nloc;
        if (old + 1u == (gen + 1u) * nloc) {
            __builtin_amdgcn_fence(__ATOMIC_RELEASE, "agent");
            asm volatile("s_waitcnt vmcnt(0)" ::: "memory");
            const unsigned og = xb_add(&bar[XB_TOP], 1u);
            const unsigned tg = og / nx;
            if (og + 1u == (tg + 1u) * nx) xb_add(&bar[XB_TOPGEN], 1u);
            else XB_SPIN(xb_ld(&bar[XB_TOPGEN]) == tg, bar);
            __builtin_amdgcn_fence(__ATOMIC_ACQUIRE, "agent");
            xb_add(&bar[XB_XGEN(b.x)], 1u);
            asm volatile("s_waitcnt vmcnt(0)" ::: "memory");
        } else {
            XB_SPIN(xb_ld(&bar[XB_XGEN(b.x)]) == gen, bar);
            __builtin_amdgcn_fence(__ATOMIC_ACQUIRE, "agent");
            asm volatile("s_waitcnt vmcnt(0)" ::: "memory");
        }
    }
    __syncthreads();
}


__device__ __forceinline__ void static_order(int L, int nM, int nN, int& pm, int& pn) {
    const int nwg = nM * nN, q = nwg / 8, xcd = L & 7, off = L >> 3; const int wgid = xcd * q + off;
    const int nig = 8 * nN, gid = wgid / nig, fm = gid * 8; pm = fm + ((wgid % nig) & 7); pn = (wgid % nig) >> 3;
}
struct SchedInProj {
    int G, c; const bf16* Bt;
    __device__ __forceinline__ bool next(int i, pg8::Unit& u) const {
        u.e = 0;
        if (c < 32) { if (i == 0) { const int gs = c >> 3; u.pm = 128; u.pn = (gs == 0 ? 1 : gs == 1 ? 2 : gs == 2 ? 4 : 5) * 8 + (c & 7); u.aux = 1; return true; } i -= 1; }
        const long L = (long)i * G + c; if (L >= 128 * 72) return false;
        static_order((int)L, 128, 72, u.pm, u.pn); u.aux = 0; return true;
    }
    __device__ __forceinline__ unsigned arow(const pg8::Unit& u, int r) const { return (unsigned)(u.pm * 256 + r); }
    __device__ __forceinline__ const char* bptr(const pg8::Unit& u) const { return (const char*)Bt + (size_t)u.pn * 256 * DM * 2; }
};
struct SchedPlain {
    int G, c, nM, nN; const bf16* Bt;
    __device__ __forceinline__ bool next(int i, pg8::Unit& u) const {
        const long L = (long)i * G + c; if (L >= (long)nM * nN) return false;
        static_order((int)L, nM, nN, u.pm, u.pn); u.e = 0; u.aux = 0; return true;
    }
    __device__ __forceinline__ unsigned arow(const pg8::Unit& u, int r) const { return (unsigned)(u.pm * 256 + r); }
    __device__ __forceinline__ const char* bptr(const pg8::Unit& u) const { return (const char*)Bt + (size_t)u.pn * 256 * DM * 2; }
};
struct SchedMoE {
    int G, c, npn; const LAS int* tstart; const bf16* W; size_t wstride; const int* slot_tok;
    __device__ __forceinline__ bool next(int i, pg8::Unit& u) const {
        const int L = i * G + c; if (L >= tstart[32] * npn) return false;
        int e = 0;
#pragma unroll 8
        for (int j = 1; j <= 32; ++j) e += (L >= tstart[j] * npn) ? 1 : 0;
        e = __builtin_amdgcn_readfirstlane(e);
        const int t0 = __builtin_amdgcn_readfirstlane(tstart[e]), t1 = __builtin_amdgcn_readfirstlane(tstart[e + 1]), w = L - t0 * npn, ne = t1 - t0;
        u.pn = w / ne; u.pm = t0 + w % ne; u.e = e; u.aux = 0; return true;
    }
    __device__ __forceinline__ unsigned arow(const pg8::Unit& u, int r) const { const int slot = u.pm * 256 + r; return slot_tok ? (unsigned)slot_tok[slot] : (unsigned)slot; }
    __device__ __forceinline__ const char* bptr(const pg8::Unit& u) const { return (const char*)W + (size_t)u.e * wstride + (size_t)u.pn * 256 * DM * 2; }
};

struct EpiInProj {
    static constexpr bool PERM = true;
    unsigned char* ws; const float *qg, *kg, *lb; LAS float* xch;
    __device__ __forceinline__ void st_hm(bf16* base, int slen, int poff, bool meta, int b, int s, int rl, int head16, int d0, v4u w) const {
        if (!meta) { *(v4u*)(base + ((size_t)(b * 16 + head16) * slen + poff + s) * 128 + d0) = w; }
        else if (rl < 16) {
#pragma unroll
            for (int bb = 0; bb < NB; ++bb) *(v4u*)(base + ((size_t)(bb * 16 + head16) * slen + 48 + rl) * 128 + d0) = w; }
    }
    __device__ __forceinline__ void operator()(const pg8::f32x4 (&acc)[2][2][4][2], const pg8::Unit& u, int wr, int wc, int fr, int fq, int wid, int lane) const {
        asm volatile("" : "+v"(fr), "+v"(fq));
        const int grp = u.pn >> 3, pl = u.pn & 7; const bool meta = u.aux != 0;
        const int d0 = 32 * wc + 8 * fq, b = u.pm >> 5, sb = (u.pm & 31) * 256;
        if (grp <= 1) {
            f32x4 g0, g1;
            if (grp == 0) { g0 = *(const f32x4*)(qg + d0); g1 = *(const f32x4*)(qg + d0 + 4); } else { g0 = *(const f32x4*)(kg + d0); g1 = *(const f32x4*)(kg + d0 + 4); }
            bf16* const QH = (bf16*)(ws + WS_QH); bf16* const KH = (bf16*)(ws + WS_KH);
#pragma unroll
            for (int ai = 0; ai < 2; ++ai)
#pragma unroll
                for (int m = 0; m < 4; ++m)
#pragma unroll
                    for (int bj = 0; bj < 2; ++bj) {
                        const f32x4 a = acc[ai][bj][m][0], c = acc[ai][bj][m][1];
                        float s = (a[0] * a[0] + a[1] * a[1]) + (a[2] * a[2] + a[3] * a[3]) + (c[0] * c[0] + c[1] * c[1]) + (c[2] * c[2] + c[3] * c[3]);
                        s += __shfl_xor(s, 16); s += __shfl_xor(s, 32);
                        const int rl = 128 * ai + 64 * wr + 16 * m + fr;
                        if (fq == 0) xch[(rl * 2 + bj) * 4 + wc] = s;
                    }
            LDS_WAIT(); __builtin_amdgcn_s_barrier(); asm volatile("" ::: "memory");
#pragma unroll
            for (int ai = 0; ai < 2; ++ai)
#pragma unroll
                for (int m = 0; m < 4; ++m)
#pragma unroll
                    for (int bj = 0; bj < 2; ++bj) {
                        const int rl = 128 * ai + 64 * wr + 16 * m + fr;
                        const f32x4 p = *(const LAS f32x4*)(xch + (rl * 2 + bj) * 4);
                        const float rs = __builtin_amdgcn_rsqf(((p[0] + p[1]) + (p[2] + p[3])) * (1.f / 128.f) + RMS_EPS);
                        const f32x4 a = acc[ai][bj][m][0] * rs * g0, c = acc[ai][bj][m][1] * rs * g1;
                        v4u w; w.x = pk2(a[0], a[1]); w.y = pk2(a[2], a[3]); w.z = pk2(c[0], c[1]); w.w = pk2(c[2], c[3]);
                        if (grp == 0) { if (!meta) *(v4u*)(QH + ((size_t)(b * 16 + 2 * pl + bj) * SEQ + sb + rl) * 128 + d0) = w; }
                        else st_hm(KH, PKV, 64, meta, b, sb + rl, rl, 2 * pl + bj, d0, w);
                    }
        } else if (grp == 2 || grp == 5) {
            bf16* dst = (bf16*)(ws + (grp == 2 ? WS_VH : WS_HV));
#pragma unroll
            for (int ai = 0; ai < 2; ++ai)
#pragma unroll
                for (int m = 0; m < 4; ++m)
#pragma unroll
                    for (int bj = 0; bj < 2; ++bj) {
                        const int rl = 128 * ai + 64 * wr + 16 * m + fr; const f32x4 a = acc[ai][bj][m][0], c = acc[ai][bj][m][1];
                        v4u w; w.x = pk2(a[0], a[1]); w.y = pk2(a[2], a[3]); w.z = pk2(c[0], c[1]); w.w = pk2(c[2], c[3]);
                        st_hm(dst, PKV, 64, meta, b, sb + rl, rl, 2 * pl + bj, d0, w);
                    }
        } else if (grp == 3) {
            if (!meta) {
#pragma unroll
            for (int ai = 0; ai < 2; ++ai)
#pragma unroll
                for (int m = 0; m < 4; ++m)
#pragma unroll
                    for (int bj = 0; bj < 2; ++bj) {
                        const int rl = 128 * ai + 64 * wr + 16 * m + fr; f32x4 a = acc[ai][bj][m][0], c = acc[ai][bj][m][1];
#pragma unroll
                        for (int j = 0; j < 4; ++j) { a[j] *= sigmoidf_(a[j]); c[j] *= sigmoidf_(c[j]); }
                        v4u w; w.x = pk2(a[0], a[1]); w.y = pk2(a[2], a[3]); w.z = pk2(c[0], c[1]); w.w = pk2(c[2], c[3]);
                        st_hm((bf16*)(ws + WS_HQ), PKV, 64, false, b, sb + rl, rl, 2 * pl + bj, d0, w);
                    }
            }
        } else if (grp == 4) {
#pragma unroll
            for (int bj = 0; bj < 2; ++bj) {
                const f32x4 l0 = *(const f32x4*)(lb + 256 * pl + 128 * bj + d0), l1 = *(const f32x4*)(lb + 256 * pl + 128 * bj + d0 + 4);
#pragma unroll
                for (int ai = 0; ai < 2; ++ai)
#pragma unroll
                    for (int m = 0; m < 4; ++m) {
                        const int rl = 128 * ai + 64 * wr + 16 * m + fr; const f32x4 a = acc[ai][bj][m][0], c = acc[ai][bj][m][1];
                        f32x4 ga, gc, ka, kc;
#pragma unroll
                        for (int j = 0; j < 4; ++j) { const float sa = sigmoidf_(a[j]), sc = sigmoidf_(c[j]);
                            ga[j] = __logf(l0[j] + (1.f - l0[j]) * sa); gc[j] = __logf(l1[j] + (1.f - l1[j]) * sc);
                            ka[j] = (1.f - l0[j]) * (1.f - sa); kc[j] = (1.f - l1[j]) * (1.f - sc); }
                        v4u w; w.x = pk2(ga[0], ga[1]); w.y = pk2(ga[2], ga[3]); w.z = pk2(gc[0], gc[1]); w.w = pk2(gc[2], gc[3]);
                        st_hm((bf16*)(ws + WS_HGT), PKV, 64, meta, b, sb + rl, rl, 2 * pl + bj, d0, w);
                        w.x = pk2(ka[0], ka[1]); w.y = pk2(ka[2], ka[3]); w.z = pk2(kc[0], kc[1]); w.w = pk2(kc[2], kc[3]);
                        st_hm((bf16*)(ws + WS_HK), PKV, 64, meta, b, sb + rl, rl, 2 * pl + bj, d0, w);
                    }
            }
        } else if (!meta) {
            bf16* dst = (bf16*)(ws + (grp == 6 ? WS_OG : grp == 7 ? WS_GA : WS_GH));
#pragma unroll
            for (int ai = 0; ai < 2; ++ai)
#pragma unroll
                for (int m = 0; m < 4; ++m)
#pragma unroll
                    for (int bj = 0; bj < 2; ++bj) {
                        const int rl = 128 * ai + 64 * wr + 16 * m + fr; f32x4 a = acc[ai][bj][m][0], c = acc[ai][bj][m][1];
#pragma unroll
                        for (int j = 0; j < 4; ++j) { const float sa = sigmoidf_(a[j]), sc = sigmoidf_(c[j]); a[j] = grp == 6 ? a[j] * sa : sa; c[j] = grp == 6 ? c[j] * sc : sc; }
                        v4u w; w.x = pk2(a[0], a[1]); w.y = pk2(a[2], a[3]); w.z = pk2(c[0], c[1]); w.w = pk2(c[2], c[3]);
                        *(v4u*)(dst + (size_t)(u.pm * 256 + rl) * DM + 256 * pl + 128 * bj + d0) = w;
                    }
        }
    }
};
struct EpiOutProj {
    static constexpr bool PERM = false;
    const float* x; float* out;
    __device__ __forceinline__ void operator()(const pg8::f32x4 (&acc)[2][2][4][2], const pg8::Unit& u, int wr, int wc, int fr, int fq, int wid, int lane) const {
        asm volatile("" : "+v"(fr), "+v"(fq));
        const int row0 = u.pm * 256 + wr * 64 + fr, col0 = u.pn * 256 + wc * 32 + 4 * fq;
#pragma unroll
        for (int ai = 0; ai < 2; ++ai)
#pragma unroll
            for (int m = 0; m < 4; ++m) { const size_t off = (size_t)(row0 + ai * 128 + m * 16) * DM + col0;
#pragma unroll
                for (int bj = 0; bj < 2; ++bj)
#pragma unroll
                    for (int n = 0; n < 2; ++n) { const f32x4 xv = *(const f32x4*)(x + off + bj * 128 + n * 16); *(f32x4*)(out + off + bj * 128 + n * 16) = xv + acc[ai][bj][m][n]; }
                asm volatile("" ::: "memory"); }
    }
};
struct EpiGateUp {
    static constexpr bool PERM = true;
    const float* bgu; const float* slot_rstd; bf16* ACT;
    __device__ __forceinline__ void operator()(const pg8::f32x4 (&acc)[2][2][4][2], const pg8::Unit& u, int wr, int wc, int fr, int fq, int wid, int lane) const {
        asm volatile("" : "+v"(fr), "+v"(fq));
        const int d0 = 32 * wc + 8 * fq; const float* bp = bgu + (size_t)u.e * (2 * DFF) + 128 * u.pn + d0;
        const f32x4 bg0 = *(const f32x4*)bp, bg1 = *(const f32x4*)(bp + 4), bl0 = *(const f32x4*)(bp + DFF), bl1 = *(const f32x4*)(bp + DFF + 4);
#pragma unroll
        for (int ai = 0; ai < 2; ++ai)
#pragma unroll
            for (int m = 0; m < 4; ++m) {
                const int slot = u.pm * 256 + 128 * ai + 64 * wr + 16 * m + fr; const float rs = slot_rstd[slot];
                f32x4 o[2];
#pragma unroll
                for (int n = 0; n < 2; ++n) { const f32x4 g = acc[ai][0][m][n] * rs + (n ? bg1 : bg0), l = acc[ai][1][m][n] * rs + (n ? bl1 : bl0);
#pragma unroll
                    for (int j = 0; j < 4; ++j) { const float xg = fminf(g[j], 7.f), xl = fminf(fmaxf(l[j], -7.f), 7.f); o[n][j] = xg * sigmoidf_(1.702f * xg) * (xl + 1.f); } }
                v4u w; w.x = pk2(o[0][0], o[0][1]); w.y = pk2(o[0][2], o[0][3]); w.z = pk2(o[1][0], o[1][1]); w.w = pk2(o[1][2], o[1][3]);
                *(v4u*)(ACT + (size_t)slot * DFF + 128 * u.pn + d0) = w;
            }
    }
};
struct EpiDown {
    static constexpr bool PERM = true;
    const float* bdn; const float* slot_gate; bf16* YS;
    __device__ __forceinline__ void operator()(const pg8::f32x4 (&acc)[2][2][4][2], const pg8::Unit& u, int wr, int wc, int fr, int fq, int wid, int lane) const {
        asm volatile("" : "+v"(fr), "+v"(fq));
        const int d0 = 32 * wc + 8 * fq; const float* bp = bdn + (size_t)u.e * DM + 256 * u.pn + d0;
        f32x4 bv[2][2];
#pragma unroll
        for (int bj = 0; bj < 2; ++bj) { bv[bj][0] = *(const f32x4*)(bp + 128 * bj); bv[bj][1] = *(const f32x4*)(bp + 128 * bj + 4); }
#pragma unroll
        for (int ai = 0; ai < 2; ++ai)
#pragma unroll
            for (int m = 0; m < 4; ++m) {
                const int slot = u.pm * 256 + 128 * ai + 64 * wr + 16 * m + fr; const float gt = slot_gate[slot];
#pragma unroll
                for (int bj = 0; bj < 2; ++bj) { const f32x4 a = (acc[ai][bj][m][0] + bv[bj][0]) * gt, c = (acc[ai][bj][m][1] + bv[bj][1]) * gt;
                    v4u w; w.x = pk2(a[0], a[1]); w.y = pk2(a[2], a[3]); w.z = pk2(c[0], c[1]); w.w = pk2(c[2], c[3]);
                    *(v4u*)(YS + (size_t)slot * DM + 256 * u.pn + 128 * bj + d0) = w; }
            }
    }
};

__device__ __forceinline__ void p0_transpose_item(const float* W, int ldw, bf16* WT, int k0, int n0, size_t dst_row0, LAS float* scr, int lane) {
    float v[32];
#pragma unroll
    for (int i = 0; i < 32; ++i) { const int kk = 2 * i + (lane >> 5); v[i] = W[(size_t)(k0 + kk) * ldw + n0 + (lane & 31)]; }
#pragma unroll
    for (int i = 0; i < 32; ++i) { const int kk = 2 * i + (lane >> 5); scr[kk * 33 + (lane & 31)] = v[i]; }
    LDS_WAIT(); asm volatile("" ::: "memory");
    const int c = lane & 7;
#pragma unroll
    for (int j = 0; j < 4; ++j) { const int n = (lane >> 3) + 8 * j; const LAS float* s = scr + (8 * c) * 33 + n;
        v4u o; o.x = pk2(s[0 * 33], s[1 * 33]); o.y = pk2(s[2 * 33], s[3 * 33]); o.z = pk2(s[4 * 33], s[5 * 33]); o.w = pk2(s[6 * 33], s[7 * 33]);
        *(v4u*)(WT + (dst_row0 + n) * DM + k0 + 8 * c) = o; }
    LDS_WAIT(); asm volatile("" ::: "memory");
}
__device__ __forceinline__ void rms_row_to_bf16(const float* xrow, const float* gain, bf16* orow, int lane) {
    const f32x4* xr = (const f32x4*)xrow + lane; const f32x4* gr = (const f32x4*)gain + lane;
    f32x4 v[8]; float s = 0.f;
#pragma unroll
    for (int j = 0; j < 8; ++j) { v[j] = xr[64 * j]; s += (v[j][0] * v[j][0] + v[j][1] * v[j][1]) + (v[j][2] * v[j][2] + v[j][3] * v[j][3]); }
    const float rs = __builtin_amdgcn_rsqf(wave_sum(s) * (1.f / DM) + RMS_EPS);
    v2u* o8 = (v2u*)orow + lane;
#pragma unroll
    for (int j = 0; j < 8; ++j) { const f32x4 g = gr[64 * j]; v2u w; w.x = pk2(v[j][0] * rs * g[0], v[j][1] * rs * g[1]); w.y = pk2(v[j][2] * rs * g[2], v[j][3] * rs * g[3]); o8[64 * j] = w; }
}
__device__ __forceinline__ int t5_bucket(int n) {
    if (n < 16) return n;
    const int l = 16 + (int)(__builtin_logf((float)n / 16.f) / 2.0794415416798357f * 16.f);
    return l < 31 ? l : 31;
}
struct P0Args { const float *x, *meta, *rel_bias, *lb_logits, *norm1, *w_in, *diff_lambda, *w_out, *router_w, *w_gu, *w_dn; unsigned char* ws; };
__device__ __forceinline__ void p0_prologue(const P0Args& a, LAS unsigned char* lds, int vcu, int G, int tid) {
    const int lane = tid & 63, wave = __builtin_amdgcn_readfirstlane(tid >> 6);
    const int gw = vcu * NWAVES + wave, NGW = G * NWAVES; const long gid = (long)vcu * NTHR + tid, NG = (long)G * NTHR;
    unsigned char* ws = a.ws;
    float* lbp = (float*)(ws + SM_LB);
    for (long i = gid; i < DM; i += NG) lbp[i] = sigmoidf_(a.lb_logits[i] - a.lb_logits[DM + i]);
    if (gw == 0) { const float* lv = a.diff_lambda; float s1 = lv[lane] * lv[128 + lane] + lv[64 + lane] * lv[192 + lane], s2 = lv[256 + lane] * lv[384 + lane] + lv[320 + lane] * lv[448 + lane];
        s1 = wave_sum(s1); s2 = wave_sum(s2); if (lane == 0) *(float*)(ws + SM_LAM) = __expf(s1) - __expf(s2) + LAMBDA_INIT; }
    { float* bt = (float*)(ws + SM_BT);
      for (long i = gid; i < 8 * att::BT_LEN; i += NG) { const int h = (int)i / att::BT_LEN, rel = (int)i % att::BT_LEN - att::BT_OFF;
          bt[i] = (rel >= 0 && rel < 113) ? (a.rel_bias[t5_bucket(rel) * 8 + h] - a.rel_bias[31 * 8 + h]) * (1.f / att::SCALE) : 0.f; } }
    { int* st = (int*)(ws + SM_ST); float* sr = (float*)(ws + SM_SR); float* sg = (float*)(ws + SM_SG);
      for (long i = gid; i < RSLOT; i += NG) { st[i] = MTOK; sr[i] = 0.f; sg[i] = 0.f; } }
    { const v4u z = {0u, 0u, 0u, 0u};
      for (long i = gid; i < 5L * 64 * 768; i += NG) { const int tsel = (int)(i / (64 * 768)), r = (int)(i % (64 * 768)), bh = r / 768, q = r % 768;
          const size_t base = tsel == 0 ? WS_KH : tsel == 1 ? WS_VH : tsel == 2 ? WS_HK : tsel == 3 ? WS_HGT : WS_HV;
          *(v4u*)(ws + base + ((size_t)bh * PKV * 128) * 2 + (size_t)q * 16) = z; }
      for (long i = gid; i < 240L * 256; i += NG) *(v4u*)(ws + WS_U + (size_t)(MTOK + 16) * DM * 2 + (size_t)i * 16) = z; }
    for (int m = gw; m < MTOK + NMETA; m += NGW) rms_row_to_bf16(m < MTOK ? a.x + (size_t)m * DM : a.meta + (size_t)(m - MTOK) * DM, a.norm1, (bf16*)(ws + WS_U) + (size_t)m * DM, lane);
    LAS float* scr = (LAS float*)(lds + wave * 8704);
    constexpr int I_IN = 32 * (DIN / 32), I_OUT = 32 * 64, I_R = 32, I_GU = 32 * 128, I_DN = 32 * 64;
    constexpr int NITEMS = I_IN + I_OUT + I_R + NE * (I_GU + I_DN);
    for (int it = gw; it < NITEMS; it += NGW) {
        int r = it;
        if (r < I_IN) { const int nb = r % (DIN / 32), kb = r / (DIN / 32); p0_transpose_item(a.w_in, DIN, (bf16*)(ws + WS_WIN), 64 * kb, 32 * nb, (size_t)32 * nb, scr, lane); continue; } r -= I_IN;
        if (r < I_OUT) { const int nb = r % 64, kb = r / 64; p0_transpose_item(a.w_out, DM, (bf16*)(ws + WS_WOUT), 64 * kb, 32 * nb, (size_t)32 * nb, scr, lane); continue; } r -= I_OUT;
        if (r < I_R) { p0_transpose_item(a.router_w, NE, (bf16*)(ws + WS_WR), 64 * r, 0, 0, scr, lane); continue; } r -= I_R;
        const int e = r / (I_GU + I_DN); r -= e * (I_GU + I_DN);
        if (r < I_GU) { const int nb = r % 128, kb = r / 128, n0 = 32 * nb;
            const int nn = n0 & (DFF - 1); const size_t drow = (size_t)e * (2 * DFF) + (size_t)(nn >> 7) * 256 + (n0 >= DFF ? 128 : 0) + (nn & 127);
            p0_transpose_item(a.w_gu + (size_t)e * DM * 2 * DFF, 2 * DFF, (bf16*)(ws + WS_WGU), 64 * kb, n0, drow, scr, lane); continue; } r -= I_GU;
        { const int nb = r % 64, kb = r / 64; p0_transpose_item(a.w_dn + (size_t)e * DFF * DM, DM, (bf16*)(ws + WS_WDN), 64 * kb, 32 * nb, (size_t)e * DM + 32 * nb, scr, lane); }
    }
}

typedef LAS bf16x8 lbf8; typedef LAS v4u lv4u;
#define MFMA32(a, b, c) __builtin_amdgcn_mfma_f32_32x32x16_bf16(a, b, c, 0, 0, 0)
#define MFMA16(a, b, c) __builtin_amdgcn_mfma_f32_16x16x32_bf16(a, b, c, 0, 0, 0)
__device__ __forceinline__ int crow32(int r, int hi) { return (r & 3) + 8 * (r >> 2) + 4 * hi; }
__device__ __forceinline__ void hgrn_a_unit(int bh, int c, const bf16* HK, const bf16* HG, const bf16* HV, bf16* DS, float* DEC, LAS unsigned char* lds, int tid) {
    LAS float* part = (LAS float*)lds; LAS bf16* KT = (LAS bf16*)(lds + 2048); LAS bf16* VT = (LAS bf16*)(lds + 2048 + 18432);
    const int k = tid & 127, sq = tid >> 7, lane = tid & 63, w = __builtin_amdgcn_readfirstlane(tid >> 6);
    const size_t row0 = ((size_t)bh * PKV + 64 * c + 16 * sq) * 128 + k;
    float g[16], kv[16]; unsigned vv[16];
#pragma unroll
    for (int i = 0; i < 16; ++i) { g[i] = bf2f(HG[row0 + i * 128]); kv[i] = bf2f(HK[row0 + i * 128]); vv[i] = HV[row0 + i * 128]; }
    float run = 0.f;
#pragma unroll
    for (int i = 0; i < 16; ++i) { run += g[i]; g[i] = run; }
    part[sq * 128 + k] = run;
    __syncthreads();
    float off = 0.f, tot = 0.f;
#pragma unroll
    for (int j = 0; j < 4; ++j) { const float p = part[j * 128 + k]; tot += p; off += (j < sq) ? p : 0.f; }
    unsigned kw[8], vw[8];
#pragma unroll
    for (int i = 0; i < 8; ++i) { kw[i] = pk2(kv[2 * i] * __expf(tot - off - g[2 * i]), kv[2 * i + 1] * __expf(tot - off - g[2 * i + 1])); vw[i] = vv[2 * i] | (vv[2 * i + 1] << 16); }
    *(lv4u*)(KT + k * 72 + 16 * sq) = (v4u){kw[0], kw[1], kw[2], kw[3]}; *(lv4u*)(KT + k * 72 + 16 * sq + 8) = (v4u){kw[4], kw[5], kw[6], kw[7]};
    *(lv4u*)(VT + k * 72 + 16 * sq) = (v4u){vw[0], vw[1], vw[2], vw[3]}; *(lv4u*)(VT + k * 72 + 16 * sq + 8) = (v4u){vw[4], vw[5], vw[6], vw[7]};
    if (sq == 0) DEC[((size_t)bh * NCHK + c) * 128 + k] = __expf(tot);
    __syncthreads();
    const int k0 = 32 * (w & 3), vb = 64 * (w >> 2), li = lane & 31, hi = lane >> 5;
    f32x16 a0 = {}, a1 = {};
#pragma unroll
    for (int ks = 0; ks < 4; ++ks) { const bf16x8 av = *(const lbf8*)(KT + (k0 + li) * 72 + 16 * ks + 8 * hi);
        const bf16x8 b0 = *(const lbf8*)(VT + (vb + li) * 72 + 16 * ks + 8 * hi), b1 = *(const lbf8*)(VT + (vb + 32 + li) * 72 + 16 * ks + 8 * hi);
        a0 = MFMA32(av, b0, a0); a1 = MFMA32(av, b1, a1); }
    bf16* dst = DS + ((size_t)bh * NCHK + c) * 16384;
#pragma unroll
    for (int j = 0; j < 4; ++j) { const int kk = k0 + 8 * j + 4 * hi;
        *(v2u*)(dst + (size_t)(vb + li) * 128 + kk) = (v2u){pk2(a0[4 * j], a0[4 * j + 1]), pk2(a0[4 * j + 2], a0[4 * j + 3])};
        *(v2u*)(dst + (size_t)(vb + 32 + li) * 128 + kk) = (v2u){pk2(a1[4 * j], a1[4 * j + 1]), pk2(a1[4 * j + 2], a1[4 * j + 3])}; }
    __syncthreads();
}
__device__ __forceinline__ void hgrn_b_scan(bf16* DS, const float* DEC, long gid, long NG) {
    for (long idx = gid; idx < 64L * 128 * 16; idx += NG) {
        const int bh = (int)(idx >> 11), rem = (int)(idx & 2047), v = rem >> 4, k8 = (rem & 15) * 8;
        float S[8];
#pragma unroll
        for (int j = 0; j < 8; ++j) S[j] = 0.f;
        bf16* p = DS + ((size_t)bh * NCHK * 128 + v) * 128 + k8; const float* dp = DEC + (size_t)bh * NCHK * 128 + k8;
        for (int c = 0; c < NCHK; c += 4) {
            v4u d[4]; f32x4 e0[4], e1[4];
#pragma unroll
            for (int u = 0; u < 4; ++u) { d[u] = *(const v4u*)(p + (size_t)(c + u) * 16384); e0[u] = *(const f32x4*)(dp + (c + u) * 128); e1[u] = *(const f32x4*)(dp + (c + u) * 128 + 4); }
#pragma unroll
            for (int u = 0; u < 4; ++u) {
                S[0] = e0[u][0] * S[0] + bf_lo(d[u].x); S[1] = e0[u][1] * S[1] + bf_hi(d[u].x); S[2] = e0[u][2] * S[2] + bf_lo(d[u].y); S[3] = e0[u][3] * S[3] + bf_hi(d[u].y);
                S[4] = e1[u][0] * S[4] + bf_lo(d[u].z); S[5] = e1[u][1] * S[5] + bf_hi(d[u].z); S[6] = e1[u][2] * S[6] + bf_lo(d[u].w); S[7] = e1[u][3] * S[7] + bf_hi(d[u].w);
                *(v4u*)(p + (size_t)(c + u) * 16384) = (v4u){pk2(S[0], S[1]), pk2(S[2], S[3]), pk2(S[4], S[5]), pk2(S[6], S[7])}; }
        }
    }
}
struct HcArgs { const bf16 *HQ, *HK, *HG, *HV, *DS, *OP, *OG, *GA, *GH; bf16* Y; const float *subln, *hgn; float lam; };
__device__ __forceinline__ void hgrn_c_unit(const HcArgs& A, int b, int c, int hp, LAS unsigned char* lds, int tid) {
    LAS bf16* QI = (LAS bf16*)lds;
    LAS bf16* VT = (LAS bf16*)(lds + 17408);
    LAS bf16* AT = (LAS bf16*)(lds + 35840);
    LAS bf16* ST = (LAS bf16*)(lds + 45056);
    LAS bf16* QR = (LAS bf16*)(lds + 79872);
    LAS bf16* KR = (LAS bf16*)(lds + 97280);
    LAS float* OT = (LAS float*)(lds + 79872);
    LAS float* part = (LAS float*)(lds + 140800);
    const int lane = tid & 63, w = __builtin_amdgcn_readfirstlane(tid >> 6);
    const int t8 = tid >> 3, j8 = tid & 7;
    const size_t m = (size_t)b * SEQ + 64 * (c - 1) + t8;
    float an[32];
    { float ss = 0.f;
#pragma unroll
      for (int half = 0; half < 2; ++half) {
          const bf16* p0 = A.OP + ((size_t)(b * 32 + (2 * hp) * 2 + half) * SEQ + 64 * (c - 1) + t8) * 128 + 16 * j8;
          const bf16* p1 = A.OP + ((size_t)(b * 32 + (2 * hp + 1) * 2 + half) * SEQ + 64 * (c - 1) + t8) * 128 + 16 * j8;
          const v4u x0 = *(const v4u*)p0, x1 = *(const v4u*)(p0 + 8), y0 = *(const v4u*)p1, y1 = *(const v4u*)(p1 + 8);
          const unsigned xs[8] = {x0.x, x0.y, x0.z, x0.w, x1.x, x1.y, x1.z, x1.w}, ys[8] = {y0.x, y0.y, y0.z, y0.w, y1.x, y1.y, y1.z, y1.w};
#pragma unroll
          for (int i = 0; i < 8; ++i) { const float a0 = bf_lo(xs[i]) - A.lam * bf_lo(ys[i]), a1 = bf_hi(xs[i]) - A.lam * bf_hi(ys[i]); an[16 * half + 2 * i] = a0; an[16 * half + 2 * i + 1] = a1; ss += a0 * a0 + a1 * a1; } }
      ss += __shfl_xor(ss, 1); ss += __shfl_xor(ss, 2); ss += __shfl_xor(ss, 4);
      const float rs = __builtin_amdgcn_rsqf(ss * (1.f / 256.f) + RMS_EPS) * (1.f - LAMBDA_INIT);
#pragma unroll
      for (int half = 0; half < 2; ++half)
#pragma unroll
          for (int q = 0; q < 4; ++q) { const f32x4 g = *(const f32x4*)(A.subln + 128 * half + 16 * j8 + 4 * q);
#pragma unroll
              for (int i = 0; i < 4; ++i) an[16 * half + 4 * q + i] *= rs * g[i]; } }
#pragma unroll
    for (int hi2 = 0; hi2 < 2; ++hi2) {
        const int hh = 2 * hp + hi2, bh = b * 16 + hh;
        const int k = tid & 127, sq = tid >> 7;
        const size_t row0 = ((size_t)bh * PKV + 64 * c + 16 * sq) * 128 + k;
        float g[16], qv[16], kv[16]; unsigned vv[16];
#pragma unroll
        for (int i = 0; i < 16; ++i) { g[i] = bf2f(A.HG[row0 + i * 128]); qv[i] = bf2f(A.HQ[row0 + i * 128]); kv[i] = bf2f(A.HK[row0 + i * 128]); vv[i] = A.HV[row0 + i * 128]; }
        v4u sp[4];
        { const bf16* sp0 = A.DS + ((size_t)bh * NCHK + (c - 1)) * 16384;
#pragma unroll
          for (int j = 0; j < 4; ++j) sp[j] = *(const v4u*)(sp0 + (size_t)(tid + 512 * j) * 8); }
        float run = 0.f;
#pragma unroll
        for (int i = 0; i < 16; ++i) { run += g[i]; g[i] = run; }
        part[sq * 128 + k] = run;
        *(lv4u*)(AT + t8 * 72 + 8 * j8) = (v4u){0u, 0u, 0u, 0u};
        __syncthreads();
        float E[4];
        { float s = 0.f;
#pragma unroll
          for (int j = 0; j < 4; ++j) { s += part[j * 128 + k]; E[j] = s; } }
        const float off = sq == 0 ? 0.f : sq == 1 ? E[0] : sq == 2 ? E[1] : E[2];
#pragma unroll
        for (int i = 0; i < 16; ++i) { const int t = 16 * sq + i;
            QI[t * 136 + k] = (bf16)f2bf(qv[i] * __expf(off + g[i]));
            QR[t * 136 + k] = (bf16)f2bf(qv[i] * __expf(g[i])); }
#pragma unroll
        for (int ip = 0; ip < 4; ++ip) if (ip >= sq) {
            const float ep = ip == 0 ? 0.f : E[ip - 1]; const int rb = ip == 0 ? 0 : ip == 1 ? 16 : ip == 2 ? 48 : 96;
#pragma unroll
            for (int i = 0; i < 16; ++i) KR[(rb + 16 * sq + i) * 136 + k] = (bf16)f2bf(kv[i] * __expf(ep - off - g[i])); }
        { unsigned vw[8];
#pragma unroll
          for (int i = 0; i < 8; ++i) vw[i] = vv[2 * i] | (vv[2 * i + 1] << 16);
          *(lv4u*)(VT + k * 72 + 16 * sq) = (v4u){vw[0], vw[1], vw[2], vw[3]}; *(lv4u*)(VT + k * 72 + 16 * sq + 8) = (v4u){vw[4], vw[5], vw[6], vw[7]}; }
#pragma unroll
        for (int j = 0; j < 4; ++j) { const int q4 = tid + 512 * j; *(lv4u*)(ST + (q4 >> 4) * 136 + (q4 & 15) * 8) = sp[j]; }
        __syncthreads();
#pragma unroll
        for (int rep = 0; rep < 2; ++rep) { const int tl = w + 8 * rep;
            if (tl < 10) { const int ip = tl >= 6 ? 3 : tl >= 3 ? 2 : tl >= 1 ? 1 : 0, jp = tl - (ip == 3 ? 6 : ip == 2 ? 3 : ip == 1 ? 1 : 0), rb = ip == 0 ? 0 : ip == 1 ? 16 : ip == 2 ? 48 : 96;
                const int r = lane & 15, q = lane >> 4; f32x4 sa = {0.f, 0.f, 0.f, 0.f};
#pragma unroll
                for (int ks = 0; ks < 4; ++ks) { const bf16x8 av = *(const lbf8*)(QR + (16 * ip + r) * 136 + 32 * ks + 8 * q), bv = *(const lbf8*)(KR + (rb + 16 * jp + r) * 136 + 32 * ks + 8 * q); sa = MFMA16(av, bv, sa); }
#pragma unroll
                for (int i = 0; i < 4; ++i) { const float val = (jp == ip && r > 4 * q + i) ? 0.f : sa[i]; AT[(16 * ip + 4 * q + i) * 72 + 16 * jp + r] = (bf16)f2bf(val); } } }
        __syncthreads();
        { const int t0 = 32 * (w & 1), v0 = 32 * (w >> 1), li = lane & 31, hi = lane >> 5; f32x16 o = {};
#pragma unroll
          for (int ks = 0; ks < 8; ++ks) o = MFMA32(*(const lbf8*)(QI + (t0 + li) * 136 + 16 * ks + 8 * hi), *(const lbf8*)(ST + (v0 + li) * 136 + 16 * ks + 8 * hi), o);
#pragma unroll
          for (int ks = 0; ks < 4; ++ks) o = MFMA32(*(const lbf8*)(AT + (t0 + li) * 72 + 16 * ks + 8 * hi), *(const lbf8*)(VT + (v0 + li) * 72 + 16 * ks + 8 * hi), o);
#pragma unroll
          for (int r = 0; r < 16; ++r) OT[(t0 + crow32(r, hi)) * 132 + v0 + li] = o[r]; }
        __syncthreads();
        { f32x4 ov[4]; float ss = 0.f;
#pragma unroll
          for (int q = 0; q < 4; ++q) { ov[q] = *(const LAS f32x4*)(OT + t8 * 132 + 16 * j8 + 4 * q); ss += (ov[q][0] * ov[q][0] + ov[q][1] * ov[q][1]) + (ov[q][2] * ov[q][2] + ov[q][3] * ov[q][3]); }
          ss += __shfl_xor(ss, 1); ss += __shfl_xor(ss, 2); ss += __shfl_xor(ss, 4);
          const float rs = __builtin_amdgcn_rsqf(ss * (1.f / 128.f) + RMS_EPS);
          const size_t idx = m * DM + 256 * hp + 128 * hi2 + 16 * j8;
          const v4u og0 = *(const v4u*)(A.OG + idx), og1 = *(const v4u*)(A.OG + idx + 8), ga0 = *(const v4u*)(A.GA + idx), ga1 = *(const v4u*)(A.GA + idx + 8), gh0 = *(const v4u*)(A.GH + idx), gh1 = *(const v4u*)(A.GH + idx + 8);
          const unsigned ogs[8] = {og0.x, og0.y, og0.z, og0.w, og1.x, og1.y, og1.z, og1.w}, gas[8] = {ga0.x, ga0.y, ga0.z, ga0.w, ga1.x, ga1.y, ga1.z, ga1.w}, ghs[8] = {gh0.x, gh0.y, gh0.z, gh0.w, gh1.x, gh1.y, gh1.z, gh1.w};
          unsigned yw[8];
#pragma unroll
          for (int i = 0; i < 8; ++i) { const f32x4 gn = *(const f32x4*)(A.hgn + 16 * j8 + 4 * (i >> 1));
              const float o0 = ov[i >> 1][(2 * i) & 3] * rs * gn[(2 * i) & 3], o1 = ov[i >> 1][(2 * i + 1) & 3] * rs * gn[(2 * i + 1) & 3];
              const float y0 = bf_lo(gas[i]) * an[16 * hi2 + 2 * i] + bf_lo(ghs[i]) * o0 * bf_lo(ogs[i]), y1 = bf_hi(gas[i]) * an[16 * hi2 + 2 * i + 1] + bf_hi(ghs[i]) * o1 * bf_hi(ogs[i]);
              yw[i] = pk2(y0, y1); }
          *(v4u*)(A.Y + idx) = (v4u){yw[0], yw[1], yw[2], yw[3]}; *(v4u*)(A.Y + idx + 8) = (v4u){yw[4], yw[5], yw[6], yw[7]}; }
        __syncthreads();
    }
}

struct P6Args { const float *h2, *norm2, *router_b; const bf16* WR; bf16* HG2; float* rstd2; int *assign_e, *assign_rank; float* assign_gate; unsigned* gcnt; };
__device__ __forceinline__ void p6_router(const P6Args& A, LAS unsigned char* ctrl, int vcu, int G, int tid) {
    LAS unsigned* lcount = (LAS unsigned*)(ctrl + 512); LAS unsigned* lbase = (LAS unsigned*)(ctrl + 640);
    const int lane = tid & 63, w = __builtin_amdgcn_readfirstlane(tid >> 6), r = lane & 15, q = lane >> 4;
    if (vcu == 0 && tid < 256) *(v4u*)(A.HG2 + (size_t)MTOK * DM + tid * 8) = (v4u){0u, 0u, 0u, 0u};
    for (int grp = vcu; grp < MTOK / 128; grp += G) {
        if (tid < 32) lcount[tid] = 0u;
        __syncthreads();
        const int m0 = grp * 128 + w * 16; const size_t rowoff = (size_t)(m0 + r) * DM;
        f32x4 acc0 = {0.f, 0.f, 0.f, 0.f}, acc1 = {0.f, 0.f, 0.f, 0.f}; float ss = 0.f;
#pragma unroll 4
        for (int ks = 0; ks < 64; ++ks) { const int k = 32 * ks + 8 * q;
            const f32x4 h0 = *(const f32x4*)(A.h2 + rowoff + k), h1 = *(const f32x4*)(A.h2 + rowoff + k + 4), g0 = *(const f32x4*)(A.norm2 + k), g1 = *(const f32x4*)(A.norm2 + k + 4);
            const bf16x8 b0 = *(const bf16x8*)(A.WR + (size_t)r * DM + k), b1 = *(const bf16x8*)(A.WR + (size_t)(16 + r) * DM + k);
            ss += (h0[0] * h0[0] + h0[1] * h0[1]) + (h0[2] * h0[2] + h0[3] * h0[3]) + (h1[0] * h1[0] + h1[1] * h1[1]) + (h1[2] * h1[2] + h1[3] * h1[3]);
            const v4u xw = {pk2(h0[0] * g0[0], h0[1] * g0[1]), pk2(h0[2] * g0[2], h0[3] * g0[3]), pk2(h1[0] * g1[0], h1[1] * g1[1]), pk2(h1[2] * g1[2], h1[3] * g1[3])};
            *(v4u*)(A.HG2 + rowoff + k) = xw;
            const bf16x8 xa = __builtin_bit_cast(bf16x8, xw);
            acc0 = MFMA16(b0, xa, acc0); acc1 = MFMA16(b1, xa, acc1); }
        ss += __shfl_xor(ss, 16); ss += __shfl_xor(ss, 32);
        const float rs = __builtin_amdgcn_rsqf(ss * (1.f / DM) + RMS_EPS);
        if (q == 0) A.rstd2[m0 + r] = rs;
        float l[8];
        { const f32x4 rb0 = *(const f32x4*)(A.router_b + 4 * q), rb1 = *(const f32x4*)(A.router_b + 16 + 4 * q);
#pragma unroll
          for (int i = 0; i < 4; ++i) { l[i] = acc0[i] * rs + rb0[i]; l[4 + i] = acc1[i] * rs + rb1[i]; } }
        unsigned used = 0u; float tv[4]; int te[4];
#pragma unroll
        for (int kk = 0; kk < 4; ++kk) {
            float bv = -__builtin_inff(); int be = 64;
#pragma unroll
            for (int j = 0; j < 8; ++j) { const int ej = (j < 4 ? 0 : 16) + 4 * q + (j & 3); const bool ok = !((used >> j) & 1u) && l[j] > bv; bv = ok ? l[j] : bv; be = ok ? ej : be; }
#pragma unroll
            for (int o = 16; o <= 32; o <<= 1) { const float ov = __shfl_xor(bv, o); const int oe = __shfl_xor(be, o); const bool tk = ov > bv || (ov == bv && oe < be); bv = tk ? ov : bv; be = tk ? oe : be; }
            tv[kk] = bv; te[kk] = be;
            if (((be & 15) >> 2) == q) used |= 1u << (((be >> 4) << 2) + (be & 3));
        }
        const float e1 = __expf(tv[1] - tv[0]), e2 = __expf(tv[2] - tv[0]), e3 = __expf(tv[3] - tv[0]), inv = 1.f / (1.f + e1 + e2 + e3);
        const int es = q == 0 ? te[0] : q == 1 ? te[1] : q == 2 ? te[2] : te[3];
        const float gs = (q == 0 ? 1.f : q == 1 ? e1 : q == 2 ? e2 : e3) * inv;
        const unsigned lrank = __hip_atomic_fetch_add((unsigned*)(lcount + es), 1u, __ATOMIC_RELAXED, __HIP_MEMORY_SCOPE_WORKGROUP);
        __syncthreads();
        if (tid < 32) lbase[tid] = __hip_atomic_fetch_add(A.gcnt + tid, (unsigned)lcount[tid], __ATOMIC_RELAXED, __HIP_MEMORY_SCOPE_AGENT);
        __syncthreads();
        const int a = (m0 + r) * 4 + q;
        A.assign_e[a] = es; A.assign_rank[a] = (int)(lbase[es] + lrank); A.assign_gate[a] = gs;
        __syncthreads();
    }
}
__device__ __forceinline__ void moe_tstart(const unsigned* gcnt, LAS int* tstart, int tid) {
    if (tid == 0) { int s = 0;
        for (int e = 0; e < NE; ++e) { tstart[e] = s; s += (int)((__hip_atomic_load(gcnt + e, __ATOMIC_RELAXED, __HIP_MEMORY_SCOPE_AGENT) + 255u) >> 8); }
        tstart[NE] = s; }
    __syncthreads();
}

namespace att {
struct Tensors { const bf16* Q; const bf16* K; const bf16* V; bf16* O; const float* bt; };
__device__ __forceinline__ BlockRef<bf16, bf16> mkref(const Tensors& T, int id, int pass) {
    const int grp = id >> 6, w = id & 63, b = grp >> 3, h = grp & 7, sub = w >> 4, map = sub >> 1, half = sub & 1, y = w & 15, qb = pass ? 31 - y : y;
    BlockRef<bf16, bf16> r;
    r.Q = T.Q + ((size_t)(b * 16 + 2 * h + map) * SEQ_ + (size_t)qb * QB) * D;
    r.K = T.K + (size_t)(b * 16 + 2 * h + map) * PKV_ * D;
    r.V = T.V + (size_t)(b * 16 + 2 * h + half) * PKV_ * D;
    r.O = T.O + ((size_t)(b * 32 + (2 * h + map) * 2 + half) * SEQ_ + (size_t)qb * QB) * D;
    r.P0 = 64 + qb * QB; r.bt = T.bt + h * BT_LEN;
    return r;
}
__device__ __forceinline__ int item_id(int i, int c, int G) {
    if (G == 256) return i < 8 ? (c & 7) * 256 + i * 32 + (c >> 3) : -1;
    const long L = (long)i * G + c; return L < 2048 ? (int)L : -1;
}
__device__ __forceinline__ void attn_phase(char* lds, const Tensors& T, int G, int c) {
    constexpr int W = 1 << 30;
    int i = 0, id = item_id(0, c, G); if (id < 0) return;
    int pass = 0;
    BlockRef<bf16, bf16> cur = mkref(T, id, 0);
    Seam<bf16> S;
    causal_swa_prime<bf16, bf16>(cur, W, lds, S);
    for (;;) {
        const int idn = item_id(i + 1, c, G);
        const bool more_pass = pass == 0, more_item = idn >= 0, last = !more_pass && !more_item;
        const BlockRef<bf16, bf16> nxt = last ? cur : (more_pass ? mkref(T, id, 1) : mkref(T, idn, 0));
        causal_swa_block<bf16, bf16>(cur, nxt, PKV_, W, lds, S);
        if (last) break;
        cur = nxt; if (more_pass) pass = 1; else { pass = 0; id = idn; ++i; }
    }
}
}

struct Args { const float* in[19]; float* out; unsigned char* ws; int ph_lo, ph_hi, li, pad; };
#define ARG(k) argp(args, k)
__device__ __forceinline__ unsigned char* wsp(const Args& a) { int k = 0; asm volatile("" : "+s"(k)); return (&a.ws)[k]; }
__device__ __forceinline__ float* outp(const Args& a) { int k = 0; asm volatile("" : "+s"(k)); return (&a.out)[k]; }
__device__ __forceinline__ const float* argp(const Args& a, int k) { asm volatile("" : "+s"(k)); return a.in[k]; }
__global__ void __launch_bounds__(NTHR, 2) hyb_fwd(Args args) {
    extern __shared__ __attribute__((aligned(16))) unsigned char lds_raw[];
    LAS unsigned char* lds = (LAS unsigned char*)lds_raw;
    const int G = gridDim.x, bx = blockIdx.x;
    { unsigned char* ws0 = args.ws;
      int t0_ = threadIdx.x; asm volatile("" : "+v"(t0_));
      for (int u = t0_; u < (LDS_BYTES - CTRL_OFF) / 4; u += NTHR) ((LAS unsigned*)(lds + CTRL_OFF))[u] = 0u;
      __syncthreads(); (void)ws0; }
    XcdBarrier bar; bar.bar = (unsigned*)(args.ws + WS_CTL) + CW_BAR; bar.x = 0; bar.st = nullptr;
    if (N_LAUNCHES == 1) bar = xcd_barrier_post((unsigned*)(args.ws + WS_CTL) + CW_BAR, (volatile LAS unsigned*)(lds + CTRL_OFF));
#define GRID_BAR() do { if (N_LAUNCHES == 1) xcd_barrier(bar); } while (0)
    const int lo = args.ph_lo, hi = args.ph_hi;
#ifndef PH_MASK
#define PH_MASK 0x7ff
#endif
#define IN(k) (((PH_MASK >> (k)) & 1) && lo <= (k) && (k) < hi)
#define BOTH(k) (IN(k) && IN((k) + 1))
#define PHASE_LOCALS() int tid_ = threadIdx.x; asm volatile("" : "+v"(tid_)); const int tid = tid_, lane = tid & 63, wave = __builtin_amdgcn_readfirstlane(tid >> 6); (void)lane; (void)wave; \
    const int vcu = (G % 8 == 0) ? (bx % 8) * (G / 8) + bx / 8 : bx; (void)vcu; unsigned char* ws = wsp(args); (void)ws; \
    const int gw = vcu * NWAVES + wave, NGW = G * NWAVES; const long gid = (long)vcu * NTHR + tid, NG = (long)G * NTHR; (void)gw; (void)NGW; (void)gid; (void)NG
#define QH ((bf16*)(ws + WS_QH))
#define KH ((bf16*)(ws + WS_KH))
#define VH ((bf16*)(ws + WS_VH))
#define HQ ((bf16*)(ws + WS_HQ))
#define HK ((bf16*)(ws + WS_HK))
#define HGT ((bf16*)(ws + WS_HGT))
#define HV ((bf16*)(ws + WS_HV))
#define OG ((bf16*)(ws + WS_OG))
#define GA ((bf16*)(ws + WS_GA))
#define GH ((bf16*)(ws + WS_GH))
#define OP ((bf16*)(ws + WS_OP))
#define DS ((bf16*)(ws + WS_DS))
#define DEC ((float*)(ws + WS_DEC))
#define GCNT ((unsigned*)(ws + WS_CTL) + CW_CNT)
#define TSTART ((LAS int*)(lds + CTRL_OFF + 256))
#define OUTP outp(args)

    if (IN(0)) { PHASE_LOCALS();
        P0Args a{ARG(0), ARG(1), ARG(2), ARG(3), ARG(4), ARG(5), ARG(8), ARG(11), ARG(13), ARG(15), ARG(17), ws};
        p0_prologue(a, lds, vcu, G, tid);
        if (BOTH(0)) GRID_BAR();
    }
    if (IN(1)) { PHASE_LOCALS();
        SchedInProj S{G, bx, (const bf16*)(ws + WS_WIN)};
        EpiInProj E{ws, ARG(6), ARG(7), (const float*)(ws + SM_LB), (LAS float*)(lds + XCH_OFF)};
        pg8::gemm_phase<EpiInProj, SchedInProj, false>(lds, (const bf16*)(ws + WS_U), DM, S, E);
        if (BOTH(1)) GRID_BAR();
    }
    if (IN(2)) { PHASE_LOCALS();
        for (int u = vcu; u < 64 * NCHK; u += G) hgrn_a_unit(u / NCHK, u % NCHK, HK, HGT, HV, DS, DEC, lds, tid);
        const att::Tensors T{QH, KH, VH, OP, (const float*)(ws + SM_BT)};
        att::attn_phase((char*)lds_raw, T, G, bx);
        if (BOTH(2)) GRID_BAR();
    }
    if (IN(3)) { PHASE_LOCALS(); hgrn_b_scan(DS, DEC, gid, NG); if (BOTH(3)) GRID_BAR(); }
    if (IN(4)) { PHASE_LOCALS();
        const HcArgs A{HQ, HK, HGT, HV, DS, OP, OG, GA, GH, (bf16*)(ws + WS_Y), ARG(9), ARG(10), *(const float*)(ws + SM_LAM)};
        for (int u = vcu; u < NB * NCHK * 8; u += G) { const int hp = u & 7, c = ((u >> 3) % NCHK) + 1, b = (u >> 3) / NCHK; hgrn_c_unit(A, b, c, hp, lds, tid); }
        if (BOTH(4)) GRID_BAR();
    }
    if (IN(5)) { PHASE_LOCALS();
        SchedPlain S{G, bx, MTOK / 256, DM / 256, (const bf16*)(ws + WS_WOUT)};
        EpiOutProj E{ARG(0), OUTP};
        pg8::gemm_phase<EpiOutProj, SchedPlain, false>(lds, (const bf16*)(ws + WS_Y), DM, S, E);
        if (BOTH(5)) GRID_BAR();
    }
    if (IN(6)) { PHASE_LOCALS();
        const P6Args A{OUTP, ARG(12), ARG(14), (const bf16*)(ws + WS_WR), (bf16*)(ws + WS_HG2), (float*)(ws + SM_RSTD), (int*)(ws + SM_AE), (int*)(ws + SM_AR), (float*)(ws + SM_AG), GCNT};
        p6_router(A, lds + CTRL_OFF, vcu, G, tid);
        if (BOTH(6)) GRID_BAR();
    }
    if (IN(7)) { PHASE_LOCALS();
        moe_tstart(GCNT, TSTART, tid);
        const int* ae = (const int*)(ws + SM_AE); const int* ar = (const int*)(ws + SM_AR); const float* ag = (const float*)(ws + SM_AG); const float* rstd2 = (const float*)(ws + SM_RSTD);
        int* slot_tok = (int*)(ws + SM_ST); float* slot_rstd = (float*)(ws + SM_SR); float* slot_gate = (float*)(ws + SM_SG); int* tok_slot = (int*)(ws + SM_TS);
        for (long a = gid; a < NASSIGN; a += NG) { const int e = ae[a], slot = TSTART[e] * 256 + ar[a], t = (int)(a >> 2);
            slot_tok[slot] = t; slot_rstd[slot] = rstd2[t]; slot_gate[slot] = ag[a]; tok_slot[a] = slot; }
        if (BOTH(7)) GRID_BAR();
    }
    if (IN(8)) { PHASE_LOCALS();
        moe_tstart(GCNT, TSTART, tid);
        SchedMoE S{G, bx, DFF / 128, TSTART, (const bf16*)(ws + WS_WGU), (size_t)2 * DFF * DM * 2, (const int*)(ws + SM_ST)};
        EpiGateUp E{ARG(16), (const float*)(ws + SM_SR), (bf16*)(ws + WS_ACT)};
        pg8::gemm_phase<EpiGateUp, SchedMoE, true>(lds, (const bf16*)(ws + WS_HG2), DM, S, E);
        if (BOTH(8)) GRID_BAR();
    }
    if (IN(9)) { PHASE_LOCALS();
        moe_tstart(GCNT, TSTART, tid);
        SchedMoE S{G, bx, DM / 256, TSTART, (const bf16*)(ws + WS_WDN), (size_t)DM * DFF * 2, nullptr};
        EpiDown E{ARG(18), (const float*)(ws + SM_SG), (bf16*)(ws + WS_YS)};
        pg8::gemm_phase<EpiDown, SchedMoE, false>(lds, (const bf16*)(ws + WS_ACT), DFF, S, E);
        if (BOTH(9)) GRID_BAR();
    }
    if (IN(10)) { PHASE_LOCALS();
        const int* tok_slot = (const int*)(ws + SM_TS); const bf16* YS = (const bf16*)(ws + WS_YS);
        float* out = OUTP;
        for (int m = gw; m < MTOK; m += NGW) {
            const int s0 = tok_slot[4 * m], s1 = tok_slot[4 * m + 1], s2 = tok_slot[4 * m + 2], s3 = tok_slot[4 * m + 3];
#pragma unroll
            for (int j = 0; j < 4; ++j) { const int col = lane * 8 + 512 * j; float* op = out + (size_t)m * DM + col;
                f32x4 o0 = *(const f32x4*)op, o1 = *(const f32x4*)(op + 4);
                const v4u y0 = *(const v4u*)(YS + (size_t)s0 * DM + col), y1 = *(const v4u*)(YS + (size_t)s1 * DM + col), y2 = *(const v4u*)(YS + (size_t)s2 * DM + col), y3 = *(const v4u*)(YS + (size_t)s3 * DM + col);
#define ADDY(Q_) do { o0[0] += bf_lo(Q_.x); o0[1] += bf_hi(Q_.x); o0[2] += bf_lo(Q_.y); o0[3] += bf_hi(Q_.y); o1[0] += bf_lo(Q_.z); o1[1] += bf_hi(Q_.z); o1[2] += bf_lo(Q_.w); o1[3] += bf_hi(Q_.w); } while (0)
                ADDY(y0); ADDY(y1); ADDY(y2); ADDY(y3);
#undef ADDY
                *(f32x4*)op = o0; *(f32x4*)(op + 4) = o1; }
        }
    }
#undef IN
#undef BOTH
#undef GRID_BAR
}


#ifdef DBG_DUMP
__global__ void dbg_dump(const unsigned char* ws, float* out, unsigned mask) {
    const size_t offs[16] = {WS_U, WS_WIN, WS_QH, WS_KH, WS_VH, WS_HQ, WS_HK, WS_HGT, WS_HV, WS_OG, WS_GA, WS_GH, WS_OP, WS_DS, WS_Y, WS_WOUT};
    for (size_t i = (size_t)blockIdx.x * blockDim.x + threadIdx.x; i < (size_t)MTOK * DM; i += (size_t)gridDim.x * blockDim.x) {
        float s = 0.f;
        for (int b = 0; b < 16; ++b) if ((mask >> b) & 1u) { size_t j = i; if (b == 15) j = i & (size_t)(DM * DM - 1); if (b == 12 || b == 13) j = i * 2 + ((mask >> 16) & 1u); s += bf2f(((const bf16*)(ws + offs[b]))[j]); }
        out[i] = s;
    }
}
#endif
#ifndef DBG_NLAUNCH
#define DBG_NLAUNCH NPHASE
#endif
extern "C" void kernel_launch(void* const* d_in, const int* in_sizes, int n_in, void* d_out, int out_size, void* d_ws, size_t ws_size, hipStream_t stream) {
    static int grid = 0;
    if (grid == 0) {
        if (n_in != 19 || in_sizes[0] != MTOK * DM || out_size != MTOK * DM || ws_size < WS_END) { fprintf(stderr, "kernel_launch: unexpected shapes (n_in %d, in0 %d, out %d, ws %zu < %zu); nothing launched\n", n_in, n_in > 0 ? in_sizes[0] : -1, out_size, ws_size, (size_t)WS_END); grid = -1; return; }
        int dev = 0, cus = 0, per_cu = 0;
        if (hipGetDevice(&dev) != hipSuccess || hipDeviceGetAttribute(&cus, hipDeviceAttributeMultiprocessorCount, dev) != hipSuccess) { fprintf(stderr, "kernel_launch: device query failed\n"); grid = -1; return; }
        if (hipFuncSetAttribute((const void*)hyb_fwd, hipFuncAttributeMaxDynamicSharedMemorySize, LDS_BYTES) != hipSuccess) { fprintf(stderr, "kernel_launch: hipFuncSetAttribute(%d) failed\n", LDS_BYTES); grid = -1; return; }
        if (hipOccupancyMaxActiveBlocksPerMultiprocessor(&per_cu, (const void*)hyb_fwd, NTHR, LDS_BYTES) != hipSuccess || per_cu < 1) { fprintf(stderr, "kernel_launch: occupancy query says %d workgroups per CU\n", per_cu); (void)hipGetLastError(); if (per_cu < 1) { grid = -1; return; } }
        grid = cus;
    }
    if (grid < 0) return;
    if (hipMemsetAsync((char*)d_ws + WS_CTL, 0, CTL_ZERO_BYTES, stream) != hipSuccess) { fprintf(stderr, "kernel_launch: memset failed\n"); return; }
    Args a{};
    for (int i = 0; i < 19; ++i) a.in[i] = (const float*)d_in[i];
    a.out = (float*)d_out; a.ws = (unsigned char*)d_ws;
    for (int li = 0; li < (N_LAUNCHES == 1 ? 1 : DBG_NLAUNCH); ++li) {
        a.ph_lo = (N_LAUNCHES == 1) ? 0 : li; a.ph_hi = (N_LAUNCHES == 1) ? NPHASE : li + 1; a.li = li; a.pad = 0;
        hipLaunchKernelGGL(hyb_fwd, dim3(grid), dim3(NTHR), LDS_BYTES, stream, a);
        const hipError_t le = hipPeekAtLastError();
        if (le != hipSuccess) { fprintf(stderr, "kernel_launch: launch %d failed: %s\n", li, hipGetErrorName(le)); break; }
    }
#ifdef DBG_DUMP
    hipLaunchKernelGGL(dbg_dump, dim3(2048), dim3(256), 0, stream, (const unsigned char*)d_ws, (float*)d_out, (unsigned)DBG_DUMP);
#endif
}
```

```cpp
#include <hip/hip_runtime.h>
#include <cstdio>
#include <cstdint>

namespace pg8 {
#define PG8_LAS __attribute__((address_space(3)))
typedef unsigned short bf16_t;
typedef short bf16x8 __attribute__((ext_vector_type(8)));
typedef float f32x4 __attribute__((ext_vector_type(4)));
typedef unsigned u32x4 __attribute__((ext_vector_type(4)));
constexpr int BM = 256, BK = 64, HALF = 128, HTB = HALF * BK * 2  , STAGE_BYTES = 8 * HTB;

__host__ __device__ __forceinline__ int lds_byte(int r, int c) { const int st = (r >> 4) * 2 + (c >> 5), rr = r & 15, cc = c & 31, ob = rr * 64 + cc * 2; return st * 1024 + (ob ^ (((ob >> 9) & 1) << 5)); }
__host__ __device__ __forceinline__ void stage_rc(int b, int& R, int& C) { const int st = b / 1024, sb = b % 1024, swz = sb ^ (((sb >> 9) & 1) << 5); R = (st >> 1) * 16 + swz / 64; C = (st & 1) * 32 + (swz % 64) / 2; }
__host__ __device__ __forceinline__ int perm32(int rho) { const int n = rho >> 4, i = rho & 15; return 8 * (i >> 2) + 4 * n + (i & 3); }

struct Unit { int pm, pn, e, aux; };

__device__ __forceinline__ unsigned cvt_pk_bf16(float lo, float hi) { unsigned r; asm volatile("v_cvt_pk_bf16_f32 %0, %1, %2" : "=v"(r) : "v"(lo), "v"(hi)); return r; }

typedef int i32x4 __attribute__((ext_vector_type(4)));
typedef int i32x8 __attribute__((ext_vector_type(8)));
template <class Epi, class Sched, bool GATHER, bool FP8 = false>
__device__ __forceinline__ void gemm_phase(PG8_LAS unsigned char* lds, const bf16_t* Abase, const int K, const Sched& S, const Epi& E) {
    const int tid = threadIdx.x, wid = __builtin_amdgcn_readfirstlane(tid >> 6), lane = tid & 63, wr = wid >> 2, wc = wid & 3, fr = lane & 15, fq = lane >> 4;
    const int nt = K / BK;
    int Rr[2]; unsigned cb[2], voffB[2], voffA[2];
#pragma unroll
    for (int i = 0; i < 2; ++i) { int R, C; stage_rc(tid * 16 + i * 8192, R, C); const int Rb = Epi::PERM ? ((R & ~31) + perm32(R & 31)) : R;
        Rr[i] = R; cb[i] = (unsigned)C * 2u; voffB[i] = (unsigned)(Rb * K + C) * 2u; voffA[i] = (unsigned)(R * K + C) * 2u; }
    const unsigned rowB = (unsigned)K * 2u;
    const size_t kstep = (size_t)(BK * 2);
    const size_t hstep = (size_t)HALF * K * 2;
    const unsigned ldsw = (unsigned)wid * 1024u;
    const int aoff = lds_byte(wr * 64 + fr, fq * 8), boff = lds_byte(wc * 32 + fr, fq * 8);
#define PG8_SA(b, h) (((b) * 2 + (h)) * HTB)
#define PG8_SB(b, h) ((4 + (b) * 2 + (h)) * HTB)
#define PG8_STAGE(bufoff, gbase, voff) do { _Pragma("unroll") for (int _i = 0; _i < 2; ++_i) \
        __builtin_amdgcn_global_load_lds((const unsigned*)((const char*)(gbase) + (voff)[_i]), (PG8_LAS unsigned*)(lds + (bufoff) + ldsw + _i * 8192), 16, 0, 0); } while (0)
#define PG8_LD8(off) __builtin_shufflevector(*(const PG8_LAS i32x4*)(lds + (off)), *(const PG8_LAS i32x4*)(lds + (off) + 1024), 0, 1, 2, 3, 4, 5, 6, 7)
#define PG8_LDA(dst, b, h) do { _Pragma("unroll") for (int m = 0; m < 4; ++m) { if constexpr (FP8) dst##8[m] = PG8_LD8(PG8_SA(b, h) + aoff + m * 2048); else { _Pragma("unroll") for (int k = 0; k < 2; ++k) dst[m][k] = *(const PG8_LAS bf16x8*)(lds + PG8_SA(b, h) + aoff + m * 2048 + k * 1024); } } } while (0)
#define PG8_LDB(dst, b, h) do { _Pragma("unroll") for (int n = 0; n < 2; ++n) { if constexpr (FP8) dst##8[n] = PG8_LD8(PG8_SB(b, h) + boff + n * 2048); else { _Pragma("unroll") for (int k = 0; k < 2; ++k) dst[n][k] = *(const PG8_LAS bf16x8*)(lds + PG8_SB(b, h) + boff + n * 2048 + k * 1024); } } } while (0)
#define PG8_MMA(ai, bj, At, Bt) do { __builtin_amdgcn_s_setprio(1); _Pragma("unroll") for (int m = 0; m < 4; ++m) _Pragma("unroll") for (int n = 0; n < 2; ++n) { \
        if constexpr (FP8) asm volatile("v_mfma_scale_f32_16x16x128_f8f6f4 %0, %1, %2, %0, %3, %3 op_sel_hi:[0,0,0]" : "+v"(acc[ai][bj][m][n]) : "v"(Bt##8[n]), "v"(At##8[m]), "v"(sc8)); \
        else { _Pragma("unroll") for (int k = 0; k < 2; ++k) acc[ai][bj][m][n] = __builtin_amdgcn_mfma_f32_16x16x32_bf16(Bt[n][k], At[m][k], acc[ai][bj][m][n], 0, 0, 0); } } __builtin_amdgcn_s_setprio(0); } while (0)
#define PG8_WAIT_V(n) asm volatile("s_waitcnt vmcnt(" #n ")" ::: "memory")
#define PG8_WAIT_L(n) asm volatile("s_waitcnt lgkmcnt(" #n ")" ::: "memory")
#define PG8_BAR __builtin_amdgcn_s_barrier()
#define PG8_SCHED __builtin_amdgcn_sched_barrier(0)
#define PG8_VA(dst, u) do { if constexpr (GATHER) { _Pragma("unroll") for (int _h = 0; _h < 2; ++_h) _Pragma("unroll") for (int _i = 0; _i < 2; ++_i) dst[_h][_i] = S.arow(u, _h * HALF + Rr[_i]) * rowB + cb[_i]; } } while (0)
#define PG8_STAGE_A(bufoff, h, base, vsel) do { if constexpr (GATHER) PG8_STAGE(bufoff, base, vsel[h]); else PG8_STAGE(bufoff, (base) + (h) * hstep, voffA); } while (0)
    Unit cur, nxt; int ui = 0;
    if (!S.next(0, cur)) return;
    f32x4 acc[2][2][4][2];
#pragma unroll
    for (int a = 0; a < 2; ++a)
#pragma unroll
        for (int b = 0; b < 2; ++b)
#pragma unroll
            for (int m = 0; m < 4; ++m)
#pragma unroll
                for (int n = 0; n < 2; ++n) acc[a][b][m][n] = (f32x4){0.f, 0.f, 0.f, 0.f};
    int sc8 = 0x7f7f7f7f; asm volatile("" : "+v"(sc8));
    bf16x8 At[4][2], B0[2][2], B1[2][2]; i32x8 At8[4], B08[2], B18[2];
    unsigned vAc[2][2], vAn[2][2];
    PG8_VA(vAc, cur);
    const char* cA = GATHER ? (const char*)Abase : (const char*)Abase + (size_t)S.arow(cur, 0) * rowB; const char* cB = S.bptr(cur);
    PG8_STAGE(PG8_SB(0, 0), cB, voffB); PG8_STAGE(PG8_SB(0, 1), cB + hstep, voffB); PG8_STAGE_A(PG8_SA(0, 0), 0, cA, vAc); PG8_STAGE_A(PG8_SA(0, 1), 1, cA, vAc);
    if (wr == 1) PG8_BAR;
    PG8_WAIT_V(2); PG8_BAR;
    PG8_STAGE(PG8_SB(1, 0), cB + kstep, voffB); PG8_STAGE_A(PG8_SA(1, 0), 0, cA + kstep, vAc); PG8_STAGE(PG8_SB(1, 1), cB + hstep + kstep, voffB);
    PG8_WAIT_V(6); PG8_BAR;
    for (;;) {
        const bool has_next = S.next(ui + 1, nxt);
        const char* nB = cB; const char* nA = cA;
        if (has_next) { nB = S.bptr(nxt); PG8_VA(vAn, nxt); if constexpr (!GATHER) nA = (const char*)Abase + (size_t)S.arow(nxt, 0) * rowB; }
        else if constexpr (GATHER) {
#pragma unroll
            for (int h = 0; h < 2; ++h)
#pragma unroll
                for (int i = 0; i < 2; ++i) vAn[h][i] = vAc[h][i];
        }
        for (int t = 0; t < nt; t += 2) {
            const bool last = (t == nt - 2);
            const char* a1 = cA + (size_t)(t + 1) * kstep;
            const char* a2 = last ? nA : cA + (size_t)(t + 2) * kstep; const char* b2 = last ? nB : cB + (size_t)(t + 2) * kstep;
            const char* a3 = a2 + kstep; const char* b3 = b2 + kstep;
            unsigned v2[2][2];
            if constexpr (GATHER) {
#pragma unroll
            for (int h = 0; h < 2; ++h)
#pragma unroll
                for (int i = 0; i < 2; ++i) v2[h][i] = last ? vAn[h][i] : vAc[h][i]; }
            PG8_LDB(B0, 0, 0); PG8_LDB(B1, 0, 1); PG8_SCHED; PG8_LDA(At, 0, 0); PG8_STAGE_A(PG8_SA(1, 1), 1, a1, vAc);
            PG8_WAIT_V(8); PG8_WAIT_L(0); PG8_BAR; PG8_MMA(0, 0, At, B0); PG8_MMA(0, 1, At, B1); PG8_BAR; PG8_SCHED;
            PG8_LDA(At, 0, 1); PG8_STAGE(PG8_SB(0, 0), b2, voffB); PG8_STAGE(PG8_SB(0, 1), b2 + hstep, voffB); PG8_STAGE_A(PG8_SA(0, 0), 0, a2, v2);
            PG8_WAIT_V(8); PG8_WAIT_L(0); PG8_BAR; PG8_MMA(1, 0, At, B0); PG8_MMA(1, 1, At, B1); PG8_BAR; PG8_SCHED;
            PG8_LDB(B0, 1, 0); PG8_LDB(B1, 1, 1); PG8_SCHED; PG8_LDA(At, 1, 0); PG8_STAGE_A(PG8_SA(0, 1), 1, a2, v2);
            PG8_WAIT_V(8); PG8_WAIT_L(0); PG8_BAR; PG8_MMA(0, 0, At, B0); PG8_MMA(0, 1, At, B1); PG8_BAR; PG8_SCHED;
            PG8_LDA(At, 1, 1); PG8_STAGE(PG8_SB(1, 0), b3, voffB); PG8_STAGE(PG8_SB(1, 1), b3 + hstep, voffB); PG8_STAGE_A(PG8_SA(1, 0), 0, a3, v2);
            PG8_WAIT_V(8); PG8_WAIT_L(0); PG8_BAR; PG8_MMA(1, 0, At, B0); PG8_MMA(1, 1, At, B1); PG8_BAR; PG8_SCHED;
        }
        if (wr == 0) PG8_BAR;
        if constexpr (FP8) asm volatile("s_nop 15\n\ts_nop 15" ::: "memory");
        E(acc, cur, wr, wc, fr, fq, wid, lane);
        if (!has_next) break;
#pragma unroll
        for (int a = 0; a < 2; ++a)
#pragma unroll
            for (int b = 0; b < 2; ++b)
#pragma unroll
                for (int m = 0; m < 4; ++m)
#pragma unroll
                    for (int n = 0; n < 2; ++n) acc[a][b][m][n] = (f32x4){0.f, 0.f, 0.f, 0.f};
        cur = nxt; cB = nB; cA = nA; ++ui;
        if constexpr (GATHER) {
#pragma unroll
        for (int h = 0; h < 2; ++h)
#pragma unroll
            for (int i = 0; i < 2; ++i) vAc[h][i] = vAn[h][i]; }
        if (wr == 1) PG8_BAR;
    }
    PG8_WAIT_V(0);
    PG8_BAR;
#undef PG8_SA
#undef PG8_SB
#undef PG8_STAGE
#undef PG8_LDA
#undef PG8_LDB
#undef PG8_MMA
#undef PG8_LD8
#undef PG8_WAIT_V
#undef PG8_WAIT_L
#undef PG8_BAR
#undef PG8_SCHED
#undef PG8_VA
#undef PG8_STAGE_A
}
}

namespace att {
constexpr int D = 128, SEQ_ = 8192, PKV_ = 8256;
constexpr float THR = 8.f;
constexpr bool WSKIP = false;
constexpr float SCALE = 0.08838834764831845f;
constexpr int NW = 8, QBLK = 32, KVBLK = 64, QB = NW * QBLK;
constexpr int SHM_V = KVBLK * D * 2, SHM_K = KVBLK * D * 2;
constexpr int LDS_BYTES = 2 * SHM_V + 2 * SHM_K + NW * 64 * 4;
constexpr int BT_LEN = 352, BT_OFF = 96;
typedef unsigned short bf16;
typedef short bf16x8 __attribute__((ext_vector_type(8)));
typedef short s16x4 __attribute__((ext_vector_type(4)));
typedef float f32x16 __attribute__((ext_vector_type(16)));
typedef float f32x4 __attribute__((ext_vector_type(4)));
typedef unsigned u32x4 __attribute__((ext_vector_type(4)));
template <class A, class Bt> struct same_t { static constexpr bool v = false; };
template <class A> struct same_t<A, A> { static constexpr bool v = true; };

#define KSWZ(row, colB) ((row) * 256 + ((colB) ^ (((row) & 7) << 4)))
#define SBAR() __builtin_amdgcn_sched_barrier(0)
__device__ __forceinline__ int v_st(int k, int c) { const int kk = (k & ~0xC) | ((k & 4) << 1) | ((k & 8) >> 1); return ((kk >> 3) * 4 + (c >> 5)) * 512 + ((kk & 7) * 32 + (c & 31)) * 2; }
__device__ __forceinline__ int v_rd_base(int lane) { return ((lane & 3) << 3) | (((lane >> 2) & 3) << 6) | (((lane >> 4) & 1) << 5) | (((lane >> 5) & 1) << 8); }
constexpr int v_rd_off(int d0, int ks, int half) { return d0 * 512 + ks * 4096 + half * 2048; }
__device__ __forceinline__ int crow(int r, int hi) { return (r & 3) + 8 * (r >> 2) + 4 * hi; }
__device__ __forceinline__ unsigned cvtpk(float lo, float hi) {
    unsigned r; asm volatile("v_cvt_pk_bf16_f32 %0, %1, %2" : "=v"(r) : "v"(lo), "v"(hi)); return r;
}
__device__ __forceinline__ bf16x8 pack8(f32x4 a, f32x4 b) {
    u32x4 w = {cvtpk(a[0], a[1]), cvtpk(a[2], a[3]), cvtpk(b[0], b[1]), cvtpk(b[2], b[3])};
    return *reinterpret_cast<bf16x8*>(&w);
}
template <class T> __device__ __forceinline__ bf16x8 load8(const T* p) {
    if constexpr (same_t<T, float>::v) { return pack8(*(const f32x4*)p, *(const f32x4*)(p + 4)); }
    else { return *reinterpret_cast<const bf16x8*>(p); }
}
__device__ __forceinline__ void mask_tile(f32x16& p0, f32x16& p1, int dq, unsigned W) {
    const float NEG = -__builtin_inff();
#pragma unroll
    for (int r = 0; r < 16; ++r) {
        const int c = (r & 3) + 8 * (r >> 2);
        if ((unsigned)(dq - c) >= W) p0[r] = NEG;
        if ((unsigned)(dq - c - 32) >= W) p1[r] = NEG;
    }
}
__device__ __forceinline__ void bias_tile(f32x16& p0, f32x16& p1, int dq, const float* __restrict__ tab) {
    const float* tb = tab + (dq + 96);
#pragma unroll
    for (int r = 0; r < 16; ++r) {
        const int c = (r & 3) + 8 * (r >> 2);
        p0[r] += tb[-c];
        p1[r] += tb[-c - 32];
    }
}
__device__ __forceinline__ void padmask_tile(f32x16& p0, f32x16& p1) {
    const float NEG = -__builtin_inff();
#pragma unroll
    for (int r = 0; r < 16; ++r) p0[r] = NEG;
#pragma unroll
    for (int r = 0; r < 8; ++r) p1[r] = NEG;
}
__device__ __forceinline__ void partialSM(f32x16& p0, f32x16& p1, float& m_reg, float& mn, float& alpha) {
    float pmax = p0[0]; for (int r = 1; r < 16; ++r) pmax = fmaxf(pmax, p0[r]); for (int r = 0; r < 16; ++r) pmax = fmaxf(pmax, p1[r]);
    { auto rr = __builtin_amdgcn_permlane32_swap(__float_as_uint(pmax), __float_as_uint(pmax), false, false);
      pmax = fmaxf(__uint_as_float(rr[0]), __uint_as_float(rr[1])); }
    constexpr float C2 = 1.4426950408889634f * SCALE;
    if (__builtin_expect(__all((pmax - m_reg) * SCALE <= THR), 1)) { mn = m_reg; alpha = 1.f; }
    else { mn = fmaxf(m_reg, pmax); alpha = __builtin_amdgcn_exp2f((m_reg - mn) * C2); m_reg = mn; }
    const float mnL = -mn * C2;
    for (int r = 0; r < 16; ++r) p0[r] = fmaf(p0[r], C2, mnL); for (int r = 0; r < 16; ++r) p1[r] = fmaf(p1[r], C2, mnL);
    for (int r = 0; r < 16; ++r) p0[r] = __builtin_amdgcn_exp2f(p0[r]);
}
__device__ __forceinline__ void finishSM(f32x16& p0, f32x16& p1, float alpha, float& l_reg, bf16x8& pa0, bf16x8& pa1, bf16x8& pa2, bf16x8& pa3) {
    for (int r = 0; r < 16; ++r) p1[r] = __builtin_amdgcn_exp2f(p1[r]);
    float ps = 0; for (int r = 0; r < 16; ++r) ps += p0[r]; for (int r = 0; r < 16; ++r) ps += p1[r];
    { auto rr = __builtin_amdgcn_permlane32_swap(__float_as_uint(ps), __float_as_uint(ps), false, false);
      ps = __uint_as_float(rr[0]) + __uint_as_float(rr[1]); }
    l_reg = l_reg * alpha + ps;
#define PK4(P, B_, OUT) do { unsigned a0 = cvtpk(P[B_+0], P[B_+1]), a1 = cvtpk(P[B_+2], P[B_+3]);                          \
        unsigned b0 = cvtpk(P[B_+4], P[B_+5]), b1 = cvtpk(P[B_+6], P[B_+7]);                                             \
        auto r0 = __builtin_amdgcn_permlane32_swap(a0, b0, false, false); auto r1 = __builtin_amdgcn_permlane32_swap(a1, b1, false, false); \
        u32x4 w = {r0[0], r1[0], r0[1], r1[1]}; OUT = *reinterpret_cast<bf16x8*>(&w); } while (0)
    PK4(p0, 0, pa0); PK4(p0, 8, pa1); PK4(p1, 0, pa2); PK4(p1, 8, pa3);
#undef PK4
}
template <int KB, bool SK>
__device__ __forceinline__ void qkt(f32x16& p0, f32x16& p1, const char* K_lds, int r32, int hi, const bf16x8* qr, bool act) {
    if (SK && !act) { const float NEG = -__builtin_inff();
#pragma unroll
        for (int r = 0; r < 16; ++r) { p0[r] = NEG; p1[r] = NEG; } return; }
    p0 = f32x16{}; p1 = f32x16{};
    const char* kb[4];
#pragma unroll
    for (int dd = 0; dd < 4; ++dd) kb[dd] = K_lds + KB * SHM_K + KSWZ(r32, (dd * 16 + hi * 8) * 2);
#pragma unroll
    for (int d0 = 0; d0 < 8; ++d0) { const char* a = kb[d0 & 3] + (d0 >> 2) * 128;
        bf16x8 b0 = *reinterpret_cast<const bf16x8*>(a);
        bf16x8 b1 = *reinterpret_cast<const bf16x8*>(a + 32 * 256);
        p0 = __builtin_amdgcn_mfma_f32_32x32x16_bf16(b0, qr[d0], p0, 0, 0, 0);
        p1 = __builtin_amdgcn_mfma_f32_32x32x16_bf16(b1, qr[d0], p1, 0, 0, 0); }
}
template <int VB, bool SK>
__device__ __forceinline__ void pv_tile(f32x16* o, int vb0, bf16x8 pa0, bf16x8 pa1, bf16x8 pa2, bf16x8 pa3, bool act) {
    if (SK && !act) return;
#define TRRD(dst, off) asm volatile("ds_read_b64_tr_b16 %0, %1 offset:%2" : "=&v"(dst) : "v"(vb0), "i"(off) : "memory")
#define PV_D0(d0) do { s16x4 l0, l1, l2, l3, h0, h1, h2, h3; constexpr int b_ = VB * SHM_V + v_rd_off(d0, 0, 0);     \
        TRRD(l0, b_); TRRD(h0, b_ + 2048); TRRD(l1, b_ + 4096); TRRD(h1, b_ + 6144); TRRD(l2, b_ + 8192); TRRD(h2, b_ + 10240); TRRD(l3, b_ + 12288); TRRD(h3, b_ + 14336); \
        asm volatile("s_waitcnt lgkmcnt(0)" ::: "memory"); SBAR();                 \
        o[d0] = __builtin_amdgcn_mfma_f32_32x32x16_bf16(pa0, (bf16x8){l0[0], l0[1], l0[2], l0[3], h0[0], h0[1], h0[2], h0[3]}, o[d0], 0, 0, 0);   \
        o[d0] = __builtin_amdgcn_mfma_f32_32x32x16_bf16(pa1, (bf16x8){l1[0], l1[1], l1[2], l1[3], h1[0], h1[1], h1[2], h1[3]}, o[d0], 0, 0, 0);   \
        o[d0] = __builtin_amdgcn_mfma_f32_32x32x16_bf16(pa2, (bf16x8){l2[0], l2[1], l2[2], l2[3], h2[0], h2[1], h2[2], h2[3]}, o[d0], 0, 0, 0);   \
        o[d0] = __builtin_amdgcn_mfma_f32_32x32x16_bf16(pa3, (bf16x8){l3[0], l3[1], l3[2], l3[3], h3[0], h3[1], h3[2], h3[3]}, o[d0], 0, 0, 0); } while (0)
    PV_D0(0); PV_D0(1); PV_D0(2); PV_D0(3);
#undef PV_D0
#undef TRRD
}

template <class TIn, class TOut> struct BlockRef { const TIn* Q; const TIn* K; const TIn* V; TOut* O; int P0; const float* bt; };
template <class TIn> struct Seam {
    bf16x8 qr[8];
    bf16x8 st_v0, st_v1, st_k0, st_k1; f32x4 sf0, sf1, sf2, sf3;
    f32x4 tq[16];
};
__device__ __forceinline__ int swa_jlo(int P0, int W) { const int lowk = P0 - W + 1; return lowk > 0 ? lowk / KVBLK : 0; }
#define ROW(p, k0, rr) ((p) + (size_t)((k0) + (rr)) * D + sc)
#define VMW() asm volatile("s_waitcnt vmcnt(0)" ::: "memory")
#define VMWN(n) asm volatile("s_waitcnt vmcnt(%0)" :: "i"(n) : "memory")
#define SLOAD_H(Kp, Vp, k0) do { S.st_v0 = load8<TIn>(ROW(Vp, k0, sr)); S.st_v1 = load8<TIn>(ROW(Vp, k0, 32 + sr));              \
                         S.st_k0 = load8<TIn>(ROW(Kp, k0, sr)); S.st_k1 = load8<TIn>(ROW(Kp, k0, 32 + sr)); } while (0)
#define SWRITE_HK(bf) do { *(bf16x8*)(K_lds + (bf) * SHM_K + kws) = S.st_k0; *(bf16x8*)(K_lds + (bf) * SHM_K + kws + 32 * 256) = S.st_k1; } while (0)
#define SWRITE_HV(bf) do { *(bf16x8*)(V_lds + (bf) * SHM_V + vst0) = S.st_v0; *(bf16x8*)(V_lds + (bf) * SHM_V + vst1) = S.st_v1; } while (0)
#define SWRITE_H(bf) do { SWRITE_HV(bf); SWRITE_HK(bf); } while (0)
#define SLOAD_F(p, k0) do { S.sf0 = *(const f32x4*)ROW(p, k0, sr); S.sf1 = *(const f32x4*)(ROW(p, k0, sr) + 4);                \
                            S.sf2 = *(const f32x4*)ROW(p, k0, 32 + sr); S.sf3 = *(const f32x4*)(ROW(p, k0, 32 + sr) + 4); } while (0)
#define SWRITE_KF(bf) do { *(bf16x8*)(K_lds + (bf) * SHM_K + kws) = pack8(S.sf0, S.sf1); *(bf16x8*)(K_lds + (bf) * SHM_K + kws + 32 * 256) = pack8(S.sf2, S.sf3); } while (0)
#define SWRITE_VF(bf) do { *(bf16x8*)(V_lds + (bf) * SHM_V + vst0) = pack8(S.sf0, S.sf1); *(bf16x8*)(V_lds + (bf) * SHM_V + vst1) = pack8(S.sf2, S.sf3); } while (0)
template <class TIn, class TOut>
__device__ __forceinline__ void causal_swa_prime(const BlockRef<TIn, TOut>& cur, int W, char* lds, Seam<TIn>& S) {
    constexpr bool F32 = same_t<TIn, float>::v;
    const int tid = threadIdx.x, wid = __builtin_amdgcn_readfirstlane(tid >> 6), lane = tid & 63, r32 = lane & 31, hi = lane >> 5;
    const int sr = tid >> 4, sc = (tid & 15) * 8, kws = KSWZ(sr, sc * 2); char* K_lds = lds + 2 * SHM_V;
    const int kb0 = swa_jlo(cur.P0, W) * KVBLK;
    for (int d0 = 0; d0 < 8; ++d0) S.qr[d0] = load8<TIn>(cur.Q + (size_t)(wid * QBLK + r32) * D + d0 * 16 + hi * 8);
    if constexpr (F32) { SLOAD_F((const float*)cur.K, kb0); VMW(); SWRITE_KF(0); SBAR(); SLOAD_F((const float*)cur.V, kb0); }
    else { SLOAD_H(cur.K, cur.V, kb0); VMW(); SWRITE_HK(0); }
    __syncthreads();
}
template <class TIn, class TOut>
__device__ __forceinline__ void causal_swa_block(const BlockRef<TIn, TOut>& cur, const BlockRef<TIn, TOut>& nxt, int skv, int W, char* lds, Seam<TIn>& S) {
    constexpr bool F32 = same_t<TIn, float>::v;
    const int tid = threadIdx.x, wid = __builtin_amdgcn_readfirstlane(tid >> 6), lane = tid & 63, r32 = lane & 31, hi = lane >> 5;
    const int j_lo = swa_jlo(cur.P0, W);
    int j_hi = (cur.P0 + QB - 1) / KVBLK + 1; if (j_hi > skv / KVBLK) j_hi = skv / KVBLK;
    const int NT = j_hi - j_lo;
    const int kbn = swa_jlo(nxt.P0, W) * KVBLK;
    const int qlo = cur.P0 + wid * QBLK, qm = qlo + r32 - 4 * hi;
    char* V_lds = lds; char* K_lds = lds + 2 * SHM_V;
    float* ws = (float*)(lds + 2 * SHM_V + 2 * SHM_K) + wid * 64; float* li_l = ws, * al_l = ws + 32;
    float m_reg = -1e30f, l_reg = 0; f32x16 o[4] = {};
    const int sr = tid >> 4, sc = (tid & 15) * 8, vst0 = v_st(sr, sc), vst1 = v_st(32 + sr, sc), kws = KSWZ(sr, sc * 2);
    const int vb0 = (int)(uintptr_t)V_lds + v_rd_base(lane);
    const TIn* Kh = cur.K; const TIn* Vh = cur.V;
#define RESC(a) do { if (__any((a) < 1.f)) { if (hi == 0) al_l[r32] = (a); asm volatile("s_waitcnt lgkmcnt(0)" ::: "memory");              \
                     for (int d_ = 0; d_ < 4; ++d_) for (int r = 0; r < 16; ++r) o[d_][r] *= al_l[crow(r, hi)]; } } while (0)
#define KBASE(t) ((j_lo + (t)) * KVBLK)
#define ACT(t) (KBASE(t) <= qlo + QBLK - 1 && KBASE(t) + KVBLK - 1 >= qlo - W + 1)
#define MASKT(P0_, P1_, t) do { const int kb_ = KBASE(t); \
        if (kb_ <= qlo + QBLK - 1 && qlo - kb_ <= 190) bias_tile(P0_, P1_, qm - kb_, cur.bt);            \
        if (kb_ == 0) padmask_tile(P0_, P1_);                                                         \
        if ((!SK || ACT(t)) && (kb_ + KVBLK - 1 > qlo || kb_ <= qlo + QBLK - 1 - W)) mask_tile(P0_, P1_, qm - kb_, (unsigned)W); } while (0)
    constexpr int NQL = F32 ? 16 : 8;
    constexpr bool SK = WSKIP && !F32;
#define SEAM_K0() do { VMWN(NQL); if constexpr (F32) { SWRITE_KF(0); SBAR(); SLOAD_F((const float*)nxt.V, kbn); } else { SWRITE_HK(0); } SBAR(); } while (0)
    f32x16 pA0, pA1, pB0, pB1; float mnA, mnB, alA, alB; bf16x8 pa0, pa1, pa2, pa3;
    if constexpr (F32) { VMW(); SWRITE_VF(0); SBAR(); } else { SWRITE_HV(0); SBAR(); }
    if (NT > 1) { if constexpr (F32) SLOAD_F((const float*)Kh, KBASE(1)); else SLOAD_H(Kh, Vh, KBASE(1)); }
    SBAR(); qkt<0, SK>(pA0, pA1, K_lds, r32, hi, S.qr, ACT(0));
    if constexpr (F32) { if (NT > 1) { VMW(); SWRITE_KF(1); SBAR(); SLOAD_F((const float*)Vh, KBASE(1)); } }
    MASKT(pA0, pA1, 0); partialSM(pA0, pA1, m_reg, mnA, alA);
    if (NT > 1) { VMW(); if constexpr (F32) { SWRITE_VF(1); SBAR(); if (NT > 2) SLOAD_F((const float*)Kh, KBASE(2)); } else SWRITE_H(1); }
    __syncthreads();
#define HALF_STEP(PX0, PX1, mnX, alX, PY0, PY1, alY, t, KB, VB, SB) do {                                                      \
        SBAR(); qkt<KB, SK>(PX0, PX1, K_lds, r32, hi, S.qr, ACT(t));                                             \
        finishSM(PY0, PY1, alY, l_reg, pa0, pa1, pa2, pa3); SBAR();                                                           \
        if ((t) + 1 < NT) { if constexpr (F32) { VMW(); SWRITE_KF(SB); SBAR(); SLOAD_F((const float*)Vh, KBASE((t) + 1)); }  \
                            else { SLOAD_H(Kh, Vh, KBASE((t) + 1)); } SBAR(); }                                               \
        pv_tile<VB, SK>(o, vb0, pa0, pa1, pa2, pa3, ACT((t) - 1)); MASKT(PX0, PX1, (t)); partialSM(PX0, PX1, m_reg, mnX, alX);                                        \
        __syncthreads();                                                                                                      \
        if ((t) + 1 < NT) { VMW(); if constexpr (F32) { SWRITE_VF(SB); SBAR(); if ((t) + 2 < NT) SLOAD_F((const float*)Kh, KBASE((t) + 2)); } \
                            else { SWRITE_H(SB); } }                                                                          \
        RESC(alX); __syncthreads(); } while (0)
    for (int t = 1; t + 1 < NT; t += 2) {
        HALF_STEP(pB0, pB1, mnB, alB, pA0, pA1, alA, t, 1, 0, 0);
        HALF_STEP(pA0, pA1, mnA, alA, pB0, pB1, alB, t + 1, 0, 1, 1);
    }
    const bool even = (NT & 1) == 0;
    if (even) { SBAR(); qkt<1, SK>(pB0, pB1, K_lds, r32, hi, S.qr, ACT(NT - 1)); SBAR(); }
#define QROW(e) (nxt.Q + (size_t)(wid * QBLK + r32) * D + ((e) >> 1) * 16 + hi * 8 + ((e) & 1) * 4)
    if constexpr (F32) { SLOAD_F((const float*)nxt.K, kbn); SBAR();
#pragma unroll
        for (int e = 0; e < 8; ++e) S.tq[e] = *(const f32x4*)QROW(e); }
    else { SLOAD_H(nxt.K, nxt.V, kbn); SBAR();
#pragma unroll
        for (int d0 = 0; d0 < 8; ++d0) S.qr[d0] = load8<TIn>(nxt.Q + (size_t)(wid * QBLK + r32) * D + d0 * 16 + hi * 8); }
    SBAR();
    finishSM(pA0, pA1, alA, l_reg, pa0, pa1, pa2, pa3); SBAR();
    if constexpr (F32) {
#pragma unroll
        for (int e = 8; e < 16; ++e) S.tq[e] = *(const f32x4*)QROW(e); SBAR(); }
#undef QROW
    pv_tile<0, SK>(o, vb0, pa0, pa1, pa2, pa3, ACT(even ? NT - 2 : NT - 1));
    if (even) { MASKT(pB0, pB1, NT - 1); partialSM(pB0, pB1, m_reg, mnB, alB); __syncthreads(); RESC(alB);
        finishSM(pB0, pB1, alB, l_reg, pa0, pa1, pa2, pa3); SBAR(); pv_tile<1, SK>(o, vb0, pa0, pa1, pa2, pa3, ACT(NT - 1)); }
    SBAR(); SEAM_K0();
    if (hi == 0) li_l[r32] = l_reg; asm volatile("s_waitcnt lgkmcnt(0)" ::: "memory");
    float rli[16];
#pragma unroll
    for (int r = 0; r < 16; ++r) rli[r] = __builtin_amdgcn_rcpf(li_l[crow(r, hi)]);
    TOut* Ow = cur.O + (size_t)(wid * QBLK) * D;
#pragma unroll
    for (int r = 0; r < 16; ++r) { const int orow = crow(r, hi);
#pragma unroll
        for (int d0 = 0; d0 < 4; ++d0) { const float v = o[d0][r] * rli[r];
            if constexpr (same_t<TOut, float>::v) { Ow[(size_t)orow * D + d0 * 32 + r32] = v; }
            else { const float vn = __shfl_xor(v, 1);
                   if ((r32 & 1) == 0) *(unsigned*)(Ow + (size_t)orow * D + d0 * 32 + r32) = cvtpk(v, vn); } } }
    if constexpr (F32) {
#pragma unroll
        for (int d0 = 0; d0 < 8; ++d0) S.qr[d0] = pack8(S.tq[2 * d0], S.tq[2 * d0 + 1]); }
    __syncthreads();
#undef RESC
#undef KBASE
#undef ACT
#undef MASKT
#undef SEAM_K0
#undef HALF_STEP
}
#undef ROW
#undef VMW
#undef VMWN
#undef SLOAD_H
#undef SWRITE_HK
#undef SWRITE_HV
#undef SWRITE_H
#undef SLOAD_F
#undef SWRITE_KF
#undef SWRITE_VF
#undef KSWZ
#undef SBAR
}

constexpr int NWAVES = 8, NTHR = NWAVES * 64;
constexpr int DM = 2048, NB = 4, SEQ = 8192, NMETA = 16;
constexpr int MTOK = NB * SEQ;
constexpr int MROWS = MTOK + 256;
constexpr int DIN = 9 * DM;
constexpr int PKV = 64 + SEQ;
constexpr int NCHK = SEQ / 64;
constexpr int NE = 32, TOPK = 4, DFF = 2048;
constexpr int NASSIGN = MTOK * TOPK;
constexpr int RSLOT = NASSIGN + NE * 256;
constexpr float RMS_EPS = 1e-6f;
constexpr float LAMBDA_INIT = 0.2f;

constexpr size_t MiB = 1u << 20, KiB = 1u << 10;
constexpr size_t WS_CTL = 0, CTL_ZERO_BYTES = 1 * MiB;
constexpr size_t WS_SM = 1 * MiB;
constexpr size_t SM_LB = WS_SM, SM_LAM = WS_SM + 8 * KiB, SM_BT = WS_SM + 9 * KiB, SM_RSTD = WS_SM + 32 * KiB;
constexpr size_t SM_AE = WS_SM + 256 * KiB, SM_AR = WS_SM + 768 * KiB, SM_AG = WS_SM + 1280 * KiB, SM_TS = WS_SM + 1792 * KiB;
constexpr size_t SM_ST = WS_SM + 2304 * KiB, SM_SR = WS_SM + 2848 * KiB, SM_SG = WS_SM + 3392 * KiB;
static_assert(SM_SG + (size_t)RSLOT * 4 <= 5 * MiB && SM_RSTD + (size_t)MTOK * 4 <= SM_AE && SM_BT + 8 * 352 * 4 <= SM_RSTD, "small tables");
constexpr size_t WS_WOUT = 5 * MiB, WS_WR = 13 * MiB, WS_WGU = 14 * MiB, WS_WDN = 270 * MiB, WS_HG8 = 398 * MiB;
constexpr size_t WS_WIN = 782 * MiB, WS_U = 854 * MiB;
constexpr size_t WS_Y = WS_U;
constexpr size_t WS_QH = 983 * MiB, WS_KH = 1111 * MiB, WS_VH = 1240 * MiB, WS_HQ = 1369 * MiB, WS_HK = 1498 * MiB, WS_HGT = 1627 * MiB, WS_HV = 1756 * MiB;
constexpr size_t WS_OG = 1885 * MiB, WS_GA = 2013 * MiB, WS_GH = 2141 * MiB;
constexpr size_t WS_OP = 2269 * MiB, WS_DS = 2525 * MiB, WS_DEC = 2781 * MiB, WS_END = 2785 * MiB;
constexpr size_t WS_ACT = WS_QH, WS_YS = WS_HGT;
constexpr float W8_SCALE = 64.f, ACT8_SCALE = 4.f;
static_assert(WS_ACT + (size_t)RSLOT * DM * 2 <= WS_HGT && WS_YS + (size_t)RSLOT * DM * 2 <= WS_OP && WS_HG8 + (size_t)MROWS * DM <= 782 * MiB, "MoE overlays");
static_assert(WS_KH + (size_t)NB * 16 * PKV * 128 * 2 <= WS_VH && WS_U + (size_t)MROWS * DM * 2 <= WS_QH && WS_WIN + (size_t)DIN * DM * 2 <= WS_U, "d_ws map");
constexpr int CW_CNT = 64;
constexpr int CW_BAR = 4096;

constexpr int RING_BYTES = 131072;
constexpr int XCH_OFF = 131072;
constexpr int CTRL_OFF = 147456;
constexpr int LDS_BYTES = 151552;
constexpr int NPHASE = 11;
#ifndef MK_N_LAUNCHES
#define MK_N_LAUNCHES 1
#endif
constexpr int N_LAUNCHES = MK_N_LAUNCHES;
static_assert(N_LAUNCHES == 1 || N_LAUNCHES == NPHASE, "launch cuts");

#define GAS __attribute__((address_space(1)))
#define LAS __attribute__((address_space(3)))
typedef unsigned short bf16;
typedef unsigned v4u __attribute__((ext_vector_type(4)));
typedef unsigned v2u __attribute__((ext_vector_type(2)));
typedef float f32x4 __attribute__((ext_vector_type(4)));
typedef float f32x16 __attribute__((ext_vector_type(16)));
typedef short bf16x8 __attribute__((ext_vector_type(8)));
#define LDS_WAIT() asm volatile("s_waitcnt lgkmcnt(0)" ::: "memory")
#define VM_WAIT() asm volatile("s_waitcnt vmcnt(0)" ::: "memory")
__device__ __forceinline__ unsigned f2bf(float f) { unsigned u = __builtin_bit_cast(unsigned, f); return (u + 0x7fffu + ((u >> 16) & 1u)) >> 16; }
typedef float f32x2_t __attribute__((ext_vector_type(2))); typedef __bf16 bf16x2_t __attribute__((ext_vector_type(2)));
__device__ __forceinline__ unsigned pk2(float lo, float hi) { f32x2_t v = {lo, hi}; bf16x2_t b = __builtin_convertvector(v, bf16x2_t); return __builtin_bit_cast(unsigned, b); }
__device__ __forceinline__ unsigned pk4_fp8(float a, float b, float c, float d) { unsigned w = 0u; w = __builtin_amdgcn_cvt_pk_fp8_f32(a, b, w, false); w = __builtin_amdgcn_cvt_pk_fp8_f32(c, d, w, true); return w; }
__device__ __forceinline__ float bf_lo(unsigned u) { return __builtin_bit_cast(float, u << 16); }
__device__ __forceinline__ float bf_hi(unsigned u) { return __builtin_bit_cast(float, u & 0xffff0000u); }
__device__ __forceinline__ float bf2f(bf16 h) { return __builtin_bit_cast(float, (unsigned)h << 16); }
__device__ __forceinline__ float sigmoidf_(float x) { return __builtin_amdgcn_rcpf(1.f + __expf(-x)); }
__device__ __forceinline__ float wave_sum(float v) {
#pragma unroll
    for (int o = 1; o < 64; o <<= 1) v += __shfl_xor(v, o);
    return v;
}
#define XB_TMO      128
#define XB_XCNT(j)  (256  + 64 * (j))
#define XB_XSUB(j)  (1280 + 64 * (j))
#define XB_XGEN(j)  (2304 + 64 * (j))
#define XB_TOP      3328
#define XB_TOPGEN   3392
#define XCD_BAR_WORDS 3456
#define XB_SPIN_CAP (1u << 18)

__device__ __forceinline__ unsigned xb_ld(unsigned* p)              { return __hip_atomic_load(p, __ATOMIC_RELAXED, __HIP_MEMORY_SCOPE_AGENT); }
__device__ __forceinline__ unsigned xb_add(unsigned* p, unsigned v) { return __hip_atomic_fetch_add(p, v, __ATOMIC_RELAXED, __HIP_MEMORY_SCOPE_AGENT); }
__device__ __forceinline__ unsigned xb_xcc_id() { return (unsigned)__builtin_amdgcn_s_getreg((3 << 11) | 20) & 0xFu; }
#define XB_SPIN(cond, bar) do { unsigned _sp = 0; while (cond) { __builtin_amdgcn_s_sleep(1); \
    if ((++_sp & 255u) == 0u) { if (xb_ld(&(bar)[XB_TMO])) break; if (_sp > XB_SPIN_CAP) { atomicAdd(&(bar)[XB_TMO], 1u); break; } } } } while (0)

struct XcdBarrier {
    unsigned* bar; unsigned x;
    volatile LAS unsigned* st;
};

__device__ __forceinline__ XcdBarrier xcd_barrier_post(unsigned* bar, volatile LAS unsigned* st) {
    XcdBarrier b; b.bar = bar; b.x = xb_xcc_id(); b.st = st;
    if (threadIdx.x == 0) (void)xb_add(&bar[XB_XCNT(b.x)], 1u);
    return b;
}
__device__ __forceinline__ void xcd_barrier_complete(unsigned* bar, unsigned x, unsigned& nloc, unsigned& nx) {
    const unsigned G = gridDim.x * gridDim.y * gridDim.z;
    unsigned sum, cnt, mine, sp = 0u;
    for (;;) {
        sum = 0u; cnt = 0u; mine = 0u;
#pragma unroll
        for (unsigned j = 0; j < 16; ++j) { const unsigned c = xb_ld(&bar[XB_XCNT(j)]); sum += c; cnt += (c > 0u) ? 1u : 0u; mine = (j == x) ? c : mine; }
        if (sum == G) break;
        __builtin_amdgcn_s_sleep(1);
        if ((++sp & 255u) == 0u) { if (xb_ld(&bar[XB_TMO])) break; if (sp > XB_SPIN_CAP) { atomicAdd(&bar[XB_TMO], 1u); break; } }
    }
    nloc = mine > 0u ? mine : 1u; nx = cnt > 0u ? cnt : 1u;
}

__device__ __forceinline__ void xcd_barrier(const XcdBarrier& b) {
    asm volatile("s_waitcnt vmcnt(0)" ::: "memory");
    __syncthreads();
    if (threadIdx.x == 0) {
        unsigned* bar = b.bar;
        __builtin_amdgcn_s_waitcnt(0);
        unsigned nloc = b.st[0], nx = b.st[1];
        if (nloc == 0u) { xcd_barrier_complete(bar, b.x, nloc, nx); b.st[0] = nloc; b.st[1] = nx; }
        const unsigned old = xb_add(&bar[XB_XSUB(b.x)], 1u);
        const unsigned gen = old / nloc;
        if (old + 1u == (gen + 1u) * nloc) {
            __builtin_amdgcn_fence(__ATOMIC_RELEASE, "agent");
            asm volatile("s_waitcnt vmcnt(0)" ::: "memory");
            const unsigned og = xb_add(&bar[XB_TOP], 1u);
            const unsigned tg = og / nx;
            if (og + 1u == (tg + 1u) * nx) xb_add(&bar[XB_TOPGEN], 1u);
            else XB_SPIN(xb_ld(&bar[XB_TOPGEN]) == tg, bar);
            __builtin_amdgcn_fence(__ATOMIC_ACQUIRE, "agent");
            xb_add(&bar[XB_XGEN(b.x)], 1u);
            asm volatile("s_waitcnt vmcnt(0)" ::: "memory");
        } else {
            XB_SPIN(xb_ld(&bar[XB_XGEN(b.x)]) == gen, bar);
            __builtin_amdgcn_fence(__ATOMIC_ACQUIRE, "agent");
            asm volatile("s_waitcnt vmcnt(0)" ::: "memory");
        }
    }
    __syncthreads();
}


__device__ __forceinline__ void static_order(int L, int nM, int nN, int& pm, int& pn) {
    const int nwg = nM * nN, q = nwg / 8, xcd = L & 7, off = L >> 3; const int wgid = xcd * q + off;
    const int nig = 8 * nN, gid = wgid / nig, fm = gid * 8; pm = fm + ((wgid % nig) & 7); pn = (wgid % nig) >> 3;
}
struct SchedInProj {
    int G, c; const bf16* Bt;
    __device__ __forceinline__ bool next(int i, pg8::Unit& u) const {
        u.e = 0;
        if (c < 32) { if (i == 0) { const int gs = c >> 3; u.pm = 128; u.pn = (gs == 0 ? 1 : gs == 1 ? 2 : gs == 2 ? 4 : 5) * 8 + (c & 7); u.aux = 1; return true; } i -= 1; }
        const long L = (long)i * G + c; if (L >= 128 * 72) return false;
        static_order((int)L, 128, 72, u.pm, u.pn); u.aux = 0; return true;
    }
    __device__ __forceinline__ unsigned arow(const pg8::Unit& u, int r) const { return (unsigned)(u.pm * 256 + r); }
    __device__ __forceinline__ const char* bptr(const pg8::Unit& u) const { return (const char*)Bt + (size_t)u.pn * 256 * DM * 2; }
};
struct SchedPlain {
    int G, c, nM, nN; const bf16* Bt;
    __device__ __forceinline__ bool next(int i, pg8::Unit& u) const {
        const long L = (long)i * G + c; if (L >= (long)nM * nN) return false;
        static_order((int)L, nM, nN, u.pm, u.pn); u.e = 0; u.aux = 0; return true;
    }
    __device__ __forceinline__ unsigned arow(const pg8::Unit& u, int r) const { return (unsigned)(u.pm * 256 + r); }
    __device__ __forceinline__ const char* bptr(const pg8::Unit& u) const { return (const char*)Bt + (size_t)u.pn * 256 * DM * 2; }
};
struct SchedMoE {
    int G, c, npn; const LAS int* tstart; const unsigned char* W; size_t wstride, tilebytes; const int* slot_tok;
    __device__ __forceinline__ bool next(int i, pg8::Unit& u) const {
        const int L = i * G + c; if (L >= tstart[32] * npn) return false;
        int e = 0;
#pragma unroll 8
        for (int j = 1; j <= 32; ++j) e += (L >= tstart[j] * npn) ? 1 : 0;
        e = __builtin_amdgcn_readfirstlane(e);
        const int t0 = __builtin_amdgcn_readfirstlane(tstart[e]), t1 = __builtin_amdgcn_readfirstlane(tstart[e + 1]), w = L - t0 * npn, ne = t1 - t0;
        u.pn = w / ne; u.pm = t0 + w % ne; u.e = e; u.aux = 0; return true;
    }
    __device__ __forceinline__ unsigned arow(const pg8::Unit& u, int r) const { const int slot = u.pm * 256 + r; return slot_tok ? (unsigned)slot_tok[slot] : (unsigned)slot; }
    __device__ __forceinline__ const char* bptr(const pg8::Unit& u) const { return (const char*)W + (size_t)u.e * wstride + (size_t)u.pn * tilebytes; }
};

struct EpiInProj {
    static constexpr bool PERM = true;
    unsigned char* ws; const float *qg, *kg, *lb; LAS float* xch;
    __device__ __forceinline__ void st_hm(bf16* base, int slen, int poff, bool meta, int b, int s, int rl, int head16, int d0, v4u w) const {
        if (!meta) { *(v4u*)(base + ((size_t)(b * 16 + head16) * slen + poff + s) * 128 + d0) = w; }
        else if (rl < 16) {
#pragma unroll
            for (int bb = 0; bb < NB; ++bb) *(v4u*)(base + ((size_t)(bb * 16 + head16) * slen + 48 + rl) * 128 + d0) = w; }
    }
    __device__ __forceinline__ void operator()(const pg8::f32x4 (&acc)[2][2][4][2], const pg8::Unit& u, int wr, int wc, int fr, int fq, int wid, int lane) const {
        asm volatile("" : "+v"(fr), "+v"(fq));
        const int grp = u.pn >> 3, pl = u.pn & 7; const bool meta = u.aux != 0;
        const int d0 = 32 * wc + 8 * fq, b = u.pm >> 5, sb = (u.pm & 31) * 256;
        if (grp <= 1) {
            f32x4 g0, g1;
            if (grp == 0) { g0 = *(const f32x4*)(qg + d0); g1 = *(const f32x4*)(qg + d0 + 4); } else { g0 = *(const f32x4*)(kg + d0); g1 = *(const f32x4*)(kg + d0 + 4); }
            bf16* const QH = (bf16*)(ws + WS_QH); bf16* const KH = (bf16*)(ws + WS_KH);
#pragma unroll
            for (int ai = 0; ai < 2; ++ai)
#pragma unroll
                for (int m = 0; m < 4; ++m)
#pragma unroll
                    for (int bj = 0; bj < 2; ++bj) {
                        const f32x4 a = acc[ai][bj][m][0], c = acc[ai][bj][m][1];
                        float s = (a[0] * a[0] + a[1] * a[1]) + (a[2] * a[2] + a[3] * a[3]) + (c[0] * c[0] + c[1] * c[1]) + (c[2] * c[2] + c[3] * c[3]);
                        s += __shfl_xor(s, 16); s += __shfl_xor(s, 32);
                        const int rl = 128 * ai + 64 * wr + 16 * m + fr;
                        if (fq == 0) xch[(rl * 2 + bj) * 4 + wc] = s;
                    }
            LDS_WAIT(); __builtin_amdgcn_s_barrier(); asm volatile("" ::: "memory");
#pragma unroll
            for (int ai = 0; ai < 2; ++ai)
#pragma unroll
                for (int m = 0; m < 4; ++m)
#pragma unroll
                    for (int bj = 0; bj < 2; ++bj) {
                        const int rl = 128 * ai + 64 * wr + 16 * m + fr;
                        const f32x4 p = *(const LAS f32x4*)(xch + (rl * 2 + bj) * 4);
                        const float rs = __builtin_amdgcn_rsqf(((p[0] + p[1]) + (p[2] + p[3])) * (1.f / 128.f) + RMS_EPS);
                        const f32x4 a = acc[ai][bj][m][0] * rs * g0, c = acc[ai][bj][m][1] * rs * g1;
                        v4u w; w.x = pk2(a[0], a[1]); w.y = pk2(a[2], a[3]); w.z = pk2(c[0], c[1]); w.w = pk2(c[2], c[3]);
                        if (grp == 0) { if (!meta) *(v4u*)(QH + ((size_t)(b * 16 + 2 * pl + bj) * SEQ + sb + rl) * 128 + d0) = w; }
                        else st_hm(KH, PKV, 64, meta, b, sb + rl, rl, 2 * pl + bj, d0, w);
                    }
        } else if (grp == 2 || grp == 5) {
            bf16* dst = (bf16*)(ws + (grp == 2 ? WS_VH : WS_HV));
#pragma unroll
            for (int ai = 0; ai < 2; ++ai)
#pragma unroll
                for (int m = 0; m < 4; ++m)
#pragma unroll
                    for (int bj = 0; bj < 2; ++bj) {
                        const int rl = 128 * ai + 64 * wr + 16 * m + fr; const f32x4 a = acc[ai][bj][m][0], c = acc[ai][bj][m][1];
                        v4u w; w.x = pk2(a[0], a[1]); w.y = pk2(a[2], a[3]); w.z = pk2(c[0], c[1]); w.w = pk2(c[2], c[3]);
                        st_hm(dst, PKV, 64, meta, b, sb + rl, rl, 2 * pl + bj, d0, w);
                    }
        } else if (grp == 3) {
            if (!meta) {
#pragma unroll
            for (int ai = 0; ai < 2; ++ai)
#pragma unroll
                for (int m = 0; m < 4; ++m)
#pragma unroll
                    for (int bj = 0; bj < 2; ++bj) {
                        const int rl = 128 * ai + 64 * wr + 16 * m + fr; f32x4 a = acc[ai][bj][m][0], c = acc[ai][bj][m][1];
#pragma unroll
                        for (int j = 0; j < 4; ++j) { a[j] *= sigmoidf_(a[j]); c[j] *= sigmoidf_(c[j]); }
                        v4u w; w.x = pk2(a[0], a[1]); w.y = pk2(a[2], a[3]); w.z = pk2(c[0], c[1]); w.w = pk2(c[2], c[3]);
                        st_hm((bf16*)(ws + WS_HQ), PKV, 64, false, b, sb + rl, rl, 2 * pl + bj, d0, w);
                    }
            }
        } else if (grp == 4) {
#pragma unroll
            for (int bj = 0; bj < 2; ++bj) {
                const f32x4 l0 = *(const f32x4*)(lb + 256 * pl + 128 * bj + d0), l1 = *(const f32x4*)(lb + 256 * pl + 128 * bj + d0 + 4);
#pragma unroll
                for (int ai = 0; ai < 2; ++ai)
#pragma unroll
                    for (int m = 0; m < 4; ++m) {
                        const int rl = 128 * ai + 64 * wr + 16 * m + fr; const f32x4 a = acc[ai][bj][m][0], c = acc[ai][bj][m][1];
                        f32x4 ga, gc, ka, kc;
#pragma unroll
                        for (int j = 0; j < 4; ++j) { const float sa = sigmoidf_(a[j]), sc = sigmoidf_(c[j]);
                            ga[j] = __logf(l0[j] + (1.f - l0[j]) * sa); gc[j] = __logf(l1[j] + (1.f - l1[j]) * sc);
                            ka[j] = (1.f - l0[j]) * (1.f - sa); kc[j] = (1.f - l1[j]) * (1.f - sc); }
                        v4u w; w.x = pk2(ga[0], ga[1]); w.y = pk2(ga[2], ga[3]); w.z = pk2(gc[0], gc[1]); w.w = pk2(gc[2], gc[3]);
                        st_hm((bf16*)(ws + WS_HGT), PKV, 64, meta, b, sb + rl, rl, 2 * pl + bj, d0, w);
                        w.x = pk2(ka[0], ka[1]); w.y = pk2(ka[2], ka[3]); w.z = pk2(kc[0], kc[1]); w.w = pk2(kc[2], kc[3]);
                        st_hm((bf16*)(ws + WS_HK), PKV, 64, meta, b, sb + rl, rl, 2 * pl + bj, d0, w);
                    }
            }
        } else if (!meta) {
            bf16* dst = (bf16*)(ws + (grp == 6 ? WS_OG : grp == 7 ? WS_GA : WS_GH));
#pragma unroll
            for (int ai = 0; ai < 2; ++ai)
#pragma unroll
                for (int m = 0; m < 4; ++m)
#pragma unroll
                    for (int bj = 0; bj < 2; ++bj) {
                        const int rl = 128 * ai + 64 * wr + 16 * m + fr; f32x4 a = acc[ai][bj][m][0], c = acc[ai][bj][m][1];
#pragma unroll
                        for (int j = 0; j < 4; ++j) { const float sa = sigmoidf_(a[j]), sc = sigmoidf_(c[j]); a[j] = grp == 6 ? a[j] * sa : sa; c[j] = grp == 6 ? c[j] * sc : sc; }
                        v4u w; w.x = pk2(a[0], a[1]); w.y = pk2(a[2], a[3]); w.z = pk2(c[0], c[1]); w.w = pk2(c[2], c[3]);
                        *(v4u*)(dst + (size_t)(u.pm * 256 + rl) * DM + 256 * pl + 128 * bj + d0) = w;
                    }
        }
    }
};
struct EpiOutProj {
    static constexpr bool PERM = false;
    const float* x; float* out;
    __device__ __forceinline__ void operator()(const pg8::f32x4 (&acc)[2][2][4][2], const pg8::Unit& u, int wr, int wc, int fr, int fq, int wid, int lane) const {
        asm volatile("" : "+v"(fr), "+v"(fq));
        const int row0 = u.pm * 256 + wr * 64 + fr, col0 = u.pn * 256 + wc * 32 + 4 * fq;
#pragma unroll
        for (int ai = 0; ai < 2; ++ai)
#pragma unroll
            for (int m = 0; m < 4; ++m) { const size_t off = (size_t)(row0 + ai * 128 + m * 16) * DM + col0;
#pragma unroll
                for (int bj = 0; bj < 2; ++bj)
#pragma unroll
                    for (int n = 0; n < 2; ++n) { const f32x4 xv = *(const f32x4*)(x + off + bj * 128 + n * 16); *(f32x4*)(out + off + bj * 128 + n * 16) = xv + acc[ai][bj][m][n]; }
                asm volatile("" ::: "memory"); }
    }
};
struct EpiGateUp {
    static constexpr bool PERM = true;
    const float* bgu; const float* slot_rstd; unsigned char* ACT;
    __device__ __forceinline__ void operator()(const pg8::f32x4 (&acc)[2][2][4][2], const pg8::Unit& u, int wr, int wc, int fr, int fq, int wid, int lane) const {
        asm volatile("" : "+v"(fr), "+v"(fq));
        const int d0 = 32 * wc + 8 * fq; const float* bp = bgu + (size_t)u.e * (2 * DFF) + 128 * u.pn + d0;
        const f32x4 bg0 = *(const f32x4*)bp, bg1 = *(const f32x4*)(bp + 4), bl0 = *(const f32x4*)(bp + DFF), bl1 = *(const f32x4*)(bp + DFF + 4);
#pragma unroll
        for (int ai = 0; ai < 2; ++ai)
#pragma unroll
            for (int m = 0; m < 4; ++m) {
                const int slot = u.pm * 256 + 128 * ai + 64 * wr + 16 * m + fr; const float rs = slot_rstd[slot] * (1.f / W8_SCALE);
                f32x4 o[2];
#pragma unroll
                for (int n = 0; n < 2; ++n) { const f32x4 g = acc[ai][0][m][n] * rs + (n ? bg1 : bg0), l = acc[ai][1][m][n] * rs + (n ? bl1 : bl0);
#pragma unroll
                    for (int j = 0; j < 4; ++j) { const float xg = fminf(g[j], 7.f), xl = fminf(fmaxf(l[j], -7.f), 7.f); o[n][j] = xg * sigmoidf_(1.702f * xg) * (xl + 1.f) * ACT8_SCALE; } }
                *(v2u*)(ACT + (size_t)slot * DFF + 128 * u.pn + d0) = (v2u){pk4_fp8(o[0][0], o[0][1], o[0][2], o[0][3]), pk4_fp8(o[1][0], o[1][1], o[1][2], o[1][3])};
            }
    }
};
struct EpiDown {
    static constexpr bool PERM = true;
    const float* bdn; const float* slot_gate; bf16* YS;
    __device__ __forceinline__ void operator()(const pg8::f32x4 (&acc)[2][2][4][2], const pg8::Unit& u, int wr, int wc, int fr, int fq, int wid, int lane) const {
        asm volatile("" : "+v"(fr), "+v"(fq));
        const int d0 = 32 * wc + 8 * fq; const float* bp = bdn + (size_t)u.e * DM + 256 * u.pn + d0;
        f32x4 bv[2][2];
#pragma unroll
        for (int bj = 0; bj < 2; ++bj) { bv[bj][0] = *(const f32x4*)(bp + 128 * bj); bv[bj][1] = *(const f32x4*)(bp + 128 * bj + 4); }
#pragma unroll
        for (int ai = 0; ai < 2; ++ai)
#pragma unroll
            for (int m = 0; m < 4; ++m) {
                const int slot = u.pm * 256 + 128 * ai + 64 * wr + 16 * m + fr; const float gt = slot_gate[slot];
#pragma unroll
                for (int bj = 0; bj < 2; ++bj) { const f32x4 a = (acc[ai][bj][m][0] * (1.f / (W8_SCALE * ACT8_SCALE)) + bv[bj][0]) * gt, c = (acc[ai][bj][m][1] * (1.f / (W8_SCALE * ACT8_SCALE)) + bv[bj][1]) * gt;
                    v4u w; w.x = pk2(a[0], a[1]); w.y = pk2(a[2], a[3]); w.z = pk2(c[0], c[1]); w.w = pk2(c[2], c[3]);
                    *(v4u*)(YS + (size_t)slot * DM + 256 * u.pn + 128 * bj + d0) = w; }
            }
    }
};

__device__ __forceinline__ void p0_transpose_item(const float* W, int ldw, bf16* WT, int k0, int n0, size_t dst_row0, LAS float* scr, int lane) {
    float v[32];
#pragma unroll
    for (int i = 0; i < 32; ++i) { const int kk = 2 * i + (lane >> 5); v[i] = W[(size_t)(k0 + kk) * ldw + n0 + (lane & 31)]; }
#pragma unroll
    for (int i = 0; i < 32; ++i) { const int kk = 2 * i + (lane >> 5); scr[kk * 33 + (lane & 31)] = v[i]; }
    LDS_WAIT(); asm volatile("" ::: "memory");
    const int c = lane & 7;
#pragma unroll
    for (int j = 0; j < 4; ++j) { const int n = (lane >> 3) + 8 * j; const LAS float* s = scr + (8 * c) * 33 + n;
        v4u o; o.x = pk2(s[0 * 33], s[1 * 33]); o.y = pk2(s[2 * 33], s[3 * 33]); o.z = pk2(s[4 * 33], s[5 * 33]); o.w = pk2(s[6 * 33], s[7 * 33]);
        *(v4u*)(WT + (dst_row0 + n) * DM + k0 + 8 * c) = o; }
    LDS_WAIT(); asm volatile("" ::: "memory");
}
__device__ __forceinline__ void p0_transpose_item_fp8(const float* W, int ldw, unsigned char* WT, int k0, int n0, size_t dst_row0, float scale, LAS float* scr, int lane) {
    float v[32];
#pragma unroll
    for (int i = 0; i < 32; ++i) { const int kk = 2 * i + (lane >> 5); v[i] = W[(size_t)(k0 + kk) * ldw + n0 + (lane & 31)]; }
#pragma unroll
    for (int i = 0; i < 32; ++i) { const int kk = 2 * i + (lane >> 5); scr[kk * 33 + (lane & 31)] = v[i] * scale; }
    LDS_WAIT(); asm volatile("" ::: "memory");
    const int c = lane & 7;
#pragma unroll
    for (int j = 0; j < 4; ++j) { const int n = (lane >> 3) + 8 * j; const LAS float* s = scr + (8 * c) * 33 + n;
        *(v2u*)(WT + (dst_row0 + n) * DM + k0 + 8 * c) = (v2u){pk4_fp8(s[0 * 33], s[1 * 33], s[2 * 33], s[3 * 33]), pk4_fp8(s[4 * 33], s[5 * 33], s[6 * 33], s[7 * 33])}; }
    LDS_WAIT(); asm volatile("" ::: "memory");
}
__device__ __forceinline__ void rms_row_to_bf16(const float* xrow, const float* gain, bf16* orow, int lane) {
    const f32x4* xr = (const f32x4*)xrow + lane; const f32x4* gr = (const f32x4*)gain + lane;
    f32x4 v[8]; float s = 0.f;
#pragma unroll
    for (int j = 0; j < 8; ++j) { v[j] = xr[64 * j]; s += (v[j][0] * v[j][0] + v[j][1] * v[j][1]) + (v[j][2] * v[j][2] + v[j][3] * v[j][3]); }
    const float rs = __builtin_amdgcn_rsqf(wave_sum(s) * (1.f / DM) + RMS_EPS);
    v2u* o8 = (v2u*)orow + lane;
#pragma unroll
    for (int j = 0; j < 8; ++j) { const f32x4 g = gr[64 * j]; v2u w; w.x = pk2(v[j][0] * rs * g[0], v[j][1] * rs * g[1]); w.y = pk2(v[j][2] * rs * g[2], v[j][3] * rs * g[3]); o8[64 * j] = w; }
}
__device__ __forceinline__ int t5_bucket(int n) {
    if (n < 16) return n;
    const int l = 16 + (int)(__builtin_logf((float)n / 16.f) / 2.0794415416798357f * 16.f);
    return l < 31 ? l : 31;
}
struct P0Args { const float *x, *meta, *rel_bias, *lb_logits, *norm1, *w_in, *diff_lambda, *w_out, *router_w, *w_gu, *w_dn; unsigned char* ws; };
__device__ __forceinline__ void p0_prologue(const P0Args& a, LAS unsigned char* lds, int vcu, int G, int tid) {
    const int lane = tid & 63, wave = __builtin_amdgcn_readfirstlane(tid >> 6);
    const int gw = vcu * NWAVES + wave, NGW = G * NWAVES; const long gid = (long)vcu * NTHR + tid, NG = (long)G * NTHR;
    unsigned char* ws = a.ws;
    float* lbp = (float*)(ws + SM_LB);
    for (long i = gid; i < DM; i += NG) lbp[i] = sigmoidf_(a.lb_logits[i] - a.lb_logits[DM + i]);
    if (gw == 0) { const float* lv = a.diff_lambda; float s1 = lv[lane] * lv[128 + lane] + lv[64 + lane] * lv[192 + lane], s2 = lv[256 + lane] * lv[384 + lane] + lv[320 + lane] * lv[448 + lane];
        s1 = wave_sum(s1); s2 = wave_sum(s2); if (lane == 0) *(float*)(ws + SM_LAM) = __expf(s1) - __expf(s2) + LAMBDA_INIT; }
    { float* bt = (float*)(ws + SM_BT);
      for (long i = gid; i < 8 * att::BT_LEN; i += NG) { const int h = (int)i / att::BT_LEN, rel = (int)i % att::BT_LEN - att::BT_OFF;
          bt[i] = (rel >= 0 && rel < 113) ? (a.rel_bias[t5_bucket(rel) * 8 + h] - a.rel_bias[31 * 8 + h]) * (1.f / att::SCALE) : 0.f; } }
    { int* st = (int*)(ws + SM_ST); float* sr = (float*)(ws + SM_SR); float* sg = (float*)(ws + SM_SG);
      for (long i = gid; i < RSLOT; i += NG) { st[i] = MTOK; sr[i] = 0.f; sg[i] = 0.f; } }
    { const v4u z = {0u, 0u, 0u, 0u};
      for (long i = gid; i < 5L * 64 * 768; i += NG) { const int tsel = (int)(i / (64 * 768)), r = (int)(i % (64 * 768)), bh = r / 768, q = r % 768;
          const size_t base = tsel == 0 ? WS_KH : tsel == 1 ? WS_VH : tsel == 2 ? WS_HK : tsel == 3 ? WS_HGT : WS_HV;
          *(v4u*)(ws + base + ((size_t)bh * PKV * 128) * 2 + (size_t)q * 16) = z; }
      for (long i = gid; i < 240L * 256; i += NG) *(v4u*)(ws + WS_U + (size_t)(MTOK + 16) * DM * 2 + (size_t)i * 16) = z; }
    for (int m = gw; m < MTOK + NMETA; m += NGW) rms_row_to_bf16(m < MTOK ? a.x + (size_t)m * DM : a.meta + (size_t)(m - MTOK) * DM, a.norm1, (bf16*)(ws + WS_U) + (size_t)m * DM, lane);
    LAS float* scr = (LAS float*)(lds + wave * 8704);
    constexpr int I_IN = 32 * (DIN / 32), I_OUT = 32 * 64, I_R = 32, I_GU = 32 * 128, I_DN = 32 * 64;
    constexpr int NITEMS = I_IN + I_OUT + I_R + NE * (I_GU + I_DN);
    for (int it = gw; it < NITEMS; it += NGW) {
        int r = it;
        if (r < I_IN) { const int nb = r % (DIN / 32), kb = r / (DIN / 32); p0_transpose_item(a.w_in, DIN, (bf16*)(ws + WS_WIN), 64 * kb, 32 * nb, (size_t)32 * nb, scr, lane); continue; } r -= I_IN;
        if (r < I_OUT) { const int nb = r % 64, kb = r / 64; p0_transpose_item(a.w_out, DM, (bf16*)(ws + WS_WOUT), 64 * kb, 32 * nb, (size_t)32 * nb, scr, lane); continue; } r -= I_OUT;
        if (r < I_R) { p0_transpose_item(a.router_w, NE, (bf16*)(ws + WS_WR), 64 * r, 0, 0, scr, lane); continue; } r -= I_R;
        const int e = r / (I_GU + I_DN); r -= e * (I_GU + I_DN);
        if (r < I_GU) { const int nb = r % 128, kb = r / 128, n0 = 32 * nb;
            const int nn = n0 & (DFF - 1); const size_t drow = (size_t)e * (2 * DFF) + (size_t)(nn >> 7) * 256 + (n0 >= DFF ? 128 : 0) + (nn & 127);
            p0_transpose_item_fp8(a.w_gu + (size_t)e * DM * 2 * DFF, 2 * DFF, ws + WS_WGU, 64 * kb, n0, drow, W8_SCALE, scr, lane); continue; } r -= I_GU;
        { const int nb = r % 64, kb = r / 64; p0_transpose_item_fp8(a.w_dn + (size_t)e * DFF * DM, DM, ws + WS_WDN, 64 * kb, 32 * nb, (size_t)e * DM + 32 * nb, W8_SCALE, scr, lane); }
    }
}

typedef LAS bf16x8 lbf8; typedef LAS v4u lv4u;
#define MFMA32(a, b, c) __builtin_amdgcn_mfma_f32_32x32x16_bf16(a, b, c, 0, 0, 0)
#define MFMA16(a, b, c) __builtin_amdgcn_mfma_f32_16x16x32_bf16(a, b, c, 0, 0, 0)
__device__ __forceinline__ int crow32(int r, int hi) { return (r & 3) + 8 * (r >> 2) + 4 * hi; }
__device__ __forceinline__ void hgrn_a_unit(int bh, int c, const bf16* HK, const bf16* HG, const bf16* HV, bf16* DS, float* DEC, LAS unsigned char* lds, int tid) {
    LAS float* part = (LAS float*)lds; LAS bf16* KT = (LAS bf16*)(lds + 2048); LAS bf16* VT = (LAS bf16*)(lds + 2048 + 18432);
    const int k = tid & 127, sq = tid >> 7, lane = tid & 63, w = __builtin_amdgcn_readfirstlane(tid >> 6);
    const size_t row0 = ((size_t)bh * PKV + 64 * c + 16 * sq) * 128 + k;
    float g[16], kv[16]; unsigned vv[16];
#pragma unroll
    for (int i = 0; i < 16; ++i) { g[i] = bf2f(HG[row0 + i * 128]); kv[i] = bf2f(HK[row0 + i * 128]); vv[i] = HV[row0 + i * 128]; }
    float run = 0.f;
#pragma unroll
    for (int i = 0; i < 16; ++i) { run += g[i]; g[i] = run; }
    part[sq * 128 + k] = run;
    __syncthreads();
    float off = 0.f, tot = 0.f;
#pragma unroll
    for (int j = 0; j < 4; ++j) { const float p = part[j * 128 + k]; tot += p; off += (j < sq) ? p : 0.f; }
    unsigned kw[8], vw[8];
#pragma unroll
    for (int i = 0; i < 8; ++i) { kw[i] = pk2(kv[2 * i] * __expf(tot - off - g[2 * i]), kv[2 * i + 1] * __expf(tot - off - g[2 * i + 1])); vw[i] = vv[2 * i] | (vv[2 * i + 1] << 16); }
    *(lv4u*)(KT + k * 72 + 16 * sq) = (v4u){kw[0], kw[1], kw[2], kw[3]}; *(lv4u*)(KT + k * 72 + 16 * sq + 8) = (v4u){kw[4], kw[5], kw[6], kw[7]};
    *(lv4u*)(VT + k * 72 + 16 * sq) = (v4u){vw[0], vw[1], vw[2], vw[3]}; *(lv4u*)(VT + k * 72 + 16 * sq + 8) = (v4u){vw[4], vw[5], vw[6], vw[7]};
    if (sq == 0) DEC[((size_t)bh * NCHK + c) * 128 + k] = __expf(tot);
    __syncthreads();
    const int k0 = 32 * (w & 3), vb = 64 * (w >> 2), li = lane & 31, hi = lane >> 5;
    f32x16 a0 = {}, a1 = {};
#pragma unroll
    for (int ks = 0; ks < 4; ++ks) { const bf16x8 av = *(const lbf8*)(KT + (k0 + li) * 72 + 16 * ks + 8 * hi);
        const bf16x8 b0 = *(const lbf8*)(VT + (vb + li) * 72 + 16 * ks + 8 * hi), b1 = *(const lbf8*)(VT + (vb + 32 + li) * 72 + 16 * ks + 8 * hi);
        a0 = MFMA32(av, b0, a0); a1 = MFMA32(av, b1, a1); }
    bf16* dst = DS + ((size_t)bh * NCHK + c) * 16384;
#pragma unroll
    for (int j = 0; j < 4; ++j) { const int kk = k0 + 8 * j + 4 * hi;
        *(v2u*)(dst + (size_t)(vb + li) * 128 + kk) = (v2u){pk2(a0[4 * j], a0[4 * j + 1]), pk2(a0[4 * j + 2], a0[4 * j + 3])};
        *(v2u*)(dst + (size_t)(vb + 32 + li) * 128 + kk) = (v2u){pk2(a1[4 * j], a1[4 * j + 1]), pk2(a1[4 * j + 2], a1[4 * j + 3])}; }
    __syncthreads();
}
__device__ __forceinline__ void hgrn_b_scan(bf16* DS, const float* DEC, long gid, long NG) {
    for (long idx = gid; idx < 64L * 128 * 16; idx += NG) {
        const int bh = (int)(idx >> 11), rem = (int)(idx & 2047), v = rem >> 4, k8 = (rem & 15) * 8;
        float S[8];
#pragma unroll
        for (int j = 0; j < 8; ++j) S[j] = 0.f;
        bf16* p = DS + ((size_t)bh * NCHK * 128 + v) * 128 + k8; const float* dp = DEC + (size_t)bh * NCHK * 128 + k8;
        for (int c = 0; c < NCHK; c += 4) {
            v4u d[4]; f32x4 e0[4], e1[4];
#pragma unroll
            for (int u = 0; u < 4; ++u) { d[u] = *(const v4u*)(p + (size_t)(c + u) * 16384); e0[u] = *(const f32x4*)(dp + (c + u) * 128); e1[u] = *(const f32x4*)(dp + (c + u) * 128 + 4); }
#pragma unroll
            for (int u = 0; u < 4; ++u) {
                S[0] = e0[u][0] * S[0] + bf_lo(d[u].x); S[1] = e0[u][1] * S[1] + bf_hi(d[u].x); S[2] = e0[u][2] * S[2] + bf_lo(d[u].y); S[3] = e0[u][3] * S[3] + bf_hi(d[u].y);
                S[4] = e1[u][0] * S[4] + bf_lo(d[u].z); S[5] = e1[u][1] * S[5] + bf_hi(d[u].z); S[6] = e1[u][2] * S[6] + bf_lo(d[u].w); S[7] = e1[u][3] * S[7] + bf_hi(d[u].w);
                *(v4u*)(p + (size_t)(c + u) * 16384) = (v4u){pk2(S[0], S[1]), pk2(S[2], S[3]), pk2(S[4], S[5]), pk2(S[6], S[7])}; }
        }
    }
}
struct HcArgs { const bf16 *HQ, *HK, *HG, *HV, *DS, *OP, *OG, *GA, *GH; bf16* Y; const float *subln, *hgn; float lam; };
__device__ __forceinline__ void hgrn_c_unit(const HcArgs& A, int b, int c, int hp, LAS unsigned char* lds, int tid) {
    LAS bf16* QI = (LAS bf16*)lds;
    LAS bf16* VT = (LAS bf16*)(lds + 17408);
    LAS bf16* AT = (LAS bf16*)(lds + 35840);
    LAS bf16* ST = (LAS bf16*)(lds + 45056);
    LAS bf16* QR = (LAS bf16*)(lds + 79872);
    LAS bf16* KR = (LAS bf16*)(lds + 97280);
    LAS float* OT = (LAS float*)(lds + 79872);
    LAS float* part = (LAS float*)(lds + 140800);
    const int lane = tid & 63, w = __builtin_amdgcn_readfirstlane(tid >> 6);
    const int t8 = tid >> 3, j8 = tid & 7;
    const size_t m = (size_t)b * SEQ + 64 * (c - 1) + t8;
    float an[32];
    { float ss = 0.f;
#pragma unroll
      for (int half = 0; half < 2; ++half) {
          const bf16* p0 = A.OP + ((size_t)(b * 32 + (2 * hp) * 2 + half) * SEQ + 64 * (c - 1) + t8) * 128 + 16 * j8;
          const bf16* p1 = A.OP + ((size_t)(b * 32 + (2 * hp + 1) * 2 + half) * SEQ + 64 * (c - 1) + t8) * 128 + 16 * j8;
          const v4u x0 = *(const v4u*)p0, x1 = *(const v4u*)(p0 + 8), y0 = *(const v4u*)p1, y1 = *(const v4u*)(p1 + 8);
          const unsigned xs[8] = {x0.x, x0.y, x0.z, x0.w, x1.x, x1.y, x1.z, x1.w}, ys[8] = {y0.x, y0.y, y0.z, y0.w, y1.x, y1.y, y1.z, y1.w};
#pragma unroll
          for (int i = 0; i < 8; ++i) { const float a0 = bf_lo(xs[i]) - A.lam * bf_lo(ys[i]), a1 = bf_hi(xs[i]) - A.lam * bf_hi(ys[i]); an[16 * half + 2 * i] = a0; an[16 * half + 2 * i + 1] = a1; ss += a0 * a0 + a1 * a1; } }
      ss += __shfl_xor(ss, 1); ss += __shfl_xor(ss, 2); ss += __shfl_xor(ss, 4);
      const float rs = __builtin_amdgcn_rsqf(ss * (1.f / 256.f) + RMS_EPS) * (1.f - LAMBDA_INIT);
#pragma unroll
      for (int half = 0; half < 2; ++half)
#pragma unroll
          for (int q = 0; q < 4; ++q) { const f32x4 g = *(const f32x4*)(A.subln + 128 * half + 16 * j8 + 4 * q);
#pragma unroll
              for (int i = 0; i < 4; ++i) an[16 * half + 4 * q + i] *= rs * g[i]; } }
#pragma unroll
    for (int hi2 = 0; hi2 < 2; ++hi2) {
        const int hh = 2 * hp + hi2, bh = b * 16 + hh;
        const int k = tid & 127, sq = tid >> 7;
        const size_t row0 = ((size_t)bh * PKV + 64 * c + 16 * sq) * 128 + k;
        float g[16], qv[16], kv[16]; unsigned vv[16];
#pragma unroll
        for (int i = 0; i < 16; ++i) { g[i] = bf2f(A.HG[row0 + i * 128]); qv[i] = bf2f(A.HQ[row0 + i * 128]); kv[i] = bf2f(A.HK[row0 + i * 128]); vv[i] = A.HV[row0 + i * 128]; }
        v4u sp[4];
        { const bf16* sp0 = A.DS + ((size_t)bh * NCHK + (c - 1)) * 16384;
#pragma unroll
          for (int j = 0; j < 4; ++j) sp[j] = *(const v4u*)(sp0 + (size_t)(tid + 512 * j) * 8); }
        float run = 0.f;
#pragma unroll
        for (int i = 0; i < 16; ++i) { run += g[i]; g[i] = run; }
        part[sq * 128 + k] = run;
        *(lv4u*)(AT + t8 * 72 + 8 * j8) = (v4u){0u, 0u, 0u, 0u};
        __syncthreads();
        float E[4];
        { float s = 0.f;
#pragma unroll
          for (int j = 0; j < 4; ++j) { s += part[j * 128 + k]; E[j] = s; } }
        const float off = sq == 0 ? 0.f : sq == 1 ? E[0] : sq == 2 ? E[1] : E[2];
#pragma unroll
        for (int i = 0; i < 16; ++i) { const int t = 16 * sq + i;
            QI[t * 136 + k] = (bf16)f2bf(qv[i] * __expf(off + g[i]));
            QR[t * 136 + k] = (bf16)f2bf(qv[i] * __expf(g[i])); }
#pragma unroll
        for (int ip = 0; ip < 4; ++ip) if (ip >= sq) {
            const float ep = ip == 0 ? 0.f : E[ip - 1]; const int rb = ip == 0 ? 0 : ip == 1 ? 16 : ip == 2 ? 48 : 96;
#pragma unroll
            for (int i = 0; i < 16; ++i) KR[(rb + 16 * sq + i) * 136 + k] = (bf16)f2bf(kv[i] * __expf(ep - off - g[i])); }
        { unsigned vw[8];
#pragma unroll
          for (int i = 0; i < 8; ++i) vw[i] = vv[2 * i] | (vv[2 * i + 1] << 16);
          *(lv4u*)(VT + k * 72 + 16 * sq) = (v4u){vw[0], vw[1], vw[2], vw[3]}; *(lv4u*)(VT + k * 72 + 16 * sq + 8) = (v4u){vw[4], vw[5], vw[6], vw[7]}; }
#pragma unroll
        for (int j = 0; j < 4; ++j) { const int q4 = tid + 512 * j; *(lv4u*)(ST + (q4 >> 4) * 136 + (q4 & 15) * 8) = sp[j]; }
        __syncthreads();
#pragma unroll
        for (int rep = 0; rep < 2; ++rep) { const int tl = w + 8 * rep;
            if (tl < 10) { const int ip = tl >= 6 ? 3 : tl >= 3 ? 2 : tl >= 1 ? 1 : 0, jp = tl - (ip == 3 ? 6 : ip == 2 ? 3 : ip == 1 ? 1 : 0), rb = ip == 0 ? 0 : ip == 1 ? 16 : ip == 2 ? 48 : 96;
                const int r = lane & 15, q = lane >> 4; f32x4 sa = {0.f, 0.f, 0.f, 0.f};
#pragma unroll
                for (int ks = 0; ks < 4; ++ks) { const bf16x8 av = *(const lbf8*)(QR + (16 * ip + r) * 136 + 32 * ks + 8 * q), bv = *(const lbf8*)(KR + (rb + 16 * jp + r) * 136 + 32 * ks + 8 * q); sa = MFMA16(av, bv, sa); }
#pragma unroll
                for (int i = 0; i < 4; ++i) { const float val = (jp == ip && r > 4 * q + i) ? 0.f : sa[i]; AT[(16 * ip + 4 * q + i) * 72 + 16 * jp + r] = (bf16)f2bf(val); } } }
        __syncthreads();
        { const int t0 = 32 * (w & 1), v0 = 32 * (w >> 1), li = lane & 31, hi = lane >> 5; f32x16 o = {};
#pragma unroll
          for (int ks = 0; ks < 8; ++ks) o = MFMA32(*(const lbf8*)(QI + (t0 + li) * 136 + 16 * ks + 8 * hi), *(const lbf8*)(ST + (v0 + li) * 136 + 16 * ks + 8 * hi), o);
#pragma unroll
          for (int ks = 0; ks < 4; ++ks) o = MFMA32(*(const lbf8*)(AT + (t0 + li) * 72 + 16 * ks + 8 * hi), *(const lbf8*)(VT + (v0 + li) * 72 + 16 * ks + 8 * hi), o);
#pragma unroll
          for (int r = 0; r < 16; ++r) OT[(t0 + crow32(r, hi)) * 132 + v0 + li] = o[r]; }
        __syncthreads();
        { f32x4 ov[4]; float ss = 0.f;
#pragma unroll
          for (int q = 0; q < 4; ++q) { ov[q] = *(const LAS f32x4*)(OT + t8 * 132 + 16 * j8 + 4 * q); ss += (ov[q][0] * ov[q][0] + ov[q][1] * ov[q][1]) + (ov[q][2] * ov[q][2] + ov[q][3] * ov[q][3]); }
          ss += __shfl_xor(ss, 1); ss += __shfl_xor(ss, 2); ss += __shfl_xor(ss, 4);
          const float rs = __builtin_amdgcn_rsqf(ss * (1.f / 128.f) + RMS_EPS);
          const size_t idx = m * DM + 256 * hp + 128 * hi2 + 16 * j8;
          const v4u og0 = *(const v4u*)(A.OG + idx), og1 = *(const v4u*)(A.OG + idx + 8), ga0 = *(const v4u*)(A.GA + idx), ga1 = *(const v4u*)(A.GA + idx + 8), gh0 = *(const v4u*)(A.GH + idx), gh1 = *(const v4u*)(A.GH + idx + 8);
          const unsigned ogs[8] = {og0.x, og0.y, og0.z, og0.w, og1.x, og1.y, og1.z, og1.w}, gas[8] = {ga0.x, ga0.y, ga0.z, ga0.w, ga1.x, ga1.y, ga1.z, ga1.w}, ghs[8] = {gh0.x, gh0.y, gh0.z, gh0.w, gh1.x, gh1.y, gh1.z, gh1.w};
          unsigned yw[8];
#pragma unroll
          for (int i = 0; i < 8; ++i) { const f32x4 gn = *(const f32x4*)(A.hgn + 16 * j8 + 4 * (i >> 1));
              const float o0 = ov[i >> 1][(2 * i) & 3] * rs * gn[(2 * i) & 3], o1 = ov[i >> 1][(2 * i + 1) & 3] * rs * gn[(2 * i + 1) & 3];
              const float y0 = bf_lo(gas[i]) * an[16 * hi2 + 2 * i] + bf_lo(ghs[i]) * o0 * bf_lo(ogs[i]), y1 = bf_hi(gas[i]) * an[16 * hi2 + 2 * i + 1] + bf_hi(ghs[i]) * o1 * bf_hi(ogs[i]);
              yw[i] = pk2(y0, y1); }
          *(v4u*)(A.Y + idx) = (v4u){yw[0], yw[1], yw[2], yw[3]}; *(v4u*)(A.Y + idx + 8) = (v4u){yw[4], yw[5], yw[6], yw[7]}; }
        __syncthreads();
    }
}

struct P6Args { const float *h2, *norm2, *router_b; const bf16* WR; unsigned char* HG8; float* rstd2; int *assign_e, *assign_rank; float* assign_gate; unsigned* gcnt; };
__device__ __forceinline__ void p6_router(const P6Args& A, LAS unsigned char* ctrl, int vcu, int G, int tid) {
    LAS unsigned* lcount = (LAS unsigned*)(ctrl + 512); LAS unsigned* lbase = (LAS unsigned*)(ctrl + 640);
    const int lane = tid & 63, w = __builtin_amdgcn_readfirstlane(tid >> 6), r = lane & 15, q = lane >> 4;
    if (vcu == 0 && tid < 128) *(v4u*)(A.HG8 + (size_t)MTOK * DM + tid * 16) = (v4u){0u, 0u, 0u, 0u};
    for (int grp = vcu; grp < MTOK / 128; grp += G) {
        if (tid < 32) lcount[tid] = 0u;
        __syncthreads();
        const int m0 = grp * 128 + w * 16; const size_t rowoff = (size_t)(m0 + r) * DM;
        f32x4 acc0 = {0.f, 0.f, 0.f, 0.f}, acc1 = {0.f, 0.f, 0.f, 0.f}; float ss = 0.f;
#pragma unroll 4
        for (int ks = 0; ks < 64; ++ks) { const int k = 32 * ks + 8 * q;
            const f32x4 h0 = *(const f32x4*)(A.h2 + rowoff + k), h1 = *(const f32x4*)(A.h2 + rowoff + k + 4), g0 = *(const f32x4*)(A.norm2 + k), g1 = *(const f32x4*)(A.norm2 + k + 4);
            const bf16x8 b0 = *(const bf16x8*)(A.WR + (size_t)r * DM + k), b1 = *(const bf16x8*)(A.WR + (size_t)(16 + r) * DM + k);
            ss += (h0[0] * h0[0] + h0[1] * h0[1]) + (h0[2] * h0[2] + h0[3] * h0[3]) + (h1[0] * h1[0] + h1[1] * h1[1]) + (h1[2] * h1[2] + h1[3] * h1[3]);
            const v4u xw = {pk2(h0[0] * g0[0], h0[1] * g0[1]), pk2(h0[2] * g0[2], h0[3] * g0[3]), pk2(h1[0] * g1[0], h1[1] * g1[1]), pk2(h1[2] * g1[2], h1[3] * g1[3])};
            *(v2u*)(A.HG8 + rowoff + k) = (v2u){pk4_fp8(h0[0] * g0[0], h0[1] * g0[1], h0[2] * g0[2], h0[3] * g0[3]), pk4_fp8(h1[0] * g1[0], h1[1] * g1[1], h1[2] * g1[2], h1[3] * g1[3])};
            const bf16x8 xa = __builtin_bit_cast(bf16x8, xw);
            acc0 = MFMA16(b0, xa, acc0); acc1 = MFMA16(b1, xa, acc1); }
        ss += __shfl_xor(ss, 16); ss += __shfl_xor(ss, 32);
        const float rs = __builtin_amdgcn_rsqf(ss * (1.f / DM) + RMS_EPS);
        if (q == 0) A.rstd2[m0 + r] = rs;
        float l[8];
        { const f32x4 rb0 = *(const f32x4*)(A.router_b + 4 * q), rb1 = *(const f32x4*)(A.router_b + 16 + 4 * q);
#pragma unroll
          for (int i = 0; i < 4; ++i) { l[i] = acc0[i] * rs + rb0[i]; l[4 + i] = acc1[i] * rs + rb1[i]; } }
        unsigned used = 0u; float tv[4]; int te[4];
#pragma unroll
        for (int kk = 0; kk < 4; ++kk) {
            float bv = -__builtin_inff(); int be = 64;
#pragma unroll
            for (int j = 0; j < 8; ++j) { const int ej = (j < 4 ? 0 : 16) + 4 * q + (j & 3); const bool ok = !((used >> j) & 1u) && l[j] > bv; bv = ok ? l[j] : bv; be = ok ? ej : be; }
#pragma unroll
            for (int o = 16; o <= 32; o <<= 1) { const float ov = __shfl_xor(bv, o); const int oe = __shfl_xor(be, o); const bool tk = ov > bv || (ov == bv && oe < be); bv = tk ? ov : bv; be = tk ? oe : be; }
            tv[kk] = bv; te[kk] = be;
            if (((be & 15) >> 2) == q) used |= 1u << (((be >> 4) << 2) + (be & 3));
        }
        const float e1 = __expf(tv[1] - tv[0]), e2 = __expf(tv[2] - tv[0]), e3 = __expf(tv[3] - tv[0]), inv = 1.f / (1.f + e1 + e2 + e3);
        const int es = q == 0 ? te[0] : q == 1 ? te[1] : q == 2 ? te[2] : te[3];
        const float gs = (q == 0 ? 1.f : q == 1 ? e1 : q == 2 ? e2 : e3) * inv;
        const unsigned lrank = __hip_atomic_fetch_add((unsigned*)(lcount + es), 1u, __ATOMIC_RELAXED, __HIP_MEMORY_SCOPE_WORKGROUP);
        __syncthreads();
        if (tid < 32) lbase[tid] = __hip_atomic_fetch_add(A.gcnt + tid, (unsigned)lcount[tid], __ATOMIC_RELAXED, __HIP_MEMORY_SCOPE_AGENT);
        __syncthreads();
        const int a = (m0 + r) * 4 + q;
        A.assign_e[a] = es; A.assign_rank[a] = (int)(lbase[es] + lrank); A.assign_gate[a] = gs;
        __syncthreads();
    }
}
__device__ __forceinline__ void moe_tstart(const unsigned* gcnt, LAS int* tstart, int tid) {
    if (tid == 0) { int s = 0;
        for (int e = 0; e < NE; ++e) { tstart[e] = s; s += (int)((__hip_atomic_load(gcnt + e, __ATOMIC_RELAXED, __HIP_MEMORY_SCOPE_AGENT) + 255u) >> 8); }
        tstart[NE] = s; }
    __syncthreads();
}

namespace att {
struct Tensors { const bf16* Q; const bf16* K; const bf16* V; bf16* O; const float* bt; };
__device__ __forceinline__ BlockRef<bf16, bf16> mkref(const Tensors& T, int id, int pass) {
    const int grp = id >> 6, w = id & 63, b = grp >> 3, h = grp & 7, sub = w >> 4, map = sub >> 1, half = sub & 1, y = w & 15, qb = pass ? 31 - y : y;
    BlockRef<bf16, bf16> r;
    r.Q = T.Q + ((size_t)(b * 16 + 2 * h + map) * SEQ_ + (size_t)qb * QB) * D;
    r.K = T.K + (size_t)(b * 16 + 2 * h + map) * PKV_ * D;
    r.V = T.V + (size_t)(b * 16 + 2 * h + half) * PKV_ * D;
    r.O = T.O + ((size_t)(b * 32 + (2 * h + map) * 2 + half) * SEQ_ + (size_t)qb * QB) * D;
    r.P0 = 64 + qb * QB; r.bt = T.bt + h * BT_LEN;
    return r;
}
__device__ __forceinline__ int item_id(int i, int c, int G) {
    if (G == 256) return i < 8 ? (c & 7) * 256 + i * 32 + (c >> 3) : -1;
    const long L = (long)i * G + c; return L < 2048 ? (int)L : -1;
}
__device__ __forceinline__ void attn_phase(char* lds, const Tensors& T, int G, int c) {
    constexpr int W = 1 << 30;
    int i = 0, id = item_id(0, c, G); if (id < 0) return;
    int pass = 0;
    BlockRef<bf16, bf16> cur = mkref(T, id, 0);
    Seam<bf16> S;
    causal_swa_prime<bf16, bf16>(cur, W, lds, S);
    for (;;) {
        const int idn = item_id(i + 1, c, G);
        const bool more_pass = pass == 0, more_item = idn >= 0, last = !more_pass && !more_item;
        const BlockRef<bf16, bf16> nxt = last ? cur : (more_pass ? mkref(T, id, 1) : mkref(T, idn, 0));
        causal_swa_block<bf16, bf16>(cur, nxt, PKV_, W, lds, S);
        if (last) break;
        cur = nxt; if (more_pass) pass = 1; else { pass = 0; id = idn; ++i; }
    }
}
}

struct Args { const float* in[19]; float* out; unsigned char* ws; int ph_lo, ph_hi, li, pad; };
#define ARG(k) argp(args, k)
__device__ __forceinline__ unsigned char* wsp(const Args& a) { int k = 0; asm volatile("" : "+s"(k)); return (&a.ws)[k]; }
__device__ __forceinline__ float* outp(const Args& a) { int k = 0; asm volatile("" : "+s"(k)); return (&a.out)[k]; }
__device__ __forceinline__ const float* argp(const Args& a, int k) { asm volatile("" : "+s"(k)); return a.in[k]; }
__global__ void __launch_bounds__(NTHR, 2) hyb_fwd(Args args) {
    extern __shared__ __attribute__((aligned(16))) unsigned char lds_raw[];
    LAS unsigned char* lds = (LAS unsigned char*)lds_raw;
    const int G = gridDim.x, bx = blockIdx.x;
    { unsigned char* ws0 = args.ws;
      int t0_ = threadIdx.x; asm volatile("" : "+v"(t0_));
      for (int u = t0_; u < (LDS_BYTES - CTRL_OFF) / 4; u += NTHR) ((LAS unsigned*)(lds + CTRL_OFF))[u] = 0u;
      __syncthreads(); (void)ws0; }
    XcdBarrier bar; bar.bar = (unsigned*)(args.ws + WS_CTL) + CW_BAR; bar.x = 0; bar.st = nullptr;
    if (N_LAUNCHES == 1) bar = xcd_barrier_post((unsigned*)(args.ws + WS_CTL) + CW_BAR, (volatile LAS unsigned*)(lds + CTRL_OFF));
#define GRID_BAR() do { if (N_LAUNCHES == 1) xcd_barrier(bar); } while (0)
    const int lo = args.ph_lo, hi = args.ph_hi;
#ifndef PH_MASK
#define PH_MASK 0x7ff
#endif
#define IN(k) (((PH_MASK >> (k)) & 1) && lo <= (k) && (k) < hi)
#define BOTH(k) (IN(k) && IN((k) + 1))
#define PHASE_LOCALS() int tid_ = threadIdx.x; asm volatile("" : "+v"(tid_)); const int tid = tid_, lane = tid & 63, wave = __builtin_amdgcn_readfirstlane(tid >> 6); (void)lane; (void)wave; \
    const int vcu = (G % 8 == 0) ? (bx % 8) * (G / 8) + bx / 8 : bx; (void)vcu; unsigned char* ws = wsp(args); (void)ws; \
    const int gw = vcu * NWAVES + wave, NGW = G * NWAVES; const long gid = (long)vcu * NTHR + tid, NG = (long)G * NTHR; (void)gw; (void)NGW; (void)gid; (void)NG
#define QH ((bf16*)(ws + WS_QH))
#define KH ((bf16*)(ws + WS_KH))
#define VH ((bf16*)(ws + WS_VH))
#define HQ ((bf16*)(ws + WS_HQ))
#define HK ((bf16*)(ws + WS_HK))
#define HGT ((bf16*)(ws + WS_HGT))
#define HV ((bf16*)(ws + WS_HV))
#define OG ((bf16*)(ws + WS_OG))
#define GA ((bf16*)(ws + WS_GA))
#define GH ((bf16*)(ws + WS_GH))
#define OP ((bf16*)(ws + WS_OP))
#define DS ((bf16*)(ws + WS_DS))
#define DEC ((float*)(ws + WS_DEC))
#define GCNT ((unsigned*)(ws + WS_CTL) + CW_CNT)
#define TSTART ((LAS int*)(lds + CTRL_OFF + 256))
#define OUTP outp(args)

    if (IN(0)) { PHASE_LOCALS();
        P0Args a{ARG(0), ARG(1), ARG(2), ARG(3), ARG(4), ARG(5), ARG(8), ARG(11), ARG(13), ARG(15), ARG(17), ws};
        p0_prologue(a, lds, vcu, G, tid);
        if (BOTH(0)) GRID_BAR();
    }
    if (IN(1)) { PHASE_LOCALS();
        SchedInProj S{G, bx, (const bf16*)(ws + WS_WIN)};
        EpiInProj E{ws, ARG(6), ARG(7), (const float*)(ws + SM_LB), (LAS float*)(lds + XCH_OFF)};
        pg8::gemm_phase<EpiInProj, SchedInProj, false>(lds, (const bf16*)(ws + WS_U), DM, S, E);
        if (BOTH(1)) GRID_BAR();
    }
    if (IN(2)) { PHASE_LOCALS();
        for (int u = vcu; u < 64 * NCHK; u += G) hgrn_a_unit(u / NCHK, u % NCHK, HK, HGT, HV, DS, DEC, lds, tid);
        const att::Tensors T{QH, KH, VH, OP, (const float*)(ws + SM_BT)};
        att::attn_phase((char*)lds_raw, T, G, bx);
        if (BOTH(2)) GRID_BAR();
    }
    if (IN(3)) { PHASE_LOCALS(); hgrn_b_scan(DS, DEC, gid, NG); if (BOTH(3)) GRID_BAR(); }
    if (IN(4)) { PHASE_LOCALS();
        const HcArgs A{HQ, HK, HGT, HV, DS, OP, OG, GA, GH, (bf16*)(ws + WS_Y), ARG(9), ARG(10), *(const float*)(ws + SM_LAM)};
        for (int u = vcu; u < NB * NCHK * 8; u += G) { const int hp = u & 7, c = ((u >> 3) % NCHK) + 1, b = (u >> 3) / NCHK; hgrn_c_unit(A, b, c, hp, lds, tid); }
        if (BOTH(4)) GRID_BAR();
    }
    if (IN(5)) { PHASE_LOCALS();
        SchedPlain S{G, bx, MTOK / 256, DM / 256, (const bf16*)(ws + WS_WOUT)};
        EpiOutProj E{ARG(0), OUTP};
        pg8::gemm_phase<EpiOutProj, SchedPlain, false>(lds, (const bf16*)(ws + WS_Y), DM, S, E);
        if (BOTH(5)) GRID_BAR();
    }
    if (IN(6)) { PHASE_LOCALS();
        const P6Args A{OUTP, ARG(12), ARG(14), (const bf16*)(ws + WS_WR), ws + WS_HG8, (float*)(ws + SM_RSTD), (int*)(ws + SM_AE), (int*)(ws + SM_AR), (float*)(ws + SM_AG), GCNT};
        p6_router(A, lds + CTRL_OFF, vcu, G, tid);
        if (BOTH(6)) GRID_BAR();
    }
    if (IN(7)) { PHASE_LOCALS();
        moe_tstart(GCNT, TSTART, tid);
        const int* ae = (const int*)(ws + SM_AE); const int* ar = (const int*)(ws + SM_AR); const float* ag = (const float*)(ws + SM_AG); const float* rstd2 = (const float*)(ws + SM_RSTD);
        int* slot_tok = (int*)(ws + SM_ST); float* slot_rstd = (float*)(ws + SM_SR); float* slot_gate = (float*)(ws + SM_SG); int* tok_slot = (int*)(ws + SM_TS);
        for (long a = gid; a < NASSIGN; a += NG) { const int e = ae[a], slot = TSTART[e] * 256 + ar[a], t = (int)(a >> 2);
            slot_tok[slot] = t; slot_rstd[slot] = rstd2[t]; slot_gate[slot] = ag[a]; tok_slot[a] = slot; }
        if (BOTH(7)) GRID_BAR();
    }
    if (IN(8)) { PHASE_LOCALS();
        moe_tstart(GCNT, TSTART, tid);
        SchedMoE S{G, bx, DFF / 128, TSTART, ws + WS_WGU, (size_t)2 * DFF * DM, (size_t)256 * DM, (const int*)(ws + SM_ST)};
        EpiGateUp E{ARG(16), (const float*)(ws + SM_SR), ws + WS_ACT};
        pg8::gemm_phase<EpiGateUp, SchedMoE, true, true>(lds, (const bf16*)(ws + WS_HG8), DM / 2, S, E);
        if (BOTH(8)) GRID_BAR();
    }
    if (IN(9)) { PHASE_LOCALS();
        moe_tstart(GCNT, TSTART, tid);
        SchedMoE S{G, bx, DM / 256, TSTART, ws + WS_WDN, (size_t)DM * DFF, (size_t)256 * DFF, nullptr};
        EpiDown E{ARG(18), (const float*)(ws + SM_SG), (bf16*)(ws + WS_YS)};
        pg8::gemm_phase<EpiDown, SchedMoE, false, true>(lds, (const bf16*)(ws + WS_ACT), DFF / 2, S, E);
        if (BOTH(9)) GRID_BAR();
    }
    if (IN(10)) { PHASE_LOCALS();
        const int* tok_slot = (const int*)(ws + SM_TS); const bf16* YS = (const bf16*)(ws + WS_YS);
        float* out = OUTP;
        for (int m = gw; m < MTOK; m += NGW) {
            const int s0 = tok_slot[4 * m], s1 = tok_slot[4 * m + 1], s2 = tok_slot[4 * m + 2], s3 = tok_slot[4 * m + 3];
#pragma unroll
            for (int j = 0; j < 4; ++j) { const int col = lane * 8 + 512 * j; float* op = out + (size_t)m * DM + col;
                f32x4 o0 = *(const f32x4*)op, o1 = *(const f32x4*)(op + 4);
                const v4u y0 = *(const v4u*)(YS + (size_t)s0 * DM + col), y1 = *(const v4u*)(YS + (size_t)s1 * DM + col), y2 = *(const v4u*)(YS + (size_t)s2 * DM + col), y3 = *(const v4u*)(YS + (size_t)s3 * DM + col);
#define ADDY(Q_) do { o0[0] += bf_lo(Q_.x); o0[1] += bf_hi(Q_.x); o0[2] += bf_lo(Q_.y); o0[3] += bf_hi(Q_.y); o1[0] += bf_lo(Q_.z); o1[1] += bf_hi(Q_.z); o1[2] += bf_lo(Q_.w); o1[3] += bf_hi(Q_.w); } while (0)
                ADDY(y0); ADDY(y1); ADDY(y2); ADDY(y3);
#undef ADDY
                *(f32x4*)op = o0; *(f32x4*)(op + 4) = o1; }
        }
    }
#undef IN
#undef BOTH
#undef GRID_BAR
}


#ifdef DBG_DUMP
__global__ void dbg_dump(const unsigned char* ws, float* out, unsigned mask) {
    const size_t offs[16] = {WS_U, WS_WIN, WS_QH, WS_KH, WS_VH, WS_HQ, WS_HK, WS_HGT, WS_HV, WS_OG, WS_GA, WS_GH, WS_OP, WS_DS, WS_Y, WS_WOUT};
    for (size_t i = (size_t)blockIdx.x * blockDim.x + threadIdx.x; i < (size_t)MTOK * DM; i += (size_t)gridDim.x * blockDim.x) {
        float s = 0.f;
        for (int b = 0; b < 16; ++b) if ((mask >> b) & 1u) { size_t j = i; if (b == 15) j = i & (size_t)(DM * DM - 1); if (b == 12 || b == 13) j = i * 2 + ((mask >> 16) & 1u); s += bf2f(((const bf16*)(ws + offs[b]))[j]); }
        out[i] = s;
    }
}
#endif
#ifndef DBG_NLAUNCH
#define DBG_NLAUNCH NPHASE
#endif
extern "C" void kernel_launch(void* const* d_in, const int* in_sizes, int n_in, void* d_out, int out_size, void* d_ws, size_t ws_size, hipStream_t stream) {
    static int grid = 0;
    if (grid == 0) {
        if (n_in != 19 || in_sizes[0] != MTOK * DM || out_size != MTOK * DM || ws_size < WS_END) { fprintf(stderr, "kernel_launch: unexpected shapes (n_in %d, in0 %d, out %d, ws %zu < %zu); nothing launched\n", n_in, n_in > 0 ? in_sizes[0] : -1, out_size, ws_size, (size_t)WS_END); grid = -1; return; }
        int dev = 0, cus = 0, per_cu = 0;
        if (hipGetDevice(&dev) != hipSuccess || hipDeviceGetAttribute(&cus, hipDeviceAttributeMultiprocessorCount, dev) != hipSuccess) { fprintf(stderr, "kernel_launch: device query failed\n"); grid = -1; return; }
        if (hipFuncSetAttribute((const void*)hyb_fwd, hipFuncAttributeMaxDynamicSharedMemorySize, LDS_BYTES) != hipSuccess) { fprintf(stderr, "kernel_launch: hipFuncSetAttribute(%d) failed\n", LDS_BYTES); grid = -1; return; }
        if (hipOccupancyMaxActiveBlocksPerMultiprocessor(&per_cu, (const void*)hyb_fwd, NTHR, LDS_BYTES) != hipSuccess || per_cu < 1) { fprintf(stderr, "kernel_launch: occupancy query says %d workgroups per CU\n", per_cu); (void)hipGetLastError(); if (per_cu < 1) { grid = -1; return; } }
        grid = cus;
    }
    if (grid < 0) return;
    if (hipMemsetAsync((char*)d_ws + WS_CTL, 0, CTL_ZERO_BYTES, stream) != hipSuccess) { fprintf(stderr, "kernel_launch: memset failed\n"); return; }
    Args a{};
    for (int i = 0; i < 19; ++i) a.in[i] = (const float*)d_in[i];
    a.out = (float*)d_out; a.ws = (unsigned char*)d_ws;
    for (int li = 0; li < (N_LAUNCHES == 1 ? 1 : DBG_NLAUNCH); ++li) {
        a.ph_lo = (N_LAUNCHES == 1) ? 0 : li; a.ph_hi = (N_LAUNCHES == 1) ? NPHASE : li + 1; a.li = li; a.pad = 0;
        hipLaunchKernelGGL(hyb_fwd, dim3(grid), dim3(NTHR), LDS_BYTES, stream, a);
        const hipError_t le = hipPeekAtLastError();
        if (le != hipSuccess) { fprintf(stderr, "kernel_launch: launch %d failed: %s\n", li, hipGetErrorName(le)); break; }
    }
#ifdef DBG_DUMP
    hipLaunchKernelGGL(dbg_dump, dim3(2048), dim3(256), 0, stream, (const unsigned char*)d_ws, (float*)d_out, (unsigned)DBG_DUMP);
#endif
}
```

```cpp
#include <hip/hip_runtime.h>
#include <cstdio>
#include <cstdint>

namespace pg8 {
#define PG8_LAS __attribute__((address_space(3)))
typedef unsigned short bf16_t;
typedef short bf16x8 __attribute__((ext_vector_type(8)));
typedef float f32x4 __attribute__((ext_vector_type(4)));
typedef unsigned u32x4 __attribute__((ext_vector_type(4)));
constexpr int BM = 256, BK = 64, HALF = 128, HTB = HALF * BK * 2  , STAGE_BYTES = 8 * HTB;

__host__ __device__ __forceinline__ int lds_byte(int r, int c) { const int st = (r >> 4) * 2 + (c >> 5), rr = r & 15, cc = c & 31, ob = rr * 64 + cc * 2; return st * 1024 + (ob ^ (((ob >> 9) & 1) << 5)); }
__host__ __device__ __forceinline__ void stage_rc(int b, int& R, int& C) { const int st = b / 1024, sb = b % 1024, swz = sb ^ (((sb >> 9) & 1) << 5); R = (st >> 1) * 16 + swz / 64; C = (st & 1) * 32 + (swz % 64) / 2; }
__host__ __device__ __forceinline__ int perm32(int rho) { const int n = rho >> 4, i = rho & 15; return 8 * (i >> 2) + 4 * n + (i & 3); }

struct Unit { int pm, pn, e, aux, par; };

__device__ __forceinline__ unsigned cvt_pk_bf16(float lo, float hi) { unsigned r; asm volatile("v_cvt_pk_bf16_f32 %0, %1, %2" : "=v"(r) : "v"(lo), "v"(hi)); return r; }

typedef int i32x4 __attribute__((ext_vector_type(4)));
typedef int i32x8 __attribute__((ext_vector_type(8)));
template <class Epi, class Sched, bool GATHER, bool FP8 = false>
__device__ __forceinline__ void gemm_phase(PG8_LAS unsigned char* lds, const bf16_t* Abase, const int K, const Sched& S, const Epi& E, const unsigned stagger_ticks = 0u) {
    if (stagger_ticks) { const unsigned long long t0_ = __builtin_amdgcn_s_memrealtime(); while (__builtin_amdgcn_s_memrealtime() - t0_ < stagger_ticks) __builtin_amdgcn_s_sleep(8); }
    const int tid = threadIdx.x, wid = __builtin_amdgcn_readfirstlane(tid >> 6), lane = tid & 63, wr = wid >> 2, wc = wid & 3, fr = lane & 15, fq = lane >> 4;
    const int nt = K / BK;
    int Rr[2]; unsigned cb[2], voffB[2], voffA[2];
#pragma unroll
    for (int i = 0; i < 2; ++i) { int R, C; stage_rc(tid * 16 + i * 8192, R, C); const int Rb = Epi::PERM ? ((R & ~31) + perm32(R & 31)) : R;
        Rr[i] = R; cb[i] = (unsigned)C * 2u; voffB[i] = (unsigned)(Rb * K + C) * 2u; voffA[i] = (unsigned)(R * K + C) * 2u; }
    const unsigned rowB = (unsigned)K * 2u;
    const unsigned kstep = (unsigned)(BK * 2);
    const unsigned hstep = (unsigned)HALF * (unsigned)K * 2u;
    const __amdgpu_buffer_rsrc_t rsA = __builtin_amdgcn_make_buffer_rsrc((void*)Abase, (short)0, -1, 0x00020000), rsB = __builtin_amdgcn_make_buffer_rsrc((void*)S.bbase(), (short)0, -1, 0x00020000);
    const unsigned ldsw = (unsigned)wid * 1024u;
    const int aoff = lds_byte(wr * 64 + fr, fq * 8), boff = lds_byte(wc * 32 + fr, fq * 8);
#define PG8_SA(b, h) (((b) * 2 + (h)) * HTB)
#define PG8_SB(b, h) ((4 + (b) * 2 + (h)) * HTB)
#define PG8_STAGE(bufoff, rs, soff, voff) do { _Pragma("unroll") for (int _i = 0; _i < 2; ++_i) \
        __builtin_amdgcn_raw_ptr_buffer_load_lds((rs), (PG8_LAS unsigned*)(lds + (bufoff) + ldsw + _i * 8192), 16, (int)(voff)[_i], (int)(soff), 0, 0); } while (0)
#define PG8_LD8(off) __builtin_shufflevector(*(const PG8_LAS i32x4*)(lds + (off)), *(const PG8_LAS i32x4*)(lds + (off) + 1024), 0, 1, 2, 3, 4, 5, 6, 7)
#define PG8_LDA(dst, b, h) do { _Pragma("unroll") for (int m = 0; m < 4; ++m) { if constexpr (FP8) dst##8[m] = PG8_LD8(PG8_SA(b, h) + aoff + m * 2048); else { _Pragma("unroll") for (int k = 0; k < 2; ++k) dst[m][k] = *(const PG8_LAS bf16x8*)(lds + PG8_SA(b, h) + aoff + m * 2048 + k * 1024); } } } while (0)
#define PG8_LDB(dst, b, h) do { _Pragma("unroll") for (int n = 0; n < 2; ++n) { if constexpr (FP8) dst##8[n] = PG8_LD8(PG8_SB(b, h) + boff + n * 2048); else { _Pragma("unroll") for (int k = 0; k < 2; ++k) dst[n][k] = *(const PG8_LAS bf16x8*)(lds + PG8_SB(b, h) + boff + n * 2048 + k * 1024); } } } while (0)
#define PG8_MMA(ai, bj, At, Bt) do { __builtin_amdgcn_s_setprio(1); _Pragma("unroll") for (int m = 0; m < 4; ++m) _Pragma("unroll") for (int n = 0; n < 2; ++n) { \
        if constexpr (FP8) asm volatile("v_mfma_scale_f32_16x16x128_f8f6f4 %0, %1, %2, %0, %3, %3 op_sel_hi:[0,0,0]" : "+v"(acc[ai][bj][m][n]) : "v"(Bt##8[n]), "v"(At##8[m]), "v"(sc8)); \
        else { _Pragma("unroll") for (int k = 0; k < 2; ++k) acc[ai][bj][m][n] = __builtin_amdgcn_mfma_f32_16x16x32_bf16(Bt[n][k], At[m][k], acc[ai][bj][m][n], 0, 0, 0); } } __builtin_amdgcn_s_setprio(0); } while (0)
#define PG8_WAIT_V(n) asm volatile("s_waitcnt vmcnt(" #n ")" ::: "memory")
#define PG8_WAIT_L(n) asm volatile("s_waitcnt lgkmcnt(" #n ")" ::: "memory")
#define PG8_BAR __builtin_amdgcn_s_barrier()
#define PG8_SCHED __builtin_amdgcn_sched_barrier(0)
#define PG8_VA(dst, u) do { if constexpr (GATHER) { _Pragma("unroll") for (int _h = 0; _h < 2; ++_h) _Pragma("unroll") for (int _i = 0; _i < 2; ++_i) dst[_h][_i] = S.arow(u, _h * HALF + Rr[_i]) * rowB + cb[_i]; } } while (0)
#define PG8_STAGE_A(bufoff, h, base, vsel) do { if constexpr (GATHER) PG8_STAGE(bufoff, rsA, base, vsel[h]); else PG8_STAGE(bufoff, rsA, (base) + (h) * hstep, voffA); } while (0)
#define PG8_STAGE_B(bufoff, base) PG8_STAGE(bufoff, rsB, base, voffB)
    Unit cur, nxt; int ui = 0;
    if (!S.next(0, cur)) return;
    cur.par = 0; E.prefetch(cur, wid, lane);
    f32x4 acc[2][2][4][2];
#pragma unroll
    for (int a = 0; a < 2; ++a)
#pragma unroll
        for (int b = 0; b < 2; ++b)
#pragma unroll
            for (int m = 0; m < 4; ++m)
#pragma unroll
                for (int n = 0; n < 2; ++n) acc[a][b][m][n] = (f32x4){0.f, 0.f, 0.f, 0.f};
    int sc8 = 0x7f7f7f7f; asm volatile("" : "+v"(sc8));
    bf16x8 At[4][2], B0[2][2], B1[2][2]; i32x8 At8[4], B08[2], B18[2];
    unsigned vAc[2][2], vAn[2][2];
    PG8_VA(vAc, cur);
    unsigned cA = GATHER ? 0u : S.arow(cur, 0) * rowB, cB = S.boff(cur);
    PG8_STAGE_B(PG8_SB(0, 0), cB); PG8_STAGE_B(PG8_SB(0, 1), cB + hstep); PG8_STAGE_A(PG8_SA(0, 0), 0, cA, vAc); PG8_STAGE_A(PG8_SA(0, 1), 1, cA, vAc);
    if (wr == 1) PG8_BAR;
    PG8_WAIT_V(2); PG8_BAR;
    PG8_STAGE_B(PG8_SB(1, 0), cB + kstep); PG8_STAGE_A(PG8_SA(1, 0), 0, cA + kstep, vAc); PG8_STAGE_B(PG8_SB(1, 1), cB + hstep + kstep);
    PG8_WAIT_V(6); PG8_BAR;
    for (;;) {
        const bool has_next = S.next(ui + 1, nxt); nxt.par = (ui + 1) & 1;
        unsigned nB = cB, nA = cA;
        if (has_next) { nB = S.boff(nxt); PG8_VA(vAn, nxt); if constexpr (!GATHER) nA = S.arow(nxt, 0) * rowB; }
        else if constexpr (GATHER) {
#pragma unroll
            for (int h = 0; h < 2; ++h)
#pragma unroll
                for (int i = 0; i < 2; ++i) vAn[h][i] = vAc[h][i];
        }
        for (int t = 0; t < nt; t += 2) {
            const bool last = (t == nt - 2);
            const unsigned a1 = cA + (unsigned)(t + 1) * kstep;
            const unsigned a2 = last ? nA : cA + (unsigned)(t + 2) * kstep, b2 = last ? nB : cB + (unsigned)(t + 2) * kstep;
            const unsigned a3 = a2 + kstep, b3 = b2 + kstep;
            unsigned v2[2][2];
            if constexpr (GATHER) {
#pragma unroll
            for (int h = 0; h < 2; ++h)
#pragma unroll
                for (int i = 0; i < 2; ++i) v2[h][i] = vAc[h][i];
            if (last) {
#pragma unroll
                for (int h = 0; h < 2; ++h)
#pragma unroll
                    for (int i = 0; i < 2; ++i) { unsigned x_ = vAn[h][i]; asm volatile("" : "+v"(x_)); v2[h][i] = x_; } } }
            PG8_LDB(B0, 0, 0); PG8_LDB(B1, 0, 1); PG8_SCHED; PG8_LDA(At, 0, 0); PG8_STAGE_A(PG8_SA(1, 1), 1, a1, vAc);
            PG8_WAIT_V(8); PG8_WAIT_L(0); PG8_BAR; PG8_MMA(0, 0, At, B0); PG8_MMA(0, 1, At, B1); PG8_BAR; PG8_SCHED;
            PG8_LDA(At, 0, 1); PG8_STAGE_B(PG8_SB(0, 0), b2); PG8_STAGE_B(PG8_SB(0, 1), b2 + hstep); PG8_STAGE_A(PG8_SA(0, 0), 0, a2, v2);
            PG8_WAIT_V(8); PG8_WAIT_L(0); PG8_BAR; PG8_MMA(1, 0, At, B0); PG8_MMA(1, 1, At, B1); PG8_BAR; PG8_SCHED;
            PG8_LDB(B0, 1, 0); PG8_LDB(B1, 1, 1); PG8_SCHED; PG8_LDA(At, 1, 0); PG8_STAGE_A(PG8_SA(0, 1), 1, a2, v2);
            PG8_WAIT_V(8); PG8_WAIT_L(0); PG8_BAR; PG8_MMA(0, 0, At, B0); PG8_MMA(0, 1, At, B1); PG8_BAR; PG8_SCHED;
            PG8_LDA(At, 1, 1); PG8_STAGE_B(PG8_SB(1, 0), b3); PG8_STAGE_B(PG8_SB(1, 1), b3 + hstep); PG8_STAGE_A(PG8_SA(1, 0), 0, a3, v2);
            PG8_WAIT_V(8); PG8_WAIT_L(0); PG8_BAR; PG8_MMA(1, 0, At, B0); PG8_MMA(1, 1, At, B1); PG8_BAR; PG8_SCHED;
        }
        if (wr == 0) PG8_BAR;
        if constexpr (FP8) asm volatile("s_nop 15\n\ts_nop 15" ::: "memory");
        E(acc, cur, wr, wc, fr, fq, wid, lane);
        if (!has_next) break;
        E.prefetch(nxt, wid, lane);
#pragma unroll
        for (int a = 0; a < 2; ++a)
#pragma unroll
            for (int b = 0; b < 2; ++b)
#pragma unroll
                for (int m = 0; m < 4; ++m)
#pragma unroll
                    for (int n = 0; n < 2; ++n) acc[a][b][m][n] = (f32x4){0.f, 0.f, 0.f, 0.f};
        cur = nxt; cB = nB; cA = nA; ++ui;
        if constexpr (GATHER) {
#pragma unroll
        for (int h = 0; h < 2; ++h)
#pragma unroll
            for (int i = 0; i < 2; ++i) vAc[h][i] = vAn[h][i]; }
        if (wr == 1) PG8_BAR;
    }
    PG8_WAIT_V(0);
    PG8_BAR;
#undef PG8_SA
#undef PG8_SB
#undef PG8_STAGE
#undef PG8_STAGE_B
#undef PG8_LDA
#undef PG8_LDB
#undef PG8_MMA
#undef PG8_LD8
#undef PG8_WAIT_V
#undef PG8_WAIT_L
#undef PG8_BAR
#undef PG8_SCHED
#undef PG8_VA
#undef PG8_STAGE_A
}
}

namespace att {
constexpr int D = 128, SEQ_ = 8192, PKV_ = 8256;
constexpr float THR = 8.f;
constexpr bool WSKIP = false;
constexpr float SCALE = 0.08838834764831845f;
constexpr int NW = 8, QBLK = 32, KVBLK = 64, QB = NW * QBLK;
constexpr int SHM_V = KVBLK * D * 2, SHM_K = KVBLK * D * 2;
constexpr int LDS_BYTES = 2 * SHM_V + 2 * SHM_K + NW * 64 * 4;
constexpr int BT_LEN = 352, BT_OFF = 96;
typedef unsigned short bf16;
typedef short bf16x8 __attribute__((ext_vector_type(8)));
typedef short s16x4 __attribute__((ext_vector_type(4)));
typedef float f32x16 __attribute__((ext_vector_type(16)));
typedef float f32x4 __attribute__((ext_vector_type(4)));
typedef unsigned u32x4 __attribute__((ext_vector_type(4)));
template <class A, class Bt> struct same_t { static constexpr bool v = false; };
template <class A> struct same_t<A, A> { static constexpr bool v = true; };

#define KSWZ(row, colB) ((row) * 256 + ((colB) ^ (((row) & 7) << 4)))
#define SBAR() __builtin_amdgcn_sched_barrier(0)
__device__ __forceinline__ int v_st(int k, int c) { const int kk = (k & ~0xC) | ((k & 4) << 1) | ((k & 8) >> 1); return ((kk >> 3) * 4 + (c >> 5)) * 512 + ((kk & 7) * 32 + (c & 31)) * 2; }
__device__ __forceinline__ int v_rd_base(int lane) { return ((lane & 3) << 3) | (((lane >> 2) & 3) << 6) | (((lane >> 4) & 1) << 5) | (((lane >> 5) & 1) << 8); }
constexpr int v_rd_off(int d0, int ks, int half) { return d0 * 512 + ks * 4096 + half * 2048; }
__device__ __forceinline__ int crow(int r, int hi) { return (r & 3) + 8 * (r >> 2) + 4 * hi; }
__device__ __forceinline__ unsigned cvtpk(float lo, float hi) {
    unsigned r; asm volatile("v_cvt_pk_bf16_f32 %0, %1, %2" : "=v"(r) : "v"(lo), "v"(hi)); return r;
}
__device__ __forceinline__ bf16x8 pack8(f32x4 a, f32x4 b) {
    u32x4 w = {cvtpk(a[0], a[1]), cvtpk(a[2], a[3]), cvtpk(b[0], b[1]), cvtpk(b[2], b[3])};
    return *reinterpret_cast<bf16x8*>(&w);
}
template <class T> __device__ __forceinline__ bf16x8 load8(const T* p) {
    if constexpr (same_t<T, float>::v) { return pack8(*(const f32x4*)p, *(const f32x4*)(p + 4)); }
    else { return *reinterpret_cast<const bf16x8*>(p); }
}
__device__ __forceinline__ void mask_tile(f32x16& p0, f32x16& p1, int dq, unsigned W) {
    const float NEG = -__builtin_inff();
#pragma unroll
    for (int r = 0; r < 16; ++r) {
        const int c = (r & 3) + 8 * (r >> 2);
        if ((unsigned)(dq - c) >= W) p0[r] = NEG;
        if ((unsigned)(dq - c - 32) >= W) p1[r] = NEG;
    }
}
__device__ __forceinline__ void bias_tile(f32x16& p0, f32x16& p1, int dq, const float* __restrict__ tab) {
    const float* tb = tab + (dq + 96);
#pragma unroll
    for (int r = 0; r < 16; ++r) {
        const int c = (r & 3) + 8 * (r >> 2);
        p0[r] += tb[-c];
        p1[r] += tb[-c - 32];
    }
}
__device__ __forceinline__ void padmask_tile(f32x16& p0, f32x16& p1) {
    const float NEG = -__builtin_inff();
#pragma unroll
    for (int r = 0; r < 16; ++r) p0[r] = NEG;
#pragma unroll
    for (int r = 0; r < 8; ++r) p1[r] = NEG;
}
template <bool FIXM>
__device__ __forceinline__ void partialSM(f32x16& p0, f32x16& p1, float& m_reg, float& mn, float& alpha) {
    if constexpr (FIXM) {
        mn = 0.f; alpha = 1.f;
        for (int r = 0; r < 16; ++r) p0[r] = __builtin_amdgcn_exp2f(p0[r]);
    } else {
    float pmax = p0[0]; for (int r = 1; r < 16; ++r) pmax = fmaxf(pmax, p0[r]); for (int r = 0; r < 16; ++r) pmax = fmaxf(pmax, p1[r]);
    { auto rr = __builtin_amdgcn_permlane32_swap(__float_as_uint(pmax), __float_as_uint(pmax), false, false);
      pmax = fmaxf(__uint_as_float(rr[0]), __uint_as_float(rr[1])); }
    if (__builtin_expect(__all((pmax - m_reg) * 0.6931471805599453f <= THR), 1)) { mn = m_reg; alpha = 1.f; }
    else { mn = fmaxf(m_reg, pmax); alpha = __builtin_amdgcn_exp2f(m_reg - mn); m_reg = mn; }
    for (int r = 0; r < 16; ++r) p0[r] -= mn; for (int r = 0; r < 16; ++r) p1[r] -= mn;
    for (int r = 0; r < 16; ++r) p0[r] = __builtin_amdgcn_exp2f(p0[r]);
    }
}
__device__ __forceinline__ void finishSM(f32x16& p0, f32x16& p1, float alpha, float& l_reg, bf16x8& pa0, bf16x8& pa1, bf16x8& pa2, bf16x8& pa3) {
    for (int r = 0; r < 16; ++r) p1[r] = __builtin_amdgcn_exp2f(p1[r]);
    float ps = 0; for (int r = 0; r < 16; ++r) ps += p0[r]; for (int r = 0; r < 16; ++r) ps += p1[r];
    { auto rr = __builtin_amdgcn_permlane32_swap(__float_as_uint(ps), __float_as_uint(ps), false, false);
      ps = __uint_as_float(rr[0]) + __uint_as_float(rr[1]); }
    l_reg = l_reg * alpha + ps;
#define PK4(P, B_, OUT) do { unsigned a0 = cvtpk(P[B_+0], P[B_+1]), a1 = cvtpk(P[B_+2], P[B_+3]);                          \
        unsigned b0 = cvtpk(P[B_+4], P[B_+5]), b1 = cvtpk(P[B_+6], P[B_+7]);                                             \
        auto r0 = __builtin_amdgcn_permlane32_swap(a0, b0, false, false); auto r1 = __builtin_amdgcn_permlane32_swap(a1, b1, false, false); \
        u32x4 w = {r0[0], r1[0], r0[1], r1[1]}; OUT = *reinterpret_cast<bf16x8*>(&w); } while (0)
    PK4(p0, 0, pa0); PK4(p0, 8, pa1); PK4(p1, 0, pa2); PK4(p1, 8, pa3);
#undef PK4
}
template <int KB, bool SK>
__device__ __forceinline__ void qkt(f32x16& p0, f32x16& p1, const char* K_lds, int r32, int hi, const bf16x8* qr, bool act) {
    if (SK && !act) { const float NEG = -__builtin_inff();
#pragma unroll
        for (int r = 0; r < 16; ++r) { p0[r] = NEG; p1[r] = NEG; } return; }
    p0 = f32x16{}; p1 = f32x16{};
    const char* kb[4];
#pragma unroll
    for (int dd = 0; dd < 4; ++dd) kb[dd] = K_lds + KB * SHM_K + KSWZ(r32, (dd * 16 + hi * 8) * 2);
#pragma unroll
    for (int d0 = 0; d0 < 8; ++d0) { const char* a = kb[d0 & 3] + (d0 >> 2) * 128;
        bf16x8 b0 = *reinterpret_cast<const bf16x8*>(a);
        bf16x8 b1 = *reinterpret_cast<const bf16x8*>(a + 32 * 256);
        p0 = __builtin_amdgcn_mfma_f32_32x32x16_bf16(b0, qr[d0], p0, 0, 0, 0);
        p1 = __builtin_amdgcn_mfma_f32_32x32x16_bf16(b1, qr[d0], p1, 0, 0, 0); }
}
template <int VB, bool SK>
__device__ __forceinline__ void pv_tile(f32x16* o, int vb0, bf16x8 pa0, bf16x8 pa1, bf16x8 pa2, bf16x8 pa3, bool act) {
    if (SK && !act) return;
#define TRRD(dst, off) asm volatile("ds_read_b64_tr_b16 %0, %1 offset:%2" : "=&v"(dst) : "v"(vb0), "i"(off) : "memory")
#define PV_D0(d0) do { s16x4 l0, l1, l2, l3, h0, h1, h2, h3; constexpr int b_ = VB * SHM_V + v_rd_off(d0, 0, 0);     \
        TRRD(l0, b_); TRRD(h0, b_ + 2048); TRRD(l1, b_ + 4096); TRRD(h1, b_ + 6144); TRRD(l2, b_ + 8192); TRRD(h2, b_ + 10240); TRRD(l3, b_ + 12288); TRRD(h3, b_ + 14336); \
        asm volatile("s_waitcnt lgkmcnt(0)" ::: "memory"); SBAR();                 \
        o[d0] = __builtin_amdgcn_mfma_f32_32x32x16_bf16(pa0, (bf16x8){l0[0], l0[1], l0[2], l0[3], h0[0], h0[1], h0[2], h0[3]}, o[d0], 0, 0, 0);   \
        o[d0] = __builtin_amdgcn_mfma_f32_32x32x16_bf16(pa1, (bf16x8){l1[0], l1[1], l1[2], l1[3], h1[0], h1[1], h1[2], h1[3]}, o[d0], 0, 0, 0);   \
        o[d0] = __builtin_amdgcn_mfma_f32_32x32x16_bf16(pa2, (bf16x8){l2[0], l2[1], l2[2], l2[3], h2[0], h2[1], h2[2], h2[3]}, o[d0], 0, 0, 0);   \
        o[d0] = __builtin_amdgcn_mfma_f32_32x32x16_bf16(pa3, (bf16x8){l3[0], l3[1], l3[2], l3[3], h3[0], h3[1], h3[2], h3[3]}, o[d0], 0, 0, 0); } while (0)
    PV_D0(0); PV_D0(1); PV_D0(2); PV_D0(3);
#undef PV_D0
#undef TRRD
}

template <class TIn, class TOut> struct BlockRef { const TIn* Q; const TIn* K; const TIn* V; TOut* O; int P0; const float* bt; };
template <class TIn> struct Seam {
    bf16x8 qr[8];
    bf16x8 st_v0, st_v1, st_k0, st_k1; f32x4 sf0, sf1, sf2, sf3;
    f32x4 tq[16];
};
__device__ __forceinline__ int swa_jlo(int P0, int W) { const int lowk = P0 - W + 1; return lowk > 0 ? lowk / KVBLK : 0; }
#define ROW(p, k0, rr) ((p) + (size_t)((k0) + (rr)) * D + sc)
#define VMW() asm volatile("s_waitcnt vmcnt(0)" ::: "memory")
#define VMWN(n) asm volatile("s_waitcnt vmcnt(%0)" :: "i"(n) : "memory")
#define SLOAD_H(Kp, Vp, k0) do { S.st_v0 = load8<TIn>(ROW(Vp, k0, sr)); S.st_v1 = load8<TIn>(ROW(Vp, k0, 32 + sr));              \
                         S.st_k0 = load8<TIn>(ROW(Kp, k0, sr)); S.st_k1 = load8<TIn>(ROW(Kp, k0, 32 + sr)); } while (0)
#define SWRITE_HK(bf) do { *(bf16x8*)(K_lds + (bf) * SHM_K + kws) = S.st_k0; *(bf16x8*)(K_lds + (bf) * SHM_K + kws + 32 * 256) = S.st_k1; } while (0)
#define SWRITE_HV(bf) do { *(bf16x8*)(V_lds + (bf) * SHM_V + vst0) = S.st_v0; *(bf16x8*)(V_lds + (bf) * SHM_V + vst1) = S.st_v1; } while (0)
#define SWRITE_H(bf) do { SWRITE_HV(bf); SWRITE_HK(bf); } while (0)
#define SLOAD_F(p, k0) do { S.sf0 = *(const f32x4*)ROW(p, k0, sr); S.sf1 = *(const f32x4*)(ROW(p, k0, sr) + 4);                \
                            S.sf2 = *(const f32x4*)ROW(p, k0, 32 + sr); S.sf3 = *(const f32x4*)(ROW(p, k0, 32 + sr) + 4); } while (0)
#define SWRITE_KF(bf) do { *(bf16x8*)(K_lds + (bf) * SHM_K + kws) = pack8(S.sf0, S.sf1); *(bf16x8*)(K_lds + (bf) * SHM_K + kws + 32 * 256) = pack8(S.sf2, S.sf3); } while (0)
#define SWRITE_VF(bf) do { *(bf16x8*)(V_lds + (bf) * SHM_V + vst0) = pack8(S.sf0, S.sf1); *(bf16x8*)(V_lds + (bf) * SHM_V + vst1) = pack8(S.sf2, S.sf3); } while (0)
template <class TIn, class TOut>
__device__ __forceinline__ void causal_swa_prime(const BlockRef<TIn, TOut>& cur, int W, char* lds, Seam<TIn>& S) {
    constexpr bool F32 = same_t<TIn, float>::v;
    int tid_ = threadIdx.x; asm volatile("" : "+v"(tid_)); const int tid = tid_, wid = __builtin_amdgcn_readfirstlane(tid >> 6), lane = tid & 63, r32 = lane & 31, hi = lane >> 5;
    const int sr = tid >> 4, sc = (tid & 15) * 8, kws = KSWZ(sr, sc * 2); char* K_lds = lds + 2 * SHM_V;
    const int kb0 = swa_jlo(cur.P0, W) * KVBLK;
    for (int d0 = 0; d0 < 8; ++d0) S.qr[d0] = load8<TIn>(cur.Q + (size_t)(wid * QBLK + r32) * D + d0 * 16 + hi * 8);
    if constexpr (F32) { SLOAD_F((const float*)cur.K, kb0); VMW(); SWRITE_KF(0); SBAR(); SLOAD_F((const float*)cur.V, kb0); }
    else { SLOAD_H(cur.K, cur.V, kb0); VMW(); SWRITE_HK(0); }
    __syncthreads();
}
template <class TIn, class TOut, bool FIXM>
__device__ __forceinline__ void causal_swa_block(const BlockRef<TIn, TOut>& cur, const BlockRef<TIn, TOut>& nxt, int skv, int W, char* lds, Seam<TIn>& S) {
    constexpr bool F32 = same_t<TIn, float>::v;
    int tid_ = threadIdx.x; asm volatile("" : "+v"(tid_)); const int tid = tid_, wid = __builtin_amdgcn_readfirstlane(tid >> 6), lane = tid & 63, r32 = lane & 31, hi = lane >> 5;
    const int j_lo = swa_jlo(cur.P0, W);
    int j_hi = (cur.P0 + QB - 1) / KVBLK + 1; if (j_hi > skv / KVBLK) j_hi = skv / KVBLK;
    const int NT = j_hi - j_lo;
    const int kbn = swa_jlo(nxt.P0, W) * KVBLK;
    const int qlo = cur.P0 + wid * QBLK, qm = qlo + r32 - 4 * hi;
    char* V_lds = lds; char* K_lds = lds + 2 * SHM_V;
    float* ws = (float*)(lds + 2 * SHM_V + 2 * SHM_K) + wid * 64; float* li_l = ws, * al_l = ws + 32;
    float m_reg = -1e30f, l_reg = 0; f32x16 o[4] = {};
    const int sr = tid >> 4, sc = (tid & 15) * 8, vst0 = v_st(sr, sc), vst1 = v_st(32 + sr, sc), kws = KSWZ(sr, sc * 2);
    const int vb0 = (int)(uintptr_t)V_lds + v_rd_base(lane);
    const TIn* Kh = cur.K; const TIn* Vh = cur.V;
#define RESC(a) do { if (!FIXM && __any((a) < 1.f)) { if (hi == 0) al_l[r32] = (a); asm volatile("s_waitcnt lgkmcnt(0)" ::: "memory");              \
                     for (int d_ = 0; d_ < 4; ++d_) for (int r = 0; r < 16; ++r) o[d_][r] *= al_l[crow(r, hi)]; } } while (0)
#define KBASE(t) ((j_lo + (t)) * KVBLK)
#define ACT(t) (KBASE(t) <= qlo + QBLK - 1 && KBASE(t) + KVBLK - 1 >= qlo - W + 1)
#define MASKT(P0_, P1_, t) do { const int kb_ = KBASE(t); \
        if (kb_ <= qlo + QBLK - 1 && qlo - kb_ <= 190) bias_tile(P0_, P1_, qm - kb_, cur.bt);            \
        if (kb_ == 0) padmask_tile(P0_, P1_);                                                         \
        if ((!SK || ACT(t)) && (kb_ + KVBLK - 1 > qlo || kb_ <= qlo + QBLK - 1 - W)) mask_tile(P0_, P1_, qm - kb_, (unsigned)W); } while (0)
    constexpr int NQL = F32 ? 16 : 8;
    constexpr bool SK = WSKIP && !F32;
#define SEAM_K0() do { VMWN(NQL); if constexpr (F32) { SWRITE_KF(0); SBAR(); SLOAD_F((const float*)nxt.V, kbn); } else { SWRITE_HK(0); } SBAR(); } while (0)
    f32x16 pA0, pA1, pB0, pB1; float mnA, mnB, alA, alB; bf16x8 pa0, pa1, pa2, pa3;
    if constexpr (F32) { VMW(); SWRITE_VF(0); SBAR(); } else { SWRITE_HV(0); SBAR(); }
    if (NT > 1) { if constexpr (F32) SLOAD_F((const float*)Kh, KBASE(1)); else SLOAD_H(Kh, Vh, KBASE(1)); }
    SBAR(); qkt<0, SK>(pA0, pA1, K_lds, r32, hi, S.qr, ACT(0));
    if constexpr (F32) { if (NT > 1) { VMW(); SWRITE_KF(1); SBAR(); SLOAD_F((const float*)Vh, KBASE(1)); } }
    MASKT(pA0, pA1, 0); partialSM<FIXM>(pA0, pA1, m_reg, mnA, alA);
    if (NT > 1) { VMW(); if constexpr (F32) { SWRITE_VF(1); SBAR(); if (NT > 2) SLOAD_F((const float*)Kh, KBASE(2)); } else SWRITE_H(1); }
    __syncthreads();
#define HALF_STEP(PX0, PX1, mnX, alX, PY0, PY1, alY, t, KB, VB, SB) do {                                                      \
        SBAR(); qkt<KB, SK>(PX0, PX1, K_lds, r32, hi, S.qr, ACT(t));                                             \
        finishSM(PY0, PY1, alY, l_reg, pa0, pa1, pa2, pa3); SBAR();                                                           \
        if ((t) + 1 < NT) { if constexpr (F32) { VMW(); SWRITE_KF(SB); SBAR(); SLOAD_F((const float*)Vh, KBASE((t) + 1)); }  \
                            else { SLOAD_H(Kh, Vh, KBASE((t) + 1)); } SBAR(); }                                               \
        pv_tile<VB, SK>(o, vb0, pa0, pa1, pa2, pa3, ACT((t) - 1)); MASKT(PX0, PX1, (t)); partialSM<FIXM>(PX0, PX1, m_reg, mnX, alX);                                        \
        __syncthreads();                                                                                                      \
        if ((t) + 1 < NT) { VMW(); if constexpr (F32) { SWRITE_VF(SB); SBAR(); if ((t) + 2 < NT) SLOAD_F((const float*)Kh, KBASE((t) + 2)); } \
                            else { SWRITE_H(SB); } }                                                                          \
        RESC(alX); __syncthreads(); } while (0)
    for (int t = 1; t + 1 < NT; t += 2) {
        HALF_STEP(pB0, pB1, mnB, alB, pA0, pA1, alA, t, 1, 0, 0);
        HALF_STEP(pA0, pA1, mnA, alA, pB0, pB1, alB, t + 1, 0, 1, 1);
    }
    const bool even = (NT & 1) == 0;
    if (even) { SBAR(); qkt<1, SK>(pB0, pB1, K_lds, r32, hi, S.qr, ACT(NT - 1)); SBAR(); }
#define QROW(e) (nxt.Q + (size_t)(wid * QBLK + r32) * D + ((e) >> 1) * 16 + hi * 8 + ((e) & 1) * 4)
    if constexpr (F32) { SLOAD_F((const float*)nxt.K, kbn); SBAR();
#pragma unroll
        for (int e = 0; e < 8; ++e) S.tq[e] = *(const f32x4*)QROW(e); }
    else { SLOAD_H(nxt.K, nxt.V, kbn); SBAR();
#pragma unroll
        for (int d0 = 0; d0 < 8; ++d0) S.qr[d0] = load8<TIn>(nxt.Q + (size_t)(wid * QBLK + r32) * D + d0 * 16 + hi * 8); }
    SBAR();
    finishSM(pA0, pA1, alA, l_reg, pa0, pa1, pa2, pa3); SBAR();
    if constexpr (F32) {
#pragma unroll
        for (int e = 8; e < 16; ++e) S.tq[e] = *(const f32x4*)QROW(e); SBAR(); }
#undef QROW
    pv_tile<0, SK>(o, vb0, pa0, pa1, pa2, pa3, ACT(even ? NT - 2 : NT - 1));
    if (even) { MASKT(pB0, pB1, NT - 1); partialSM<FIXM>(pB0, pB1, m_reg, mnB, alB); __syncthreads(); RESC(alB);
        finishSM(pB0, pB1, alB, l_reg, pa0, pa1, pa2, pa3); SBAR(); pv_tile<1, SK>(o, vb0, pa0, pa1, pa2, pa3, ACT(NT - 1)); }
    SBAR(); SEAM_K0();
    if (hi == 0) li_l[r32] = l_reg; asm volatile("s_waitcnt lgkmcnt(0)" ::: "memory");
    float rli[16];
#pragma unroll
    for (int r = 0; r < 16; ++r) rli[r] = __builtin_amdgcn_rcpf(li_l[crow(r, hi)]);
    TOut* Ow = cur.O + (size_t)(wid * QBLK) * D;
#pragma unroll
    for (int r = 0; r < 16; ++r) { const int orow = crow(r, hi);
#pragma unroll
        for (int d0 = 0; d0 < 4; ++d0) { const float v = o[d0][r] * rli[r];
            if constexpr (same_t<TOut, float>::v) { Ow[(size_t)orow * D + d0 * 32 + r32] = v; }
            else { const float vn = __shfl_xor(v, 1);
                   if ((r32 & 1) == 0) *(unsigned*)(Ow + (size_t)orow * D + d0 * 32 + r32) = cvtpk(v, vn); } } }
    if constexpr (F32) {
#pragma unroll
        for (int d0 = 0; d0 < 8; ++d0) S.qr[d0] = pack8(S.tq[2 * d0], S.tq[2 * d0 + 1]); }
    __syncthreads();
#undef RESC
#undef KBASE
#undef ACT
#undef MASKT
#undef SEAM_K0
#undef HALF_STEP
}
#undef ROW
#undef VMW
#undef VMWN
#undef SLOAD_H
#undef SWRITE_HK
#undef SWRITE_HV
#undef SWRITE_H
#undef SLOAD_F
#undef SWRITE_KF
#undef SWRITE_VF

typedef float f32x2_b __attribute__((ext_vector_type(2))); typedef __bf16 bf16x2_b __attribute__((ext_vector_type(2)));
__device__ __forceinline__ unsigned cvtpk_b(float lo, float hi) { f32x2_b v = {lo, hi}; bf16x2_b b = __builtin_convertvector(v, bf16x2_b); return __builtin_bit_cast(unsigned, b); }
constexpr int P2_QB = 128;
constexpr int P2_V = 0, P2_K = 4 * SHM_V, P2_XP = P2_K + 2 * SHM_K, P2_L = P2_XP + 2 * 8 * 2048, P2_LDS = P2_L + 8 * 32 * 4;
struct BlockRef2 { const bf16* Q; const bf16* K; const bf16* V; bf16* O; int P0; const float* bt; };
__device__ __forceinline__ void paired_block(const BlockRef2& cur, char* lds) {
    int tid_ = threadIdx.x; asm volatile("" : "+v"(tid_));
    const int tid = tid_, wid = __builtin_amdgcn_readfirstlane(tid >> 6), lane = tid & 63, r32 = lane & 31, hi = lane >> 5, wq = wid & 3, kh = wid >> 2;
    const int NT = (cur.P0 + P2_QB - 1) / KVBLK + 1;
    const int qlo = cur.P0 + wq * QBLK, qm = qlo + r32 - 4 * hi;
    char* V_lds = lds + P2_V; char* K_lds = lds + P2_K; char* XP = lds + P2_XP; float* LS = (float*)(lds + P2_L);
    const int sr = tid >> 4, sc = (tid & 15) * 8, vst0 = v_st(sr, sc), vst1 = v_st(32 + sr, sc), kws = KSWZ(sr, sc * 2);
    const int vb0 = (int)(uintptr_t)V_lds + kh * SHM_V + v_rd_base(lane);
    const bf16* Kh = cur.K; const bf16* V0 = cur.V; const bf16* V1 = cur.V + (size_t)PKV_ * D;
    bf16x8 qr[8];
#pragma unroll
    for (int d0 = 0; d0 < 8; ++d0) qr[d0] = *reinterpret_cast<const bf16x8*>(cur.Q + (size_t)(wq * QBLK + r32) * D + d0 * 16 + hi * 8);
    typedef __attribute__((address_space(3))) unsigned lds_u32;
    unsigned koff[2], voff[2];
#pragma unroll
    for (int i = 0; i < 2; ++i) { const int q = wid * 128 + i * 64 + lane, row = q >> 4, c16 = (q & 15) ^ (row & 7); koff[i] = (unsigned)(row * 256 + c16 * 16);
        const int st = q >> 5, qq = q & 31, kk = (st >> 2) * 8 + (qq >> 2), k = (kk & ~0xC) | ((kk & 4) << 1) | ((kk & 8) >> 1), c = (st & 3) * 32 + (qq & 3) * 8; voff[i] = (unsigned)(k * 256 + c * 2); }
    const unsigned ldsK = (unsigned)(uintptr_t)K_lds + wid * 2048, ldsV = (unsigned)(uintptr_t)V_lds + wid * 2048;
#define P2_DMA(gbase, goff, ldsaddr) __builtin_amdgcn_global_load_lds((const unsigned*)((const char*)(gbase) + (goff)), (lds_u32*)(ldsaddr), 16, 0, 0)
#define P2_DMAK(t, bf) do { const char* g_ = (const char*)Kh + (size_t)(t) * KVBLK * D * 2; P2_DMA(g_, koff[0], ldsK + (bf) * SHM_K); P2_DMA(g_, koff[1], ldsK + (bf) * SHM_K + 1024); } while (0)
#define P2_DMAV(t, bf) do { const char* g0_ = (const char*)V0 + (size_t)(t) * KVBLK * D * 2; const char* g1_ = (const char*)V1 + (size_t)(t) * KVBLK * D * 2;                      \
        P2_DMA(g0_, voff[0], ldsV + (bf) * 2 * SHM_V); P2_DMA(g0_, voff[1], ldsV + (bf) * 2 * SHM_V + 1024); P2_DMA(g1_, voff[0], ldsV + (bf) * 2 * SHM_V + SHM_V); P2_DMA(g1_, voff[1], ldsV + (bf) * 2 * SHM_V + SHM_V + 1024); } while (0)
    P2_DMAK(0, 0); P2_DMAK(1, 1);
    __syncthreads();
    f32x16 pc = f32x16{};
    { const char* kb[4];
#pragma unroll
      for (int dd = 0; dd < 4; ++dd) kb[dd] = K_lds + kh * (32 * 256) + KSWZ(r32, (dd * 16 + hi * 8) * 2);
#pragma unroll
      for (int d0 = 0; d0 < 8; ++d0) pc = __builtin_amdgcn_mfma_f32_32x32x16_bf16(*reinterpret_cast<const bf16x8*>(kb[d0 & 3] + (d0 >> 2) * 128), qr[d0], pc, 0, 0, 0); }
    __syncthreads();
    f32x16 o[4] = {}; float l_reg = 0.f; bf16x8 pa0, pa1, pa2, pa3;
#define P2_TR(dst, off) asm volatile("ds_read_b64_tr_b16 %0, %1 offset:%2" : "=&v"(dst) : "v"(vb0), "i"(off) : "memory")
#define P2_RD(VB_, d0, X) do { constexpr int b_ = (VB_) * 2 * SHM_V + v_rd_off(d0, 0, 0);                                                       \
        P2_TR(X##l0, b_); P2_TR(X##h0, b_ + 2048); P2_TR(X##l1, b_ + 4096); P2_TR(X##h1, b_ + 6144); P2_TR(X##l2, b_ + 8192); P2_TR(X##h2, b_ + 10240); P2_TR(X##l3, b_ + 12288); P2_TR(X##h3, b_ + 14336); } while (0)
#define P2_MM(d0, X) do {                                                                                                                   \
        o[d0] = __builtin_amdgcn_mfma_f32_32x32x16_bf16(pa0, (bf16x8){X##l0[0], X##l0[1], X##l0[2], X##l0[3], X##h0[0], X##h0[1], X##h0[2], X##h0[3]}, o[d0], 0, 0, 0); \
        o[d0] = __builtin_amdgcn_mfma_f32_32x32x16_bf16(pa1, (bf16x8){X##l1[0], X##l1[1], X##l1[2], X##l1[3], X##h1[0], X##h1[1], X##h1[2], X##h1[3]}, o[d0], 0, 0, 0); \
        o[d0] = __builtin_amdgcn_mfma_f32_32x32x16_bf16(pa2, (bf16x8){X##l2[0], X##l2[1], X##l2[2], X##l2[3], X##h2[0], X##h2[1], X##h2[2], X##h2[3]}, o[d0], 0, 0, 0); \
        o[d0] = __builtin_amdgcn_mfma_f32_32x32x16_bf16(pa3, (bf16x8){X##l3[0], X##l3[1], X##l3[2], X##l3[3], X##h3[0], X##h3[1], X##h3[2], X##h3[3]}, o[d0], 0, 0, 0); } while (0)
#define P2_LW(n) do { asm volatile("s_waitcnt lgkmcnt(" #n ")" ::: "memory"); SBAR(); } while (0)
#define P2_PVALL(VB_) do { s16x4 Al0, Al1, Al2, Al3, Ah0, Ah1, Ah2, Ah3, Bl0, Bl1, Bl2, Bl3, Bh0, Bh1, Bh2, Bh3;                                 \
        P2_RD(VB_, 0, A); P2_RD(VB_, 1, B); P2_LW(8); P2_MM(0, A); P2_RD(VB_, 2, A); P2_LW(8); P2_MM(1, B); P2_RD(VB_, 3, B); P2_LW(8); P2_MM(2, A); P2_LW(0); P2_MM(3, B); } while (0)
#define P2_STEP(s, PAR) do { f32x16 p = f32x16{};                                                                                           \
        if ((s) + 1 < NT) P2_DMAK((s) + 1, 1 - (PAR)); if ((s) < NT) P2_DMAV((s), (PAR));     \
        if ((s) < NT) {                                                                                                                    \
            const char* kb[4];                                                                                                             \
            _Pragma("unroll") for (int dd = 0; dd < 4; ++dd) kb[dd] = K_lds + (PAR) * SHM_K + kh * (32 * 256) + KSWZ(r32, (dd * 16 + hi * 8) * 2); \
            _Pragma("unroll") for (int d0 = 0; d0 < 8; ++d0) p = __builtin_amdgcn_mfma_f32_32x32x16_bf16(*reinterpret_cast<const bf16x8*>(kb[d0 & 3] + (d0 >> 2) * 128), qr[d0], p, 0, 0, 0); } \
        if ((s) >= 1) { constexpr int VB_ = 1 - (PAR);                           \
            P2_PVALL(VB_); }                                                                                                          \
        if ((s) < NT) { const int kbase = (s) * KVBLK + 32 * kh, dq = qm - kbase;                    \
            if (kbase <= qlo + QBLK - 1 && qlo - kbase <= 158) { const float* tb = cur.bt + (dq + BT_OFF);                                  \
                _Pragma("unroll") for (int r = 0; r < 16; ++r) p[r] += tb[-((r & 3) + 8 * (r >> 2))]; }                                  \
            if ((s) == 0) { const float NEG_ = -__builtin_inff(); _Pragma("unroll") for (int r = 0; r < 16; ++r) if (kh == 0 || r < 8) p[r] = NEG_; }     \
            if (kbase + 31 > qlo) { const float NEG_ = -__builtin_inff(); _Pragma("unroll") for (int r = 0; r < 16; ++r) if (dq - ((r & 3) + 8 * (r >> 2)) < 0) p[r] = NEG_; } \
            _Pragma("unroll") for (int r = 0; r < 16; ++r) p[r] = __builtin_amdgcn_exp2f(p[r]);                                             \
            float ps = 0.f; _Pragma("unroll") for (int r = 0; r < 16; ++r) ps += p[r];                                                      \
            { auto rr = __builtin_amdgcn_permlane32_swap(__float_as_uint(ps), __float_as_uint(ps), false, false); ps = __uint_as_float(rr[0]) + __uint_as_float(rr[1]); } \
            l_reg += ps;                                                                                                                   \
            bf16x8 fa, fb;                                                                                                                 \
            { unsigned a0 = cvtpk_b(p[0], p[1]), a1 = cvtpk_b(p[2], p[3]), b0 = cvtpk_b(p[4], p[5]), b1 = cvtpk_b(p[6], p[7]);                       \
              auto r0 = __builtin_amdgcn_permlane32_swap(a0, b0, false, false); auto r1 = __builtin_amdgcn_permlane32_swap(a1, b1, false, false); \
              u32x4 w = {r0[0], r1[0], r0[1], r1[1]}; fa = *reinterpret_cast<bf16x8*>(&w); }                                                 \
            { unsigned a0 = cvtpk_b(p[8], p[9]), a1 = cvtpk_b(p[10], p[11]), b0 = cvtpk_b(p[12], p[13]), b1 = cvtpk_b(p[14], p[15]);                 \
              auto r0 = __builtin_amdgcn_permlane32_swap(a0, b0, false, false); auto r1 = __builtin_amdgcn_permlane32_swap(a1, b1, false, false); \
              u32x4 w = {r0[0], r1[0], r0[1], r1[1]}; fb = *reinterpret_cast<bf16x8*>(&w); }                                                 \
            char* xp = XP + (PAR) * (8 * 2048) + wq * 4096 + lane * 16;          \
            *(bf16x8*)(xp + (2 * kh) * 1024) = fa; *(bf16x8*)(xp + (2 * kh + 1) * 1024) = fb;                                              \
            }                                                                                                                              \
        __syncthreads();                                                                                                                   \
        if ((s) < NT) { const char* xp = XP + (PAR) * (8 * 2048) + wq * 4096 + lane * 16;                                                    \
            pa0 = *(const bf16x8*)(xp); pa1 = *(const bf16x8*)(xp + 1024); pa2 = *(const bf16x8*)(xp + 2048); pa3 = *(const bf16x8*)(xp + 3072);   \
            } } while (0)
#define P2_LW2(n, X) do { asm volatile("s_waitcnt lgkmcnt(" #n ")" : "+v"(X##l0), "+v"(X##h0), "+v"(X##l1), "+v"(X##h1), "+v"(X##l2), "+v"(X##h2), "+v"(X##l3), "+v"(X##h3)); SBAR(); } while (0)
#define P2_CH(j) do { _Pragma("unroll") for (int r = 4 * (j); r < 4 * (j) + 4; ++r) { p[r] = __builtin_amdgcn_exp2f(p[r]); ps += p[r]; } } while (0)
#define P2_PACK(B_, OUT) do { unsigned a0 = cvtpk_b(p[B_ + 0], p[B_ + 1]), a1 = cvtpk_b(p[B_ + 2], p[B_ + 3]), b0 = cvtpk_b(p[B_ + 4], p[B_ + 5]), b1 = cvtpk_b(p[B_ + 6], p[B_ + 7]);   \
        auto r0 = __builtin_amdgcn_permlane32_swap(a0, b0, false, false); auto r1 = __builtin_amdgcn_permlane32_swap(a1, b1, false, false); \
        u32x4 w = {r0[0], r1[0], r0[1], r1[1]}; OUT = *reinterpret_cast<bf16x8*>(&w); } while (0)
#define P2_MAIN(s, PAR) do { constexpr int VB_ = 1 - (PAR); f32x16 p = f32x16{};                                                              \
        if ((s) + 1 < NT) P2_DMAK((s) + 1, 1 - (PAR)); P2_DMAV((s), (PAR));                                                                  \
        { const char* kb[4];                                                                                                               \
          _Pragma("unroll") for (int dd = 0; dd < 4; ++dd) kb[dd] = K_lds + (PAR) * SHM_K + kh * (32 * 256) + KSWZ(r32, (dd * 16 + hi * 8) * 2); \
          _Pragma("unroll") for (int d0 = 0; d0 < 8; ++d0) p = __builtin_amdgcn_mfma_f32_32x32x16_bf16(*reinterpret_cast<const bf16x8*>(kb[d0 & 3] + (d0 >> 2) * 128), qr[d0], p, 0, 0, 0); } \
        s16x4 Al0, Al1, Al2, Al3, Ah0, Ah1, Ah2, Ah3, Bl0, Bl1, Bl2, Bl3, Bh0, Bh1, Bh2, Bh3;                                              \
        P2_RD(VB_, 0, A); P2_RD(VB_, 1, B);                                                                                                \
        { const int kbase = (s) * KVBLK + 32 * kh, dq = qm - kbase;                                                                         \
          if (kbase <= qlo + QBLK - 1 && qlo - kbase <= 158) { const float* tb = cur.bt + (dq + BT_OFF);                                    \
              _Pragma("unroll") for (int r = 0; r < 16; ++r) p[r] += tb[-((r & 3) + 8 * (r >> 2))]; }                                    \
          if (kbase + 31 > qlo) { const float NEG_ = -__builtin_inff(); _Pragma("unroll") for (int r = 0; r < 16; ++r) if (dq - ((r & 3) + 8 * (r >> 2)) < 0) p[r] = NEG_; } } \
        float ps = 0.f; bf16x8 fa, fb;                                                                                                     \
        P2_LW2(8, A); P2_MM(0, A); SBAR(); P2_CH(0); SBAR(); P2_RD(VB_, 2, A);                                                               \
        P2_LW2(8, B); P2_MM(1, B); SBAR(); P2_CH(1); P2_PACK(0, fa); SBAR(); P2_RD(VB_, 3, B);                                               \
        P2_LW2(8, A); P2_MM(2, A); SBAR(); P2_CH(2); SBAR();                                                                                 \
        P2_LW2(0, B); P2_MM(3, B); SBAR(); P2_CH(3); P2_PACK(8, fb);                                                                         \
        { auto rr = __builtin_amdgcn_permlane32_swap(__float_as_uint(ps), __float_as_uint(ps), false, false); ps = __uint_as_float(rr[0]) + __uint_as_float(rr[1]); } \
        l_reg += ps;                                                                                                                       \
        { char* xp = XP + (PAR) * (8 * 2048) + wq * 4096 + lane * 16;                                                                       \
          *(bf16x8*)(xp + (2 * kh) * 1024) = fa; *(bf16x8*)(xp + (2 * kh + 1) * 1024) = fb; }                                              \
        __syncthreads();                                                                                                                   \
        { const char* xp = XP + (PAR) * (8 * 2048) + wq * 4096 + lane * 16;                                                                 \
          pa0 = *(const bf16x8*)(xp); pa1 = *(const bf16x8*)(xp + 1024); pa2 = *(const bf16x8*)(xp + 2048); pa3 = *(const bf16x8*)(xp + 3072); } \
        } while (0)
#define P3_QK(i) pn = __builtin_amdgcn_mfma_f32_32x32x16_bf16(*reinterpret_cast<const bf16x8*>(kb[(i) & 3] + ((i) >> 2) * 128), qr[i], pn, 0, 0, 0)
#define P3_GEN(s, PAR, HQ_, HS_, HV_) do { constexpr int VB_ = 1 - (PAR); constexpr bool hq = HQ_, hs = HS_, hv = HV_;                                \
        if (hq && (s) + 2 < NT) P2_DMAK((s) + 2, (PAR)); if (hs) P2_DMAV((s), (PAR));                                                        \
        f32x16 pn = f32x16{}; f32x16 p = pc;                                                                                               \
        const char* kb[4];                                                                                                                 \
        _Pragma("unroll") for (int dd = 0; dd < 4; ++dd) kb[dd] = K_lds + (1 - (PAR)) * SHM_K + kh * (32 * 256) + KSWZ(r32, (dd * 16 + hi * 8) * 2); \
        s16x4 Al0, Al1, Al2, Al3, Ah0, Ah1, Ah2, Ah3, Bl0, Bl1, Bl2, Bl3, Bh0, Bh1, Bh2, Bh3;                                              \
        if (hv) { P2_RD(VB_, 0, A); P2_RD(VB_, 1, B); }                                                                                     \
        if (hs) { const int kbase = (s) * KVBLK + 32 * kh, dq = qm - kbase;                                                                 \
          if (kbase <= qlo + QBLK - 1 && qlo - kbase <= 158) { const float* tb = cur.bt + (dq + BT_OFF);                                    \
              _Pragma("unroll") for (int r = 0; r < 16; ++r) p[r] += tb[-((r & 3) + 8 * (r >> 2))]; }                                    \
          if ((s) == 0) { const float NEG_ = -__builtin_inff(); _Pragma("unroll") for (int r = 0; r < 16; ++r) if (kh == 0 || r < 8) p[r] = NEG_; }     \
          if (kbase + 31 > qlo) { const float NEG_ = -__builtin_inff(); _Pragma("unroll") for (int r = 0; r < 16; ++r) if (dq - ((r & 3) + 8 * (r >> 2)) < 0) p[r] = NEG_; } } \
        float ps = 0.f; bf16x8 fa, fb;                                                                                                     \
        if (hq) { P3_QK(0); P3_QK(1); } if (hv) { P2_LW2(8, A); P2_MM(0, A); } if (hs) { P2_CH(0); } if (hv) P2_RD(VB_, 2, A);                        \
        if (hq) { P3_QK(2); P3_QK(3); } if (hv) { P2_LW2(8, B); P2_MM(1, B); } if (hs) { P2_CH(1); P2_PACK(0, fa); } if (hv) P2_RD(VB_, 3, B);        \
        if (hq) { P3_QK(4); P3_QK(5); } if (hv) { P2_LW2(8, A); P2_MM(2, A); } if (hs) { P2_CH(2); }                                                 \
        if (hq) { P3_QK(6); P3_QK(7); } if (hv) { P2_LW2(0, B); P2_MM(3, B); }                                                                     \
        if (hs) { P2_CH(3); P2_PACK(8, fb);                                                                                                 \
          { auto rr = __builtin_amdgcn_permlane32_swap(__float_as_uint(ps), __float_as_uint(ps), false, false); ps = __uint_as_float(rr[0]) + __uint_as_float(rr[1]); } \
          l_reg += ps;                                                                                                                     \
          char* xp = XP + (PAR) * (8 * 2048) + wq * 4096 + lane * 16;                                                                       \
          *(bf16x8*)(xp + (2 * kh) * 1024) = fa; *(bf16x8*)(xp + (2 * kh + 1) * 1024) = fb; }                                              \
        __syncthreads();                                                                                                                   \
        if (hs) { const char* xp = XP + (PAR) * (8 * 2048) + wq * 4096 + lane * 16;                                                          \
          pa0 = *(const bf16x8*)(xp); pa1 = *(const bf16x8*)(xp + 1024); pa2 = *(const bf16x8*)(xp + 2048); pa3 = *(const bf16x8*)(xp + 3072); } \
        pc = pn; } while (0)
    P3_GEN(0, 0, true, true, false);
    for (int s_ = 1; s_ < NT - 2; s_ += 2) { P3_GEN(s_, 1, true, true, true); P3_GEN(s_ + 1, 0, true, true, true); }
    P3_GEN(NT - 2, 1, true, true, true);
    P3_GEN(NT - 1, 0, false, true, true);
    P3_GEN(NT, 1, false, false, true);
#undef P2_TR
#undef P2_RD
#undef P2_MM
#undef P2_LW
#undef P2_PVALL
#undef P2_STEP
#undef P2_MAIN
#undef P3_GEN
#undef P3_QK
#undef P2_LW2
#undef P2_CH
#undef P2_PACK
#undef P2_DMA
#undef P2_DMAK
#undef P2_DMAV
    if (hi == 0) LS[wid * 32 + r32] = l_reg;
    __syncthreads();
    float rli[16];
#pragma unroll
    for (int r = 0; r < 16; ++r) { const int row = crow(r, hi); rli[r] = __builtin_amdgcn_rcpf(LS[wq * 32 + row] + LS[(wq + 4) * 32 + row]); }
    bf16* Ow = cur.O + (size_t)kh * SEQ_ * D + (size_t)(wq * QBLK) * D;
    char* ot = lds + wid * 8704;
#pragma unroll
    for (int r = 0; r < 16; ++r) { const int orow = crow(r, hi);
#pragma unroll
        for (int d0 = 0; d0 < 4; ++d0) { const float v = o[d0][r] * rli[r]; *(unsigned short*)(ot + orow * 272 + (d0 * 32 + r32) * 2) = (unsigned short)cvtpk_b(v, v); } }
    asm volatile("s_waitcnt lgkmcnt(0)" ::: "memory");
#pragma unroll
    for (int j = 0; j < 8; ++j) { const int row = 4 * j + (lane >> 4), ch = lane & 15;
        *(u32x4*)(Ow + (size_t)row * D + ch * 8) = *(const u32x4*)(ot + row * 272 + ch * 16); }
    __syncthreads();
}
#undef KSWZ
#undef SBAR
}

constexpr int NWAVES = 8, NTHR = NWAVES * 64;
constexpr int DM = 2048, NB = 4, SEQ = 8192, NMETA = 16;
constexpr int MTOK = NB * SEQ;
constexpr int MROWS = MTOK + 256;
constexpr int DIN = 9 * DM;
constexpr int PKV = 64 + SEQ;
constexpr int NCHK = SEQ / 64;
constexpr int NE = 32, TOPK = 4, DFF = 2048;
constexpr int NASSIGN = MTOK * TOPK;
constexpr int RSLOT = NASSIGN + NE * 256;
constexpr float RMS_EPS = 1e-6f;
constexpr float LAMBDA_INIT = 0.2f;

constexpr size_t MiB = 1u << 20, KiB = 1u << 10;
constexpr size_t WS_CTL = 0, CTL_ZERO_BYTES = 1 * MiB;
constexpr size_t WS_SM = 1 * MiB;
constexpr size_t SM_LB = WS_SM, SM_LAM = WS_SM + 8 * KiB, SM_BT = WS_SM + 9 * KiB, SM_RSTD = WS_SM + 32 * KiB;
constexpr size_t SM_AE = WS_SM + 256 * KiB, SM_AR = WS_SM + 768 * KiB, SM_AG = WS_SM + 1280 * KiB, SM_TS = WS_SM + 1792 * KiB;
constexpr size_t SM_ST = WS_SM + 2304 * KiB, SM_SR = WS_SM + 2848 * KiB, SM_SG = WS_SM + 3392 * KiB;
static_assert(SM_SG + (size_t)RSLOT * 4 <= 5 * MiB && SM_RSTD + (size_t)MTOK * 4 <= SM_AE && SM_BT + 8 * 352 * 4 <= SM_RSTD, "small tables");
constexpr size_t WS_WOUT = 5 * MiB, WS_WR = 13 * MiB, WS_WGU = 14 * MiB, WS_WDN = 270 * MiB, WS_HG8 = 398 * MiB;
constexpr size_t WS_WIN = 782 * MiB, WS_U = 854 * MiB;
constexpr size_t WS_Y = WS_U;
constexpr size_t WS_QH = 983 * MiB, WS_KH = 1111 * MiB, WS_VH = 1240 * MiB, WS_HQ = 1369 * MiB, WS_HK = 1498 * MiB, WS_HGT = 1627 * MiB, WS_HV = 1756 * MiB;
constexpr size_t WS_OG = 1885 * MiB, WS_GA = 2013 * MiB, WS_GH = 2141 * MiB;
constexpr size_t WS_OP = 2269 * MiB, WS_DS = 2525 * MiB, WS_DEC = 2781 * MiB, WS_END = 2785 * MiB;
constexpr size_t WS_H2 = WS_HK;
constexpr size_t WS_ACT = WS_QH, WS_YS = WS_HGT;
constexpr float W8_SCALE = 64.f, ACT8_SCALE = 4.f, YS8_SCALE = 16.f;
static_assert(WS_ACT + (size_t)RSLOT * DM * 2 <= WS_HGT && WS_YS + (size_t)RSLOT * DM * 2 <= WS_OP && WS_HG8 + (size_t)MROWS * DM <= 782 * MiB, "MoE overlays");
static_assert(WS_KH + (size_t)NB * 16 * PKV * 128 * 2 <= WS_VH && WS_U + (size_t)MROWS * DM * 2 <= WS_QH && WS_WIN + (size_t)DIN * DM * 2 <= WS_U, "d_ws map");
constexpr int CW_CNT = 64;
constexpr int CW_BAR = 4096;

constexpr int RING_BYTES = 131072;
constexpr int XCH_OFF = 131072;
constexpr int CTRL_OFF = 147456;
constexpr int LDS_BYTES = 151552;
constexpr int NPHASE = 11;
#ifndef MK_N_LAUNCHES
#define MK_N_LAUNCHES 1
#endif
constexpr int N_LAUNCHES = MK_N_LAUNCHES;
static_assert(N_LAUNCHES == 1 || N_LAUNCHES == NPHASE, "launch cuts");

#define GAS __attribute__((address_space(1)))
#define LAS __attribute__((address_space(3)))
typedef unsigned short bf16;
typedef unsigned v4u __attribute__((ext_vector_type(4)));
typedef unsigned v2u __attribute__((ext_vector_type(2)));
typedef float f32x4 __attribute__((ext_vector_type(4)));
typedef float f32x16 __attribute__((ext_vector_type(16)));
typedef short bf16x8 __attribute__((ext_vector_type(8)));
#define LDS_WAIT() asm volatile("s_waitcnt lgkmcnt(0)" ::: "memory")
#define VM_WAIT() asm volatile("s_waitcnt vmcnt(0)" ::: "memory")
__device__ __forceinline__ unsigned f2bf(float f) { unsigned u = __builtin_bit_cast(unsigned, f); return (u + 0x7fffu + ((u >> 16) & 1u)) >> 16; }
typedef float f32x2_t __attribute__((ext_vector_type(2))); typedef __bf16 bf16x2_t __attribute__((ext_vector_type(2)));
__device__ __forceinline__ unsigned pk2(float lo, float hi) { f32x2_t v = {lo, hi}; bf16x2_t b = __builtin_convertvector(v, bf16x2_t); return __builtin_bit_cast(unsigned, b); }
__device__ __forceinline__ unsigned pk4_fp8(float a, float b, float c, float d) { unsigned w = 0u; w = __builtin_amdgcn_cvt_pk_fp8_f32(a, b, w, false); w = __builtin_amdgcn_cvt_pk_fp8_f32(c, d, w, true); return w; }
__device__ __forceinline__ float bf_lo(unsigned u) { return __builtin_bit_cast(float, u << 16); }
__device__ __forceinline__ float bf_hi(unsigned u) { return __builtin_bit_cast(float, u & 0xffff0000u); }
__device__ __forceinline__ float bf2f(bf16 h) { return __builtin_bit_cast(float, (unsigned)h << 16); }
__device__ __forceinline__ float sigmoidf_(float x) { return __builtin_amdgcn_rcpf(1.f + __expf(-x)); }
__device__ __forceinline__ float wave_sum(float v) {
#pragma unroll
    for (int o = 1; o < 64; o <<= 1) v += __shfl_xor(v, o);
    return v;
}
#define XB_TMO      128
#define XB_XCNT(j)  (256  + 64 * (j))
#define XB_XSUB(j)  (1280 + 64 * (j))
#define XB_XGEN(j)  (2304 + 64 * (j))
#define XB_TOP      3328
#define XB_TOPGEN   3392
#define XCD_BAR_WORDS 3456
#define XB_SPIN_CAP (1u << 18)

__device__ __forceinline__ unsigned xb_ld(unsigned* p)              { return __hip_atomic_load(p, __ATOMIC_RELAXED, __HIP_MEMORY_SCOPE_AGENT); }
__device__ __forceinline__ unsigned xb_add(unsigned* p, unsigned v) { return __hip_atomic_fetch_add(p, v, __ATOMIC_RELAXED, __HIP_MEMORY_SCOPE_AGENT); }
__device__ __forceinline__ unsigned xb_xcc_id() { return (unsigned)__builtin_amdgcn_s_getreg((3 << 11) | 20) & 0xFu; }
#define XB_SPIN(cond, bar) do { unsigned _sp = 0; while (cond) { __builtin_amdgcn_s_sleep(1); \
    if ((++_sp & 255u) == 0u) { if (xb_ld(&(bar)[XB_TMO])) break; if (_sp > XB_SPIN_CAP) { atomicAdd(&(bar)[XB_TMO], 1u); break; } } } } while (0)

struct XcdBarrier {
    unsigned* bar; unsigned x;
    volatile LAS unsigned* st;
};

__device__ __forceinline__ XcdBarrier xcd_barrier_post(unsigned* bar, volatile LAS unsigned* st) {
    XcdBarrier b; b.bar = bar; b.x = xb_xcc_id(); b.st = st;
    if (threadIdx.x == 0) (void)xb_add(&bar[XB_XCNT(b.x)], 1u);
    return b;
}
__device__ __forceinline__ void xcd_barrier_complete(unsigned* bar, unsigned x, unsigned& nloc, unsigned& nx) {
    const unsigned G = gridDim.x * gridDim.y * gridDim.z;
    unsigned sum, cnt, mine, sp = 0u;
    for (;;) {
        sum = 0u; cnt = 0u; mine = 0u;
#pragma unroll
        for (unsigned j = 0; j < 16; ++j) { const unsigned c = xb_ld(&bar[XB_XCNT(j)]); sum += c; cnt += (c > 0u) ? 1u : 0u; mine = (j == x) ? c : mine; }
        if (sum == G) break;
        __builtin_amdgcn_s_sleep(1);
        if ((++sp & 255u) == 0u) { if (xb_ld(&bar[XB_TMO])) break; if (sp > XB_SPIN_CAP) { atomicAdd(&bar[XB_TMO], 1u); break; } }
    }
    nloc = mine > 0u ? mine : 1u; nx = cnt > 0u ? cnt : 1u;
}

__device__ __forceinline__ void xcd_barrier(const XcdBarrier& b) {
    asm volatile("s_waitcnt vmcnt(0)" ::: "memory");
    __syncthreads();
    if (threadIdx.x == 0) {
        unsigned* bar = b.bar;
        __builtin_amdgcn_s_waitcnt(0);
        unsigned nloc = b.st[0], nx = b.st[1];
        if (nloc == 0u) { xcd_barrier_complete(bar, b.x, nloc, nx); b.st[0] = nloc; b.st[1] = nx; }
        const unsigned old = xb_add(&bar[XB_XSUB(b.x)], 1u);
        const unsigned gen = old / nloc;
        if (old + 1u == (gen + 1u) * nloc) {
            __builtin_amdgcn_fence(__ATOMIC_RELEASE, "agent");
            asm volatile("s_waitcnt vmcnt(0)" ::: "memory");
            const unsigned og = xb_add(&bar[XB_TOP], 1u);
            const unsigned tg = og / nx;
            if (og + 1u == (tg + 1u) * nx) xb_add(&bar[XB_TOPGEN], 1u);
            else XB_SPIN(xb_ld(&bar[XB_TOPGEN]) == tg, bar);
            __builtin_amdgcn_fence(__ATOMIC_ACQUIRE, "agent");
            xb_add(&bar[XB_XGEN(b.x)], 1u);
            asm volatile("s_waitcnt vmcnt(0)" ::: "memory");
        } else {
            XB_SPIN(xb_ld(&bar[XB_XGEN(b.x)]) == gen, bar);
            __builtin_amdgcn_fence(__ATOMIC_ACQUIRE, "agent");
            asm volatile("s_waitcnt vmcnt(0)" ::: "memory");
        }
    }
    __syncthreads();
}


__device__ __forceinline__ void static_order(int L, int nM, int nN, int& pm, int& pn) {
    const int nwg = nM * nN, q = nwg / 8, xcd = L & 7, off = L >> 3; const int wgid = xcd * q + off;
    const int nig = 8 * nN, gid = wgid / nig, fm = gid * 8; pm = fm + ((wgid % nig) & 7); pn = (wgid % nig) >> 3;
}
struct SchedInProj {
    int G, c; const bf16* Bt;
    __device__ __forceinline__ bool next(int i, pg8::Unit& u) const {
        u.e = 0;
        const long L = (long)i * G + c; if (L >= 128 * 72) return false;
        static_order((int)L, 128, 72, u.pm, u.pn); u.aux = 0; return true;
    }
    __device__ __forceinline__ unsigned arow(const pg8::Unit& u, int r) const { return (unsigned)(u.pm * 256 + r); }
    __device__ __forceinline__ const void* bbase() const { return Bt; }
    __device__ __forceinline__ unsigned boff(const pg8::Unit& u) const { return (unsigned)u.pn * (256u * DM * 2u); }
};
struct SchedPlain {
    int G, c, nM, nN; const bf16* Bt;
    __device__ __forceinline__ bool next(int i, pg8::Unit& u) const {
        const long L = (long)i * G + c; if (L >= (long)nM * nN) return false;
        static_order((int)L, nM, nN, u.pm, u.pn); u.e = 0; u.aux = 0; return true;
    }
    __device__ __forceinline__ unsigned arow(const pg8::Unit& u, int r) const { return (unsigned)(u.pm * 256 + r); }
    __device__ __forceinline__ const void* bbase() const { return Bt; }
    __device__ __forceinline__ unsigned boff(const pg8::Unit& u) const { return (unsigned)u.pn * (256u * DM * 2u); }
};
struct SchedMoE {
    int G, c, npn; const LAS int* tstart; const unsigned char* W; size_t wstride, tilebytes; const int* slot_tok;
    __device__ __forceinline__ bool next(int i, pg8::Unit& u) const {
        const int L = i * G + c; if (L >= tstart[32] * npn) return false;
        int e = 0;
#pragma unroll 8
        for (int j = 1; j <= 32; ++j) e += (L >= tstart[j] * npn) ? 1 : 0;
        e = __builtin_amdgcn_readfirstlane(e);
        const int t0 = __builtin_amdgcn_readfirstlane(tstart[e]), t1 = __builtin_amdgcn_readfirstlane(tstart[e + 1]), w = L - t0 * npn, ne = t1 - t0;
        u.pn = w / ne; u.pm = t0 + w % ne; u.e = e; u.aux = 0; return true;
    }
    __device__ __forceinline__ unsigned arow(const pg8::Unit& u, int r) const { const int slot = u.pm * 256 + r; return slot_tok ? (unsigned)slot_tok[slot] : (unsigned)slot; }
    __device__ __forceinline__ const void* bbase() const { return W; }
    __device__ __forceinline__ unsigned boff(const pg8::Unit& u) const { return (unsigned)u.e * (unsigned)wstride + (unsigned)u.pn * (unsigned)tilebytes; }
};

__device__ __forceinline__ v4u rowperm(v4u w, int src4) { v4u r; r.x = (unsigned)__builtin_amdgcn_ds_bpermute(src4, (int)w.x); r.y = (unsigned)__builtin_amdgcn_ds_bpermute(src4, (int)w.y); r.z = (unsigned)__builtin_amdgcn_ds_bpermute(src4, (int)w.z); r.w = (unsigned)__builtin_amdgcn_ds_bpermute(src4, (int)w.w); return r; }
__device__ __forceinline__ v2u rowperm2(v2u w, int src4) { v2u r; r.x = (unsigned)__builtin_amdgcn_ds_bpermute(src4, (int)w.x); r.y = (unsigned)__builtin_amdgcn_ds_bpermute(src4, (int)w.y); return r; }
__device__ __forceinline__ f32x4 rowpermf(f32x4 w, int src4) { return __builtin_bit_cast(f32x4, rowperm(__builtin_bit_cast(v4u, w), src4)); }
#define ROWPERM_SETUP() const int src4_ = (((lane >> 2) + 16 * (lane & 3)) << 2), frp = lane >> 2, fqp = lane & 3; (void)src4_; (void)frp; (void)fqp

struct EpiInProj {
    static constexpr bool PERM = true;
    unsigned char* ws; const float *qg, *kg; LAS float* xch;
    __device__ __forceinline__ void st_hm(bf16* base, int slen, int poff, bool meta, int b, int s, int rl, int head16, int d0, v4u w) const {
        if (!meta) { *(v4u*)(base + ((size_t)(b * 16 + head16) * slen + poff + s) * 128 + d0) = w; }
        else if (rl < 16) {
#pragma unroll
            for (int bb = 0; bb < NB; ++bb) *(v4u*)(base + ((size_t)(bb * 16 + head16) * slen + 48 + rl) * 128 + d0) = w; }
    }
    __device__ __forceinline__ void prefetch(const pg8::Unit&, int, int) const {}
    __device__ __forceinline__ void operator()(const pg8::f32x4 (&acc)[2][2][4][2], const pg8::Unit& u, int wr, int wc, int fr, int fq, int wid, int lane) const {
        asm volatile("" : "+v"(fr), "+v"(fq));
        const int grp = u.pn >> 3, pl = u.pn & 7; const bool meta = u.aux != 0;
        const int d0 = 32 * wc + 8 * fq, b = u.pm >> 5, sb = (u.pm & 31) * 256;
        ROWPERM_SETUP(); const int d0p = 32 * wc + 8 * fqp;
        if (grp <= 1) {
            f32x4 g0, g1;
            if (grp == 0) { g0 = *(const f32x4*)(qg + d0); g1 = *(const f32x4*)(qg + d0 + 4); } else { g0 = *(const f32x4*)(kg + d0); g1 = *(const f32x4*)(kg + d0 + 4); }
            bf16* const QH = (bf16*)(ws + WS_QH); bf16* const KH = (bf16*)(ws + WS_KH);
#pragma unroll
            for (int ai = 0; ai < 2; ++ai)
#pragma unroll
                for (int m = 0; m < 4; ++m)
#pragma unroll
                    for (int bj = 0; bj < 2; ++bj) {
                        const f32x4 a = acc[ai][bj][m][0], c = acc[ai][bj][m][1];
                        float s = (a[0] * a[0] + a[1] * a[1]) + (a[2] * a[2] + a[3] * a[3]) + (c[0] * c[0] + c[1] * c[1]) + (c[2] * c[2] + c[3] * c[3]);
                        s += __shfl_xor(s, 16); s += __shfl_xor(s, 32);
                        const int rl = 128 * ai + 64 * wr + 16 * m + fr;
                        if (fq == 0) xch[(rl * 2 + bj) * 4 + wc] = s;
                    }
            LDS_WAIT(); __builtin_amdgcn_s_barrier(); asm volatile("" ::: "memory");
#pragma unroll
            for (int ai = 0; ai < 2; ++ai)
#pragma unroll
                for (int m = 0; m < 4; ++m)
#pragma unroll
                    for (int bj = 0; bj < 2; ++bj) {
                        const int rl = 128 * ai + 64 * wr + 16 * m + fr;
                        const f32x4 p = *(const LAS f32x4*)(xch + (rl * 2 + bj) * 4);
                        const float rs = __builtin_amdgcn_rsqf(((p[0] + p[1]) + (p[2] + p[3])) * (1.f / 128.f) + RMS_EPS);
                        const float rq = grp == 0 ? rs * (att::SCALE * 1.4426950408889634f) : rs;
                        const f32x4 a = acc[ai][bj][m][0] * rq * g0, c = acc[ai][bj][m][1] * rq * g1;
                        v4u w; w.x = pk2(a[0], a[1]); w.y = pk2(a[2], a[3]); w.z = pk2(c[0], c[1]); w.w = pk2(c[2], c[3]);
                        w = rowperm(w, src4_); const int rlp = 128 * ai + 64 * wr + 16 * m + frp;
                        if (grp == 0) { if (!meta) *(v4u*)(QH + ((size_t)(b * 16 + 2 * pl + bj) * SEQ + sb + rlp) * 128 + d0p) = w; }
                        else st_hm(KH, PKV, 64, meta, b, sb + rlp, rlp, 2 * pl + bj, d0p, w);
                    }
        } else if (grp == 4) {
            unsigned char* dst = ws + WS_HGT;
#pragma unroll
            for (int ai = 0; ai < 2; ++ai)
#pragma unroll
                for (int m = 0; m < 4; ++m)
#pragma unroll
                    for (int bj = 0; bj < 2; ++bj) {
                        const int rlp = 128 * ai + 64 * wr + 16 * m + frp; const f32x4 a = acc[ai][bj][m][0], c = acc[ai][bj][m][1];
                        unsigned q[8];
#pragma unroll
                        for (int j = 0; j < 4; ++j) { q[j] = (unsigned)(sigmoidf_(a[j]) * 255.f + 0.5f); q[4 + j] = (unsigned)(sigmoidf_(c[j]) * 255.f + 0.5f); }
                        const v2u w = rowperm2((v2u){q[0] | (q[1] << 8) | (q[2] << 16) | (q[3] << 24), q[4] | (q[5] << 8) | (q[6] << 16) | (q[7] << 24)}, src4_);
                        if (!meta) *(v2u*)(dst + ((size_t)(b * 16 + 2 * pl + bj) * PKV + 64 + sb + rlp) * 128 + d0p) = w;
                        else if (rlp < 16) {
#pragma unroll
                            for (int bb = 0; bb < NB; ++bb) *(v2u*)(dst + ((size_t)(bb * 16 + 2 * pl + bj) * PKV + 48 + rlp) * 128 + d0p) = w; }
                    }
        } else if (grp <= 5) {
            if (!(meta && grp == 3)) {
            bf16* dst = (bf16*)(ws + (grp == 2 ? WS_VH : grp == 3 ? WS_HQ : WS_HV));
#pragma unroll
            for (int ai = 0; ai < 2; ++ai)
#pragma unroll
                for (int m = 0; m < 4; ++m)
#pragma unroll
                    for (int bj = 0; bj < 2; ++bj) {
                        const int rlp = 128 * ai + 64 * wr + 16 * m + frp; const f32x4 a = acc[ai][bj][m][0], c = acc[ai][bj][m][1];
                        v4u w; w.x = pk2(a[0], a[1]); w.y = pk2(a[2], a[3]); w.z = pk2(c[0], c[1]); w.w = pk2(c[2], c[3]);
                        w = rowperm(w, src4_);
                        st_hm(dst, PKV, 64, meta, b, sb + rlp, rlp, 2 * pl + bj, d0p, w);
                    }
            }
        } else if (!meta && grp == 6) {
            bf16* dst = (bf16*)(ws + WS_OG);
#pragma unroll
            for (int ai = 0; ai < 2; ++ai)
#pragma unroll
                for (int m = 0; m < 4; ++m)
#pragma unroll
                    for (int bj = 0; bj < 2; ++bj) {
                        const int rlp = 128 * ai + 64 * wr + 16 * m + frp; const f32x4 a = acc[ai][bj][m][0], c = acc[ai][bj][m][1];
                        v4u w; w.x = pk2(a[0], a[1]); w.y = pk2(a[2], a[3]); w.z = pk2(c[0], c[1]); w.w = pk2(c[2], c[3]);
                        w = rowperm(w, src4_);
                        *(v4u*)(dst + (size_t)(u.pm * 256 + rlp) * DM + 256 * pl + 128 * bj + d0p) = w;
                    }
        } else if (!meta) {
            unsigned char* dst = ws + (grp == 7 ? WS_GA : WS_GH);
#pragma unroll
            for (int ai = 0; ai < 2; ++ai)
#pragma unroll
                for (int m = 0; m < 4; ++m)
#pragma unroll
                    for (int bj = 0; bj < 2; ++bj) {
                        const int rlp = 128 * ai + 64 * wr + 16 * m + frp; const f32x4 a = acc[ai][bj][m][0], c = acc[ai][bj][m][1];
                        unsigned q[8];
#pragma unroll
                        for (int j = 0; j < 4; ++j) { q[j] = (unsigned)(sigmoidf_(a[j]) * 255.f + 0.5f); q[4 + j] = (unsigned)(sigmoidf_(c[j]) * 255.f + 0.5f); }
                        const v2u w = rowperm2((v2u){q[0] | (q[1] << 8) | (q[2] << 16) | (q[3] << 24), q[4] | (q[5] << 8) | (q[6] << 16) | (q[7] << 24)}, src4_);
                        *(v2u*)(dst + (size_t)(u.pm * 256 + rlp) * DM + 256 * pl + 128 * bj + d0p) = w;
                    }
        }
    }
};
struct EpiOutProj {
    static constexpr bool PERM = true;
    const float* x; bf16* h2;
    __device__ __forceinline__ void prefetch(const pg8::Unit&, int, int) const {}
    __device__ __forceinline__ void operator()(const pg8::f32x4 (&acc)[2][2][4][2], const pg8::Unit& u, int wr, int wc, int fr, int fq, int wid, int lane) const {
        asm volatile("" : "+v"(fr), "+v"(fq));
        ROWPERM_SETUP();
        const int row0 = u.pm * 256 + wr * 64 + frp, col0 = u.pn * 256 + wc * 32 + 8 * fqp;
#pragma unroll
        for (int ai = 0; ai < 2; ++ai) {
            f32x4 xv[4][2][2];
#pragma unroll
            for (int m = 0; m < 4; ++m) { const size_t off = (size_t)(row0 + ai * 128 + m * 16) * DM + col0;
#pragma unroll
                for (int bj = 0; bj < 2; ++bj) { xv[m][bj][0] = *(const f32x4*)(x + off + bj * 128); xv[m][bj][1] = *(const f32x4*)(x + off + bj * 128 + 4); } }
#pragma unroll
            for (int m = 0; m < 4; ++m) { const size_t off = (size_t)(row0 + ai * 128 + m * 16) * DM + col0;
#pragma unroll
                for (int bj = 0; bj < 2; ++bj) {
                    const f32x4 a = xv[m][bj][0] + rowpermf(acc[ai][bj][m][0], src4_), c = xv[m][bj][1] + rowpermf(acc[ai][bj][m][1], src4_);
                    *(v4u*)(h2 + off + bj * 128) = (v4u){pk2(a[0], a[1]), pk2(a[2], a[3]), pk2(c[0], c[1]), pk2(c[2], c[3])}; } }
            asm volatile("" ::: "memory"); }
    }
};
struct EpiGateUp {
    static constexpr bool PERM = true;
    const float* bgu; const float* slot_rstd; unsigned char* ACT; LAS unsigned char* xch;
    __device__ __forceinline__ void prefetch(const pg8::Unit& u, int wid, int lane) const {
        const float* src = wid < 4 ? slot_rstd + u.pm * 256 + wid * 64 : bgu + (size_t)u.e * (2 * DFF) + 128 * u.pn + (wid < 6 ? (wid - 4) * 64 : DFF + (wid - 6) * 64);
        __builtin_amdgcn_global_load_lds((const unsigned*)(src + lane), (LAS unsigned*)(xch + u.par * 2048 + wid * 256), 4, 0, 0);
    }
    __device__ __forceinline__ void operator()(const pg8::f32x4 (&acc)[2][2][4][2], const pg8::Unit& u, int wr, int wc, int fr, int fq, int wid, int lane) const {
        asm volatile("" : "+v"(fr), "+v"(fq));
        ROWPERM_SETUP();
        const int d0 = 32 * wc + 8 * fq; const LAS float* xp = (const LAS float*)(xch + u.par * 2048);
        const f32x4 bg0 = *(const LAS f32x4*)(xp + 256 + d0), bg1 = *(const LAS f32x4*)(xp + 256 + d0 + 4), bl0 = *(const LAS f32x4*)(xp + 384 + d0), bl1 = *(const LAS f32x4*)(xp + 384 + d0 + 4);
#pragma unroll
        for (int ai = 0; ai < 2; ++ai)
#pragma unroll
            for (int m = 0; m < 4; ++m) {
                const float rs = xp[128 * ai + 64 * wr + 16 * m + fr] * (1.f / W8_SCALE);
                f32x4 o[2];
#pragma unroll
                for (int n = 0; n < 2; ++n) { const f32x4 g = acc[ai][0][m][n] * rs + (n ? bg1 : bg0), l = acc[ai][1][m][n] * rs + (n ? bl1 : bl0);
#pragma unroll
                    for (int j = 0; j < 4; ++j) { const float xg = fminf(g[j], 7.f), xl = fminf(fmaxf(l[j], -7.f), 7.f);
                        o[n][j] = (xg * __builtin_amdgcn_rcpf(1.f + __builtin_amdgcn_exp2f(xg * (-1.702f * 1.4426950408889634f)))) * __builtin_fmaf(xl, ACT8_SCALE, ACT8_SCALE); } }
                const v2u w8 = rowperm2((v2u){pk4_fp8(o[0][0], o[0][1], o[0][2], o[0][3]), pk4_fp8(o[1][0], o[1][1], o[1][2], o[1][3])}, src4_);
                *(v2u*)(ACT + (size_t)(u.pm * 256 + 128 * ai + 64 * wr + 16 * m + frp) * DFF + 128 * u.pn + 32 * wc + 8 * fqp) = w8;
            }
    }
};
struct EpiDown {
    static constexpr bool PERM = true;
    const float* bdn; const float* slot_gate; unsigned char* YS; LAS unsigned char* xch;
    __device__ __forceinline__ void prefetch(const pg8::Unit& u, int wid, int lane) const {
        const float* src = wid < 4 ? slot_gate + u.pm * 256 + wid * 64 : bdn + (size_t)u.e * DM + 256 * u.pn + (wid - 4) * 64;
        __builtin_amdgcn_global_load_lds((const unsigned*)(src + lane), (LAS unsigned*)(xch + u.par * 2048 + wid * 256), 4, 0, 0);
    }
    __device__ __forceinline__ void operator()(const pg8::f32x4 (&acc)[2][2][4][2], const pg8::Unit& u, int wr, int wc, int fr, int fq, int wid, int lane) const {
        asm volatile("" : "+v"(fr), "+v"(fq));
        ROWPERM_SETUP();
        const int d0 = 32 * wc + 8 * fq; const LAS float* xp = (const LAS float*)(xch + u.par * 2048);
        f32x4 bv[2][2];
#pragma unroll
        for (int bj = 0; bj < 2; ++bj) { bv[bj][0] = *(const LAS f32x4*)(xp + 256 + 128 * bj + d0); bv[bj][1] = *(const LAS f32x4*)(xp + 256 + 128 * bj + d0 + 4); }
#pragma unroll
        for (int ai = 0; ai < 2; ++ai)
#pragma unroll
            for (int m = 0; m < 4; ++m) {
                const float gt = xp[128 * ai + 64 * wr + 16 * m + fr] * YS8_SCALE;
#pragma unroll
                for (int bj = 0; bj < 2; ++bj) { const f32x4 a = (acc[ai][bj][m][0] * (1.f / (W8_SCALE * ACT8_SCALE)) + bv[bj][0]) * gt, c = (acc[ai][bj][m][1] * (1.f / (W8_SCALE * ACT8_SCALE)) + bv[bj][1]) * gt;
                    const v2u w = {pk4_fp8(a[0], a[1], a[2], a[3]), pk4_fp8(c[0], c[1], c[2], c[3])};
                    *(v2u*)(YS + (size_t)(u.pm * 256 + 128 * ai + 64 * wr + 16 * m + frp) * DM + 256 * u.pn + 128 * bj + 32 * wc + 8 * fqp) = rowperm2(w, src4_); }
            }
    }
};

template <int NAI, int NM>
struct EpiStoreOnly {
    static constexpr bool PERM = true;
    bf16* O;
    __device__ __forceinline__ void prefetch(const pg8::Unit&, int, int) const {}
    __device__ __forceinline__ void operator()(const pg8::f32x4 (&acc)[2][2][4][2], const pg8::Unit& u, int wr, int wc, int fr, int fq, int wid, int lane) const {
        asm volatile("" : "+v"(fr), "+v"(fq));
        ROWPERM_SETUP();
#pragma unroll
        for (int ai = 0; ai < 2; ++ai)
#pragma unroll
            for (int m = 0; m < 4; ++m) {
#pragma unroll
                for (int bj = 0; bj < 2; ++bj) { const f32x4 a = acc[ai][bj][m][0], c = acc[ai][bj][m][1];
                    if (ai < NAI && m < NM) { v4u w; w.x = pk2(a[0], a[1]); w.y = pk2(a[2], a[3]); w.z = pk2(c[0], c[1]); w.w = pk2(c[2], c[3]);
                        *(v4u*)(O + (size_t)(u.pm * 256 + 128 * ai + 64 * wr + 16 * m + frp) * DM + 256 * u.pn + 128 * bj + 32 * wc + 8 * fqp) = rowperm(w, src4_); }
                    else { asm volatile("" :: "v"(a), "v"(c)); } }
            }
    }
};
struct EpiNull {
    static constexpr bool PERM = true;
    __device__ __forceinline__ void prefetch(const pg8::Unit&, int, int) const {}
    __device__ __forceinline__ void operator()(const pg8::f32x4 (&acc)[2][2][4][2], const pg8::Unit& u, int wr, int wc, int fr, int fq, int wid, int lane) const {
#pragma unroll
        for (int ai = 0; ai < 2; ++ai)
#pragma unroll
            for (int bj = 0; bj < 2; ++bj)
#pragma unroll
                for (int m = 0; m < 4; ++m)
#pragma unroll
                    for (int n = 0; n < 2; ++n) asm volatile("" :: "v"(acc[ai][bj][m][n]));
    }
};

__device__ __forceinline__ void p0_transpose_item(const float* W, int ldw, bf16* WT, int k0, int n0, size_t dst_row0, LAS float* scr, int lane) {
    float v[32];
#pragma unroll
    for (int i = 0; i < 32; ++i) { const int kk = 2 * i + (lane >> 5); v[i] = W[(size_t)(k0 + kk) * ldw + n0 + (lane & 31)]; }
#pragma unroll
    for (int i = 0; i < 32; ++i) { const int kk = 2 * i + (lane >> 5); scr[kk * 33 + (lane & 31)] = v[i]; }
    LDS_WAIT(); asm volatile("" ::: "memory");
    const int c = lane & 7;
#pragma unroll
    for (int j = 0; j < 4; ++j) { const int n = (lane >> 3) + 8 * j; const LAS float* s = scr + (8 * c) * 33 + n;
        v4u o; o.x = pk2(s[0 * 33], s[1 * 33]); o.y = pk2(s[2 * 33], s[3 * 33]); o.z = pk2(s[4 * 33], s[5 * 33]); o.w = pk2(s[6 * 33], s[7 * 33]);
        *(v4u*)(WT + (dst_row0 + n) * DM + k0 + 8 * c) = o; }
    LDS_WAIT(); asm volatile("" ::: "memory");
}
__device__ __forceinline__ void p0_transpose_item_fp8(const float* W, int ldw, unsigned char* WT, int k0, int n0, size_t dst_row0, float scale, LAS float* scr, int lane) {
    float v[32];
#pragma unroll
    for (int i = 0; i < 32; ++i) { const int kk = 2 * i + (lane >> 5); v[i] = W[(size_t)(k0 + kk) * ldw + n0 + (lane & 31)]; }
#pragma unroll
    for (int i = 0; i < 32; ++i) { const int kk = 2 * i + (lane >> 5); scr[kk * 33 + (lane & 31)] = v[i] * scale; }
    LDS_WAIT(); asm volatile("" ::: "memory");
    const int c = lane & 7;
#pragma unroll
    for (int j = 0; j < 4; ++j) { const int n = (lane >> 3) + 8 * j; const LAS float* s = scr + (8 * c) * 33 + n;
        *(v2u*)(WT + (dst_row0 + n) * DM + k0 + 8 * c) = (v2u){pk4_fp8(s[0 * 33], s[1 * 33], s[2 * 33], s[3 * 33]), pk4_fp8(s[4 * 33], s[5 * 33], s[6 * 33], s[7 * 33])}; }
    LDS_WAIT(); asm volatile("" ::: "memory");
}
__device__ __forceinline__ void rms_row_to_bf16(const float* xrow, const float* gain, bf16* orow, int lane) {
    const f32x4* xr = (const f32x4*)xrow + lane; const f32x4* gr = (const f32x4*)gain + lane;
    f32x4 v[8]; float s = 0.f;
#pragma unroll
    for (int j = 0; j < 8; ++j) { v[j] = xr[64 * j]; s += (v[j][0] * v[j][0] + v[j][1] * v[j][1]) + (v[j][2] * v[j][2] + v[j][3] * v[j][3]); }
    const float rs = __builtin_amdgcn_rsqf(wave_sum(s) * (1.f / DM) + RMS_EPS);
    v2u* o8 = (v2u*)orow + lane;
#pragma unroll
    for (int j = 0; j < 8; ++j) { const f32x4 g = gr[64 * j]; v2u w; w.x = pk2(v[j][0] * rs * g[0], v[j][1] * rs * g[1]); w.y = pk2(v[j][2] * rs * g[2], v[j][3] * rs * g[3]); o8[64 * j] = w; }
}
__device__ __forceinline__ int t5_bucket(int n) {
    if (n < 16) return n;
    const int l = 16 + (int)(__builtin_logf((float)n / 16.f) / 2.0794415416798357f * 16.f);
    return l < 31 ? l : 31;
}
struct P0Args { const float *x, *meta, *rel_bias, *lb_logits, *norm1, *w_in, *diff_lambda, *w_out, *router_w, *w_gu, *w_dn, *qg, *kg; unsigned char* ws; };
__device__ __forceinline__ void p0_prologue(const P0Args& a, LAS unsigned char* lds, int vcu, int G, int tid) {
    const int lane = tid & 63, wave = __builtin_amdgcn_readfirstlane(tid >> 6);
    const int gw = vcu * NWAVES + wave, NGW = G * NWAVES; const long gid = (long)vcu * NTHR + tid, NG = (long)G * NTHR;
    unsigned char* ws = a.ws;
    float* lbp = (float*)(ws + SM_LB);
    for (long i = gid; i < DM; i += NG) lbp[i] = sigmoidf_(a.lb_logits[i] - a.lb_logits[DM + i]);
    if (gw == 0) { const float* lv = a.diff_lambda; float s1 = lv[lane] * lv[128 + lane] + lv[64 + lane] * lv[192 + lane], s2 = lv[256 + lane] * lv[384 + lane] + lv[320 + lane] * lv[448 + lane];
        s1 = wave_sum(s1); s2 = wave_sum(s2); if (lane == 0) *(float*)(ws + SM_LAM) = __expf(s1) - __expf(s2) + LAMBDA_INIT;
        float qm = fmaxf(fabsf(a.qg[lane]), fabsf(a.qg[64 + lane])), km = fmaxf(fabsf(a.kg[lane]), fabsf(a.kg[64 + lane])), bm = 0.f;
#pragma unroll
        for (int j = 0; j < 4; ++j) { const int e = lane + 64 * j; bm = fmaxf(bm, fabsf(a.rel_bias[e] - a.rel_bias[31 * 8 + (e & 7)])); }
#pragma unroll
        for (int o = 1; o < 64; o <<= 1) { qm = fmaxf(qm, __shfl_xor(qm, o)); km = fmaxf(km, __shfl_xor(km, o)); bm = fmaxf(bm, __shfl_xor(bm, o)); }
        if (lane == 0) *(int*)(ws + SM_LAM + 4) = (11.3137085f * qm * km + bm < 60.f) ? 1 : 0; }
    { float* bt = (float*)(ws + SM_BT);
      for (long i = gid; i < 8 * att::BT_LEN; i += NG) { const int h = (int)i / att::BT_LEN, rel = (int)i % att::BT_LEN - att::BT_OFF;
          bt[i] = (rel >= 0 && rel < 113) ? (a.rel_bias[t5_bucket(rel) * 8 + h] - a.rel_bias[31 * 8 + h]) * 1.4426950408889634f : 0.f; } }
    { int* st = (int*)(ws + SM_ST); float* sr = (float*)(ws + SM_SR); float* sg = (float*)(ws + SM_SG);
      for (long i = gid; i < RSLOT; i += NG) { st[i] = MTOK; sr[i] = 0.f; sg[i] = 0.f; } }
    { const v4u z = {0u, 0u, 0u, 0u}, big = {0xffffffffu, 0xffffffffu, 0xffffffffu, 0xffffffffu};
      for (long i = gid; i < 4L * 64 * 768; i += NG) { const int tsel = (int)(i / (64 * 768)), r = (int)(i % (64 * 768)), bh = r / 768, q = r % 768;
          const size_t base = tsel == 0 ? WS_KH : tsel == 1 ? WS_VH : tsel == 2 ? WS_HGT : WS_HV;
          if (tsel != 2) *(v4u*)(ws + base + ((size_t)bh * PKV * 128) * 2 + (size_t)q * 16) = z;
          else if (q < 384) *(v4u*)(ws + base + (size_t)bh * PKV * 128 + (size_t)q * 16) = big; }
      for (long i = gid; i < 240L * 256; i += NG) *(v4u*)(ws + WS_U + (size_t)(MTOK + 16) * DM * 2 + (size_t)i * 16) = z; }
    for (int m = gw; m < MTOK + NMETA; m += NGW) rms_row_to_bf16(m < MTOK ? a.x + (size_t)m * DM : a.meta + (size_t)(m - MTOK) * DM, a.norm1, (bf16*)(ws + WS_U) + (size_t)m * DM, lane);
    LAS float* scr = (LAS float*)(lds + wave * 17408);
    constexpr int I_IN = 16 * (DIN / 32), I_OUT = 16 * 64, I_R = 16, I_GU = 16 * 128, I_DN = 16 * 64;
    constexpr int NITEMS = I_IN + I_OUT + I_R + NE * (I_GU + I_DN);
#define P0_DECODE(it_, src_, ldw_, dst_, f8_) do { int r = (it_); \
        if (r < I_IN) { const int nb = r % (DIN / 32), kb = r / (DIN / 32); src_ = a.w_in + (size_t)(128 * kb) * DIN + 32 * nb; ldw_ = DIN; dst_ = ws + WS_WIN + ((size_t)32 * nb * DM + 128 * kb) * 2; f8_ = false; } \
        else if ((r -= I_IN) < I_OUT) { const int nb = r % 64, kb = r / 64; src_ = a.w_out + (size_t)(128 * kb) * DM + 32 * nb; ldw_ = DM; dst_ = ws + WS_WOUT + ((size_t)32 * nb * DM + 128 * kb) * 2; f8_ = false; } \
        else if ((r -= I_OUT) < I_R) { src_ = a.router_w + (size_t)(128 * r) * NE; ldw_ = NE; dst_ = ws + WS_WR + (size_t)(128 * r) * 2; f8_ = false; } \
        else { r -= I_R; const int e = r / (I_GU + I_DN); r -= e * (I_GU + I_DN); \
            if (r < I_GU) { const int nb = r % 128, kb = r / 128, n0 = 32 * nb, nn = n0 & (DFF - 1); const size_t drow = (size_t)e * (2 * DFF) + (size_t)(nn >> 7) * 256 + (n0 >= DFF ? 128 : 0) + (nn & 127);     \
                src_ = a.w_gu + (size_t)e * DM * 2 * DFF + (size_t)(128 * kb) * (2 * DFF) + n0; ldw_ = 2 * DFF; dst_ = ws + WS_WGU + drow * DM + 128 * kb; f8_ = true; } \
            else { r -= I_GU; const int nb = r % 64, kb = r / 64; src_ = a.w_dn + (size_t)e * DFF * DM + (size_t)(128 * kb) * DM + 32 * nb; ldw_ = DM; dst_ = ws + WS_WDN + ((size_t)e * DM + 32 * nb) * DM + 128 * kb; f8_ = true; } } } while (0)
#define P0_LOAD(v_, src_, ldw_) do { _Pragma("unroll") for (int i = 0; i < 16; ++i) { const f32x4 t_ = *(const f32x4*)((src_) + (size_t)(8 * i + (lane >> 3)) * (ldw_) + 4 * (lane & 7)); v_[4 * i] = t_[0]; v_[4 * i + 1] = t_[1]; v_[4 * i + 2] = t_[2]; v_[4 * i + 3] = t_[3]; } } while (0)
    int it = gw;
    if (it < NITEMS) {
        const float* csrc; int cldw; unsigned char* cdst; bool cf8; float v[64];
        P0_DECODE(it, csrc, cldw, cdst, cf8); P0_LOAD(v, csrc, cldw);
        for (;;) {
            const int itn = it + NGW; const bool more = itn < NITEMS;
            const float* nsrc = csrc; int nldw = cldw; unsigned char* ndst = cdst; bool nf8 = cf8; float vn[64];
            if (more) { P0_DECODE(itn, nsrc, nldw, ndst, nf8); P0_LOAD(vn, nsrc, nldw); }
            const float sc = cf8 ? W8_SCALE : 1.f;
#pragma unroll
            for (int i = 0; i < 64; ++i) scr[(8 * (i >> 2) + (lane >> 3)) * 33 + (i >> 2) * 4 + 4 * (lane & 7) + (i & 3)] = v[i] * sc;
            LDS_WAIT(); asm volatile("" ::: "memory");
            const int c = lane >> 2;
#pragma unroll
            for (int j = 0; j < 8; ++j) { const int n = (lane & 3) + 4 * j; const LAS float* q = scr + (8 * c) * 33 + c * 4 + n;
                const float x0 = q[0], x1 = q[33], x2 = q[66], x3 = q[99], x4 = q[132], x5 = q[165], x6 = q[198], x7 = q[231];
                if (cf8) *(v2u*)(cdst + (size_t)n * DM + 8 * c) = (v2u){pk4_fp8(x0, x1, x2, x3), pk4_fp8(x4, x5, x6, x7)};
                else *(v4u*)(cdst + ((size_t)n * DM + 8 * c) * 2) = (v4u){pk2(x0, x1), pk2(x2, x3), pk2(x4, x5), pk2(x6, x7)}; }
            LDS_WAIT(); asm volatile("" ::: "memory");
            if (!more) break;
            it = itn; csrc = nsrc; cldw = nldw; cdst = ndst; cf8 = nf8;
#pragma unroll
            for (int i = 0; i < 64; ++i) v[i] = vn[i];
        }
    }
#undef P0_DECODE
#undef P0_LOAD
}

typedef LAS bf16x8 lbf8; typedef LAS v4u lv4u;
#define MFMA32(a, b, c) __builtin_amdgcn_mfma_f32_32x32x16_bf16(a, b, c, 0, 0, 0)
#define MFMA16(a, b, c) __builtin_amdgcn_mfma_f32_16x16x32_bf16(a, b, c, 0, 0, 0)
__device__ __forceinline__ int crow32(int r, int hi) { return (r & 3) + 8 * (r >> 2) + 4 * hi; }
__device__ __forceinline__ void hgrn_a_dma(const unsigned char* HF, const bf16* HV, int bh, int c, LAS unsigned char* raw, int wid, int lane) {
    typedef __attribute__((address_space(3))) unsigned lds_u32;
    const size_t t0 = ((size_t)bh * PKV + 64 * c) * 128; const int q = (wid * 128 + lane) * 8;
    __builtin_amdgcn_global_load_lds((const unsigned*)(HF + t0 + (wid * 64 + lane) * 16), (lds_u32*)(raw + wid * 1024), 16, 0, 0);
#pragma unroll
    for (int i = 0; i < 2; ++i)
        __builtin_amdgcn_global_load_lds((const unsigned*)(HV + t0 + q + i * 512), (lds_u32*)(raw + 16384 + wid * 2048 + i * 1024), 16, 0, 0);
}
__device__ __forceinline__ void hgrn_a_phase(const unsigned char* HF, const float* lbv, const bf16* HV, bf16* DS, float* DEC, LAS unsigned char* lds, int tid, int vcu, int G) {
    LAS float* part = (LAS float*)lds; LAS bf16* KT = (LAS bf16*)(lds + 2048); LAS bf16* VT = (LAS bf16*)(lds + 2048 + 18432);
    LAS unsigned char* raw = lds + 40960;
    LAS unsigned char* ot = lds + 73728;
    const int k = tid & 127, sq = tid >> 7, lane = tid & 63, w = __builtin_amdgcn_readfirstlane(tid >> 6);
    int u = vcu; if (u >= 64 * NCHK) return;
    hgrn_a_dma(HF, HV, u / NCHK, u % NCHK, raw, w, lane);
    for (;;) {
        const int bh = u / NCHK, c = u % NCHK, un = u + G; const bool more = un < 64 * NCHK;
        __syncthreads();
        float g[16], kv[16]; unsigned vv[16];
        const float lbk = lbv[(bh & 15) * 128 + k];
#pragma unroll
        for (int i = 0; i < 16; ++i) { const float sg = (float)raw[(16 * sq + i) * 128 + k] * (1.f / 255.f); g[i] = lbk + (1.f - lbk) * sg; kv[i] = (1.f - lbk) * (1.f - sg);
            vv[i] = *(const LAS bf16*)(raw + 16384 + ((16 * sq + i) * 128 + k) * 2); }
        float run = 1.f;
#pragma unroll
        for (int i = 15; i >= 0; --i) { const float f = g[i]; g[i] = run; run *= f; }
        part[sq * 128 + k] = run;
        __syncthreads();
        float suf = 1.f, tot = 1.f;
#pragma unroll
        for (int j = 0; j < 4; ++j) { const float p = part[j * 128 + k]; tot *= p; suf *= (j > sq) ? p : 1.f; }
        unsigned kw[8], vw[8];
#pragma unroll
        for (int i = 0; i < 8; ++i) { kw[i] = pk2(kv[2 * i] * (suf * g[2 * i]), kv[2 * i + 1] * (suf * g[2 * i + 1])); vw[i] = vv[2 * i] | (vv[2 * i + 1] << 16); }
        *(lv4u*)(KT + k * 72 + 16 * sq) = (v4u){kw[0], kw[1], kw[2], kw[3]}; *(lv4u*)(KT + k * 72 + 16 * sq + 8) = (v4u){kw[4], kw[5], kw[6], kw[7]};
        *(lv4u*)(VT + k * 72 + 16 * sq) = (v4u){vw[0], vw[1], vw[2], vw[3]}; *(lv4u*)(VT + k * 72 + 16 * sq + 8) = (v4u){vw[4], vw[5], vw[6], vw[7]};
        if (sq == 0) DEC[((size_t)bh * NCHK + c) * 128 + k] = tot;
        __syncthreads();
        if (more) hgrn_a_dma(HF, HV, un / NCHK, un % NCHK, raw, w, lane);
        const int k0 = 32 * (w & 3), vb = 64 * (w >> 2), li = lane & 31, hi = lane >> 5;
        f32x16 a0 = {}, a1 = {};
#pragma unroll
        for (int ks = 0; ks < 4; ++ks) { const bf16x8 av = *(const lbf8*)(KT + (k0 + li) * 72 + 16 * ks + 8 * hi);
            const bf16x8 b0 = *(const lbf8*)(VT + (vb + li) * 72 + 16 * ks + 8 * hi), b1 = *(const lbf8*)(VT + (vb + 32 + li) * 72 + 16 * ks + 8 * hi);
            a0 = MFMA32(av, b0, a0); a1 = MFMA32(av, b1, a1); }
        LAS unsigned char* ow = ot + w * 5120;
#pragma unroll
        for (int j = 0; j < 4; ++j) { *(LAS v2u*)(ow + li * 80 + (8 * j + 4 * hi) * 2) = (v2u){pk2(a0[4 * j], a0[4 * j + 1]), pk2(a0[4 * j + 2], a0[4 * j + 3])};
            *(LAS v2u*)(ow + (32 + li) * 80 + (8 * j + 4 * hi) * 2) = (v2u){pk2(a1[4 * j], a1[4 * j + 1]), pk2(a1[4 * j + 2], a1[4 * j + 3])}; }
        LDS_WAIT();
        bf16* dst = DS + ((size_t)bh * NCHK + c) * 16384 + (size_t)vb * 128 + k0;
#pragma unroll
        for (int j = 0; j < 4; ++j) { const int v = 16 * j + (lane >> 2), ch = lane & 3; *(v4u*)(dst + (size_t)v * 128 + ch * 8) = *(const LAS v4u*)(ow + v * 80 + ch * 16); }
        if (!more) break;
        u = un;
    }
    __syncthreads();
}
__device__ __forceinline__ void hgrn_b_scan(bf16* DS, const float* DEC, long gid, long NG) {
    for (long idx = gid; idx < 64L * 128 * 16; idx += NG) {
        const int bh = (int)(idx >> 11), rem = (int)(idx & 2047), v = rem >> 4, k8 = (rem & 15) * 8;
        float S[8];
#pragma unroll
        for (int j = 0; j < 8; ++j) S[j] = 0.f;
        bf16* p = DS + ((size_t)bh * NCHK * 128 + v) * 128 + k8; const float* dp = DEC + (size_t)bh * NCHK * 128 + k8;
        for (int c = 0; c < NCHK; c += 4) {
            v4u d[4]; f32x4 e0[4], e1[4];
#pragma unroll
            for (int u = 0; u < 4; ++u) { d[u] = *(const v4u*)(p + (size_t)(c + u) * 16384); e0[u] = *(const f32x4*)(dp + (c + u) * 128); e1[u] = *(const f32x4*)(dp + (c + u) * 128 + 4); }
#pragma unroll
            for (int u = 0; u < 4; ++u) {
                S[0] = e0[u][0] * S[0] + bf_lo(d[u].x); S[1] = e0[u][1] * S[1] + bf_hi(d[u].x); S[2] = e0[u][2] * S[2] + bf_lo(d[u].y); S[3] = e0[u][3] * S[3] + bf_hi(d[u].y);
                S[4] = e1[u][0] * S[4] + bf_lo(d[u].z); S[5] = e1[u][1] * S[5] + bf_hi(d[u].z); S[6] = e1[u][2] * S[6] + bf_lo(d[u].w); S[7] = e1[u][3] * S[7] + bf_hi(d[u].w);
                *(v4u*)(p + (size_t)(c + u) * 16384) = (v4u){pk2(S[0], S[1]), pk2(S[2], S[3]), pk2(S[4], S[5]), pk2(S[6], S[7])}; }
        }
    }
}
struct HcArgs { const bf16 *HQ; const unsigned char* HF; const bf16 *HV, *DS, *OP, *OG; const unsigned char *GA, *GH; bf16* Y; const float *subln, *hgn, *lbv; float lam; };
#define LDS_BARRIER() do { asm volatile("s_waitcnt lgkmcnt(0)" ::: "memory"); __builtin_amdgcn_s_barrier(); asm volatile("" ::: "memory"); } while (0)
__device__ __forceinline__ void hgrn_c_unit(const HcArgs& A, int b, int c, int hp, LAS unsigned char* lds, int tid) {
    LAS bf16* QI = (LAS bf16*)lds;
    LAS bf16* VT = (LAS bf16*)(lds + 17408);
    LAS bf16* AT = (LAS bf16*)(lds + 35840);
    LAS bf16* ST = (LAS bf16*)(lds + 45056);
    LAS bf16* QR = (LAS bf16*)(lds + 79872);
    LAS bf16* KR = (LAS bf16*)(lds + 97280);
    LAS float* OT = (LAS float*)(lds + 79872);
    LAS float* part = (LAS float*)(lds + 140800);
    const int lane = tid & 63, w = __builtin_amdgcn_readfirstlane(tid >> 6);
    const int t8 = tid >> 3, j8 = tid & 7;
    const size_t m = (size_t)b * SEQ + 64 * (c - 1) + t8;
    unsigned rf[16], rq[16], rv[16]; v4u rsp[4]; float rlb;
#define HC_LOAD_A(HH_) do { const int bh_ = b * 16 + (HH_); const size_t r0_ = ((size_t)bh_ * PKV + 64 * c + 16 * (tid >> 7)) * 128 + (tid & 127); rlb = A.lbv[(HH_) * 128 + (tid & 127)]; \
        _Pragma("unroll") for (int i = 0; i < 16; ++i) { rf[i] = A.HF[r0_ + i * 128]; rq[i] = A.HQ[r0_ + i * 128]; rv[i] = A.HV[r0_ + i * 128]; } \
        const bf16* sp0_ = A.DS + ((size_t)bh_ * NCHK + (c - 1)) * 16384; \
        _Pragma("unroll") for (int j = 0; j < 4; ++j) rsp[j] = *(const v4u*)(sp0_ + (size_t)(tid + 512 * j) * 8); } while (0)
    HC_LOAD_A(2 * hp);
    asm volatile("" ::: "memory");
    float an[32];
    { float ss = 0.f;
#pragma unroll
      for (int half = 0; half < 2; ++half) {
          const bf16* p0 = A.OP + ((size_t)(b * 32 + (2 * hp) * 2 + half) * SEQ + 64 * (c - 1) + t8) * 128 + 16 * j8;
          const bf16* p1 = A.OP + ((size_t)(b * 32 + (2 * hp + 1) * 2 + half) * SEQ + 64 * (c - 1) + t8) * 128 + 16 * j8;
          const v4u x0 = *(const v4u*)p0, x1 = *(const v4u*)(p0 + 8), y0 = *(const v4u*)p1, y1 = *(const v4u*)(p1 + 8);
          const unsigned xs[8] = {x0.x, x0.y, x0.z, x0.w, x1.x, x1.y, x1.z, x1.w}, ys[8] = {y0.x, y0.y, y0.z, y0.w, y1.x, y1.y, y1.z, y1.w};
#pragma unroll
          for (int i = 0; i < 8; ++i) { const float a0 = bf_lo(xs[i]) - A.lam * bf_lo(ys[i]), a1 = bf_hi(xs[i]) - A.lam * bf_hi(ys[i]); an[16 * half + 2 * i] = a0; an[16 * half + 2 * i + 1] = a1; ss += a0 * a0 + a1 * a1; } }
      ss += __shfl_xor(ss, 1); ss += __shfl_xor(ss, 2); ss += __shfl_xor(ss, 4);
      const float rs = __builtin_amdgcn_rsqf(ss * (1.f / 256.f) + RMS_EPS) * (1.f - LAMBDA_INIT);
#pragma unroll
      for (int half = 0; half < 2; ++half)
#pragma unroll
          for (int q = 0; q < 4; ++q) { const f32x4 g = *(const f32x4*)(A.subln + 128 * half + 16 * j8 + 4 * q);
#pragma unroll
              for (int i = 0; i < 4; ++i) an[16 * half + 4 * q + i] *= rs * g[i]; } }
#pragma unroll
    for (int hi2 = 0; hi2 < 2; ++hi2) {
        const int hh = 2 * hp + hi2, bh = b * 16 + hh;
        const int k = tid & 127, sq = tid >> 7;
        float g[16], qv[16], kv[16]; unsigned vv[16];
        const float lbk = rlb;
#pragma unroll
        for (int i = 0; i < 16; ++i) { const float sg = (float)rf[i] * (1.f / 255.f), qx = bf2f((bf16)rq[i]);
            g[i] = lbk + (1.f - lbk) * sg; kv[i] = (1.f - lbk) * (1.f - sg); qv[i] = qx * sigmoidf_(qx); vv[i] = rv[i]; }
        v4u sp[4];
#pragma unroll
        for (int j = 0; j < 4; ++j) sp[j] = rsp[j];
        float run = 1.f;
#pragma unroll
        for (int i = 0; i < 16; ++i) { run *= g[i]; g[i] = run; }
        part[sq * 128 + k] = run;
        *(lv4u*)(AT + t8 * 72 + 8 * j8) = (v4u){0u, 0u, 0u, 0u};
        LDS_BARRIER();
        const float p0 = part[k], p1 = part[128 + k], p2 = part[256 + k];
        const float offp = sq == 0 ? 1.f : sq == 1 ? p0 : sq == 2 ? p0 * p1 : p0 * p1 * p2;
        const float m0 = sq == 0 ? p0 : sq == 1 ? p1 : p2, m1 = sq == 0 ? p1 : p2;
        const float rat1 = m0, rat2 = m0 * m1, rat3 = m0 * m1 * p2;
#pragma unroll
        for (int i = 0; i < 16; i += 2) { const int t = 16 * sq + i;
            const float r0 = qv[i] * g[i], r1 = qv[i + 1] * g[i + 1];
            const unsigned wr_ = pk2(r0, r1), wi_ = pk2(r0 * offp, r1 * offp);
            QR[t * 136 + k] = (bf16)wr_; QR[(t + 1) * 136 + k] = (bf16)(wr_ >> 16);
            QI[t * 136 + k] = (bf16)wi_; QI[(t + 1) * 136 + k] = (bf16)(wi_ >> 16); }
#pragma unroll
        for (int i = 0; i < 16; ++i) kv[i] *= __builtin_amdgcn_rcpf(g[i]);
#pragma unroll
        for (int ip = 0; ip < 4; ++ip) if (ip >= sq) {
            const int d = ip - sq; const float rt = d == 0 ? 1.f : d == 1 ? rat1 : d == 2 ? rat2 : rat3; const int rb = ip == 0 ? 0 : ip == 1 ? 16 : ip == 2 ? 48 : 96;
#pragma unroll
            for (int i = 0; i < 16; i += 2) { const unsigned w_ = pk2(kv[i] * rt, kv[i + 1] * rt);
                KR[(rb + 16 * sq + i) * 136 + k] = (bf16)w_; KR[(rb + 16 * sq + i + 1) * 136 + k] = (bf16)(w_ >> 16); } }
        { unsigned vw[8];
#pragma unroll
          for (int i = 0; i < 8; ++i) vw[i] = vv[2 * i] | (vv[2 * i + 1] << 16);
          *(lv4u*)(VT + k * 72 + 16 * sq) = (v4u){vw[0], vw[1], vw[2], vw[3]}; *(lv4u*)(VT + k * 72 + 16 * sq + 8) = (v4u){vw[4], vw[5], vw[6], vw[7]}; }
#pragma unroll
        for (int j = 0; j < 4; ++j) { const int q4 = tid + 512 * j; *(lv4u*)(ST + (q4 >> 4) * 136 + (q4 & 15) * 8) = sp[j]; }
        LDS_BARRIER();
        const size_t idx = m * DM + 256 * hp + 128 * hi2 + 16 * j8;
        const v4u og0 = *(const v4u*)(A.OG + idx), og1 = *(const v4u*)(A.OG + idx + 8), ga0 = *(const v4u*)(A.GA + idx), gh0 = *(const v4u*)(A.GH + idx);
        if (hi2 == 0) HC_LOAD_A(hh + 1);
#pragma unroll
        for (int rep = 0; rep < 2; ++rep) { const int tl = w + 8 * rep;
            if (tl < 10) { const int ip = tl >= 6 ? 3 : tl >= 3 ? 2 : tl >= 1 ? 1 : 0, jp = tl - (ip == 3 ? 6 : ip == 2 ? 3 : ip == 1 ? 1 : 0), rb = ip == 0 ? 0 : ip == 1 ? 16 : ip == 2 ? 48 : 96;
                const int r = lane & 15, q = lane >> 4; f32x4 sa = {0.f, 0.f, 0.f, 0.f};
#pragma unroll
                for (int ks = 0; ks < 4; ++ks) { const bf16x8 av = *(const lbf8*)(QR + (16 * ip + r) * 136 + 32 * ks + 8 * q), bv = *(const lbf8*)(KR + (rb + 16 * jp + r) * 136 + 32 * ks + 8 * q); sa = MFMA16(av, bv, sa); }
#pragma unroll
                for (int i = 0; i < 4; ++i) { const float val = (jp == ip && r > 4 * q + i) ? 0.f : sa[i]; AT[(16 * ip + 4 * q + i) * 72 + 16 * jp + r] = (bf16)f2bf(val); } } }
        LDS_BARRIER();
        { const int t0 = 32 * (w & 1), v0 = 32 * (w >> 1), li = lane & 31, hi = lane >> 5; f32x16 o = {};
#pragma unroll
          for (int ks = 0; ks < 8; ++ks) o = MFMA32(*(const lbf8*)(QI + (t0 + li) * 136 + 16 * ks + 8 * hi), *(const lbf8*)(ST + (v0 + li) * 136 + 16 * ks + 8 * hi), o);
#pragma unroll
          for (int ks = 0; ks < 4; ++ks) o = MFMA32(*(const lbf8*)(AT + (t0 + li) * 72 + 16 * ks + 8 * hi), *(const lbf8*)(VT + (v0 + li) * 72 + 16 * ks + 8 * hi), o);
#pragma unroll
          for (int r = 0; r < 16; ++r) OT[(t0 + crow32(r, hi)) * 132 + v0 + li] = o[r]; }
        LDS_BARRIER();
        { f32x4 ov[4]; float ss = 0.f;
#pragma unroll
          for (int q = 0; q < 4; ++q) { ov[q] = *(const LAS f32x4*)(OT + t8 * 132 + 16 * j8 + 4 * q); ss += (ov[q][0] * ov[q][0] + ov[q][1] * ov[q][1]) + (ov[q][2] * ov[q][2] + ov[q][3] * ov[q][3]); }
          ss += __shfl_xor(ss, 1); ss += __shfl_xor(ss, 2); ss += __shfl_xor(ss, 4);
          const float rs = __builtin_amdgcn_rsqf(ss * (1.f / 128.f) + RMS_EPS);
          const unsigned ogs[8] = {og0.x, og0.y, og0.z, og0.w, og1.x, og1.y, og1.z, og1.w}, gas[4] = {ga0.x, ga0.y, ga0.z, ga0.w}, ghs[4] = {gh0.x, gh0.y, gh0.z, gh0.w};
          unsigned yw[8];
#pragma unroll
          for (int i = 0; i < 8; ++i) { const f32x4 gn = *(const f32x4*)(A.hgn + 16 * j8 + 4 * (i >> 1));
              const float o0 = ov[i >> 1][(2 * i) & 3] * rs * gn[(2 * i) & 3], o1 = ov[i >> 1][(2 * i + 1) & 3] * rs * gn[(2 * i + 1) & 3];
              const float og0_ = bf_lo(ogs[i]), og1_ = bf_hi(ogs[i]);
              const float sa0 = (float)((gas[i >> 1] >> (16 * (i & 1))) & 0xffu) * (1.f / 255.f), sa1 = (float)((gas[i >> 1] >> (16 * (i & 1) + 8)) & 0xffu) * (1.f / 255.f);
              const float sh0 = (float)((ghs[i >> 1] >> (16 * (i & 1))) & 0xffu) * (1.f / 255.f), sh1 = (float)((ghs[i >> 1] >> (16 * (i & 1) + 8)) & 0xffu) * (1.f / 255.f);
              const float y0 = sa0 * an[16 * hi2 + 2 * i] + sh0 * o0 * (og0_ * sigmoidf_(og0_)), y1 = sa1 * an[16 * hi2 + 2 * i + 1] + sh1 * o1 * (og1_ * sigmoidf_(og1_));
              yw[i] = pk2(y0, y1); }
          *(v4u*)(A.Y + idx) = (v4u){yw[0], yw[1], yw[2], yw[3]}; *(v4u*)(A.Y + idx + 8) = (v4u){yw[4], yw[5], yw[6], yw[7]}; }
        LDS_BARRIER();
    }
}

__device__ __forceinline__ void meta_proj(unsigned char* ws, const float* kg, LAS float* xch, int j, int tid) {
    const int lane = tid & 63, w = __builtin_amdgcn_readfirstlane(tid >> 6), r = lane & 15, q = lane >> 4;
    const int gi = j >> 4, head16 = j & 15, grp = gi == 0 ? 1 : gi == 1 ? 2 : gi == 2 ? 4 : 5;
    const bf16* Wr = (const bf16*)(ws + WS_WIN) + (size_t)(grp * DM + head16 * 128 + w * 16 + r) * DM + 8 * q;
    const bf16* Ur = (const bf16*)(ws + WS_U) + (size_t)(MTOK + r) * DM + 8 * q;
    f32x4 acc = {0.f, 0.f, 0.f, 0.f};
#pragma unroll 16
    for (int ks = 0; ks < 64; ++ks) acc = MFMA16(*(const bf16x8*)(Wr + 32 * ks), *(const bf16x8*)(Ur + 32 * ks), acc);
    const int d = w * 16 + 4 * q;
    if (gi == 0) {
        float ss = (acc[0] * acc[0] + acc[1] * acc[1]) + (acc[2] * acc[2] + acc[3] * acc[3]);
        ss += __shfl_xor(ss, 16); ss += __shfl_xor(ss, 32);
        if (q == 0) xch[w * 16 + r] = ss;
        __syncthreads();
        float tot = 0.f;
#pragma unroll
        for (int i = 0; i < 8; ++i) tot += xch[i * 16 + r];
        const float rs = __builtin_amdgcn_rsqf(tot * (1.f / 128.f) + RMS_EPS); const f32x4 g = *(const f32x4*)(kg + d);
        acc = acc * rs * g; }
    if (gi == 2) {
        unsigned qv[4];
#pragma unroll
        for (int i = 0; i < 4; ++i) qv[i] = (unsigned)(sigmoidf_(acc[i]) * 255.f + 0.5f);
        const unsigned wv = qv[0] | (qv[1] << 8) | (qv[2] << 16) | (qv[3] << 24);
#pragma unroll
        for (int bb = 0; bb < NB; ++bb) *(unsigned*)(ws + WS_HGT + ((size_t)(bb * 16 + head16) * PKV + 48 + r) * 128 + d) = wv;
    } else {
        bf16* dst = (bf16*)(ws + (gi == 0 ? WS_KH : gi == 1 ? WS_VH : WS_HV));
        const v2u wv = {pk2(acc[0], acc[1]), pk2(acc[2], acc[3])};
#pragma unroll
        for (int bb = 0; bb < NB; ++bb) *(v2u*)(dst + ((size_t)(bb * 16 + head16) * PKV + 48 + r) * 128 + d) = wv; }
}
struct P6Args { const bf16* h2; const float *norm2, *router_b; const bf16* WR; unsigned char* HG8; float* rstd2; int *assign_e, *assign_rank; float* assign_gate; unsigned* gcnt; };
__device__ __forceinline__ void p6_router(const P6Args& A, LAS unsigned char* lds, LAS unsigned char* ctrl, int vcu, int G, int tid) {
    LAS unsigned* lcount = (LAS unsigned*)(ctrl + 512); LAS unsigned* lbase = (LAS unsigned*)(ctrl + 640);
    const int lane = tid & 63, w = __builtin_amdgcn_readfirstlane(tid >> 6), r = lane & 15, q = lane >> 4;
    if (vcu == 0 && tid < 128) *(v4u*)(A.HG8 + (size_t)MTOK * DM + tid * 16) = (v4u){0u, 0u, 0u, 0u};
    LAS unsigned char* wl = lds; LAS unsigned char* gl = lds + 135168;
    if (vcu < MTOK / 128) {
        for (int i = tid; i < 32 * 256; i += NTHR) { const int row = i >> 8, c16 = i & 255; *(LAS v4u*)(wl + row * 4112 + c16 * 16) = *(const v4u*)(A.WR + (size_t)row * DM + c16 * 8); }
        for (int i = tid; i < 512; i += NTHR) *(LAS v4u*)(gl + i * 16) = *(const v4u*)((const unsigned char*)A.norm2 + i * 16);
    }
    for (int grp = vcu; grp < MTOK / 128; grp += G) {
        if (tid < 32) lcount[tid] = 0u;
        __syncthreads();
        const int m0 = grp * 128 + w * 16; const size_t rowoff = (size_t)(m0 + r) * DM;
        f32x4 acc0 = {0.f, 0.f, 0.f, 0.f}, acc1 = {0.f, 0.f, 0.f, 0.f}; float ss = 0.f;
        v4u hc[8], hn[8];
#pragma unroll
        for (int i = 0; i < 8; ++i) hc[i] = *(const v4u*)(A.h2 + rowoff + 32 * i + 8 * q);
        for (int kb = 0; kb < 8; ++kb) {
            { const int kn = kb < 7 ? kb + 1 : kb;
#pragma unroll
              for (int i = 0; i < 8; ++i) hn[i] = *(const v4u*)(A.h2 + rowoff + 32 * (8 * kn + i) + 8 * q); }
            asm volatile("" ::: "memory");
#pragma unroll
            for (int i = 0; i < 8; ++i) { const int k = 32 * (8 * kb + i) + 8 * q; const v4u hw = hc[i];
                const f32x4 h0 = {bf_lo(hw.x), bf_hi(hw.x), bf_lo(hw.y), bf_hi(hw.y)}, h1 = {bf_lo(hw.z), bf_hi(hw.z), bf_lo(hw.w), bf_hi(hw.w)}, g0 = *(const LAS f32x4*)(gl + k * 4), g1 = *(const LAS f32x4*)(gl + k * 4 + 16);
                const bf16x8 b0 = *(const lbf8*)(wl + r * 4112 + k * 2), b1 = *(const lbf8*)(wl + (16 + r) * 4112 + k * 2);
                ss += (h0[0] * h0[0] + h0[1] * h0[1]) + (h0[2] * h0[2] + h0[3] * h0[3]) + (h1[0] * h1[0] + h1[1] * h1[1]) + (h1[2] * h1[2] + h1[3] * h1[3]);
                const v4u xw = {pk2(h0[0] * g0[0], h0[1] * g0[1]), pk2(h0[2] * g0[2], h0[3] * g0[3]), pk2(h1[0] * g1[0], h1[1] * g1[1]), pk2(h1[2] * g1[2], h1[3] * g1[3])};
                *(v2u*)(A.HG8 + rowoff + k) = (v2u){pk4_fp8(h0[0] * g0[0], h0[1] * g0[1], h0[2] * g0[2], h0[3] * g0[3]), pk4_fp8(h1[0] * g1[0], h1[1] * g1[1], h1[2] * g1[2], h1[3] * g1[3])};
                const bf16x8 xa = __builtin_bit_cast(bf16x8, xw);
                acc0 = MFMA16(b0, xa, acc0); acc1 = MFMA16(b1, xa, acc1);
                if (i & 1) asm volatile("" ::: "memory"); }
#pragma unroll
            for (int i = 0; i < 8; ++i) hc[i] = hn[i];
        }
        ss += __shfl_xor(ss, 16); ss += __shfl_xor(ss, 32);
        const float rs = __builtin_amdgcn_rsqf(ss * (1.f / DM) + RMS_EPS);
        if (q == 0) A.rstd2[m0 + r] = rs;
        float l[8];
        { const f32x4 rb0 = *(const f32x4*)(A.router_b + 4 * q), rb1 = *(const f32x4*)(A.router_b + 16 + 4 * q);
#pragma unroll
          for (int i = 0; i < 4; ++i) { l[i] = acc0[i] * rs + rb0[i]; l[4 + i] = acc1[i] * rs + rb1[i]; } }
        unsigned used = 0u; float tv[4]; int te[4];
#pragma unroll
        for (int kk = 0; kk < 4; ++kk) {
            float bv = -__builtin_inff(); int be = 64;
#pragma unroll
            for (int j = 0; j < 8; ++j) { const int ej = (j < 4 ? 0 : 16) + 4 * q + (j & 3); const bool ok = !((used >> j) & 1u) && l[j] > bv; bv = ok ? l[j] : bv; be = ok ? ej : be; }
#pragma unroll
            for (int o = 16; o <= 32; o <<= 1) { const float ov = __shfl_xor(bv, o); const int oe = __shfl_xor(be, o); const bool tk = ov > bv || (ov == bv && oe < be); bv = tk ? ov : bv; be = tk ? oe : be; }
            tv[kk] = bv; te[kk] = be;
            if (((be & 15) >> 2) == q) used |= 1u << (((be >> 4) << 2) + (be & 3));
        }
        const float e1 = __expf(tv[1] - tv[0]), e2 = __expf(tv[2] - tv[0]), e3 = __expf(tv[3] - tv[0]), inv = 1.f / (1.f + e1 + e2 + e3);
        const int es = q == 0 ? te[0] : q == 1 ? te[1] : q == 2 ? te[2] : te[3];
        const float gs = (q == 0 ? 1.f : q == 1 ? e1 : q == 2 ? e2 : e3) * inv;
        const unsigned lrank = __hip_atomic_fetch_add((unsigned*)(lcount + es), 1u, __ATOMIC_RELAXED, __HIP_MEMORY_SCOPE_WORKGROUP);
        __syncthreads();
        if (tid < 32) lbase[tid] = __hip_atomic_fetch_add(A.gcnt + tid, (unsigned)lcount[tid], __ATOMIC_RELAXED, __HIP_MEMORY_SCOPE_AGENT);
        __syncthreads();
        const int a = (m0 + r) * 4 + q;
        A.assign_e[a] = es; A.assign_rank[a] = (int)(lbase[es] + lrank); A.assign_gate[a] = gs;
        __syncthreads();
    }
}
__device__ __forceinline__ void moe_tstart(const unsigned* gcnt, LAS int* tstart, int tid) {
    if (tid == 0) { int s = 0;
        for (int e = 0; e < NE; ++e) { tstart[e] = s; s += (int)((__hip_atomic_load(gcnt + e, __ATOMIC_RELAXED, __HIP_MEMORY_SCOPE_AGENT) + 255u) >> 8); }
        tstart[NE] = s; }
    __syncthreads();
}

namespace att {
struct Tensors { const bf16* Q; const bf16* K; const bf16* V; bf16* O; const float* bt; };
__device__ __forceinline__ BlockRef<bf16, bf16> mkref(const Tensors& T, int id, int pass) {
    const int grp = id >> 6, w = id & 63, b = grp >> 3, h = grp & 7, sub = w >> 4, map = sub >> 1, half = sub & 1, y = w & 15, qb = pass ? 31 - y : y;
    BlockRef<bf16, bf16> r;
    r.Q = T.Q + ((size_t)(b * 16 + 2 * h + map) * SEQ_ + (size_t)qb * QB) * D;
    r.K = T.K + (size_t)(b * 16 + 2 * h + map) * PKV_ * D;
    r.V = T.V + (size_t)(b * 16 + 2 * h + half) * PKV_ * D;
    r.O = T.O + ((size_t)(b * 32 + (2 * h + map) * 2 + half) * SEQ_ + (size_t)qb * QB) * D;
    r.P0 = 64 + qb * QB; r.bt = T.bt + h * BT_LEN;
    return r;
}
__device__ __forceinline__ int item_id(int i, int c, int G) {
    if (G == 256) return i < 8 ? (c & 7) * 256 + i * 32 + (c >> 3) : -1;
    const long L = (long)i * G + c; return L < 2048 ? (int)L : -1;
}
template <bool FIXM>
__device__ __forceinline__ void attn_phase(char* lds, const Tensors& T, int G, int c) {
    constexpr int W = 1 << 30;
    int i = 0, id = item_id(0, c, G); if (id < 0) return;
    int pass = 0;
    BlockRef<bf16, bf16> cur = mkref(T, id, 0);
    Seam<bf16> S;
    causal_swa_prime<bf16, bf16>(cur, W, lds, S);
    for (;;) {
        const int idn = item_id(i + 1, c, G);
        const bool more_pass = pass == 0, more_item = idn >= 0, last = !more_pass && !more_item;
        const BlockRef<bf16, bf16> nxt = last ? cur : (more_pass ? mkref(T, id, 1) : mkref(T, idn, 0));
        causal_swa_block<bf16, bf16, FIXM>(cur, nxt, PKV_, W, lds, S);
        if (last) break;
        cur = nxt; if (more_pass) pass = 1; else { pass = 0; id = idn; ++i; }
    }
}
__device__ __forceinline__ BlockRef2 mkref2(const Tensors& T, int id, int pass) {
    const int mi = id >> 5, y = id & 31, qb = pass ? 63 - y : y, b = mi >> 4, hm = mi & 15, h = hm >> 1;
    BlockRef2 r;
    r.Q = T.Q + ((size_t)mi * SEQ_ + (size_t)qb * P2_QB) * D;
    r.K = T.K + (size_t)mi * PKV_ * D;
    r.V = T.V + (size_t)(b * 16 + 2 * h) * PKV_ * D;
    r.O = T.O + ((size_t)(b * 32 + hm * 2) * SEQ_ + (size_t)qb * P2_QB) * D;
    r.P0 = 64 + qb * P2_QB; r.bt = T.bt + h * BT_LEN;
    return r;
}
__device__ __forceinline__ void attn_phase2(char* lds, const Tensors& T, int G, int c) {
    for (int j = 0;; ++j) { const int id = item_id(j >> 1, c, G); if (id < 0) break;
        paired_block(mkref2(T, id, j & 1), lds); }
}
}

struct Args { const float* in[19]; float* out; unsigned char* ws; int ph_lo, ph_hi, li, pad; };
#define ARG(k) argp(args, k)
__device__ __forceinline__ unsigned char* wsp(const Args& a) { int k = 0; asm volatile("" : "+s"(k)); return (&a.ws)[k]; }
__device__ __forceinline__ float* outp(const Args& a) { int k = 0; asm volatile("" : "+s"(k)); return (&a.out)[k]; }
__device__ __forceinline__ const float* argp(const Args& a, int k) { asm volatile("" : "+s"(k)); return a.in[k]; }
__global__ void __launch_bounds__(NTHR, 2) hyb_fwd(Args args) {
    extern __shared__ __attribute__((aligned(16))) unsigned char lds_raw[];
    LAS unsigned char* lds = (LAS unsigned char*)lds_raw;
    const int G = gridDim.x, bx = blockIdx.x;
    { unsigned char* ws0 = args.ws;
      int t0_ = threadIdx.x; asm volatile("" : "+v"(t0_));
      for (int u = t0_; u < (LDS_BYTES - CTRL_OFF) / 4; u += NTHR) ((LAS unsigned*)(lds + CTRL_OFF))[u] = 0u;
      __syncthreads(); (void)ws0; }
    XcdBarrier bar; bar.bar = (unsigned*)(args.ws + WS_CTL) + CW_BAR; bar.x = 0; bar.st = nullptr;
    if (N_LAUNCHES == 1) bar = xcd_barrier_post((unsigned*)(args.ws + WS_CTL) + CW_BAR, (volatile LAS unsigned*)(lds + CTRL_OFF));
#define GRID_BAR() do { if (N_LAUNCHES == 1) xcd_barrier(bar); } while (0)
    const int lo = args.ph_lo, hi = args.ph_hi;
#ifndef PH_MASK
#define PH_MASK 0x7ff
#endif
#define IN(k) (((PH_MASK >> (k)) & 1) && lo <= (k) && (k) < hi)
#define BOTH(k) (IN(k) && IN((k) + 1))
#ifndef PROBE_DUP
#define PROBE_DUP 0
#endif
#ifndef STAGGER_TICKS
#define STAGGER_TICKS 0
#endif
#define REP(k) for (int rep_ = 0; rep_ < 1 + ((PROBE_DUP >> (k)) & 1); ++rep_)
#define PHASE_LOCALS() int tid_ = threadIdx.x; asm volatile("" : "+v"(tid_)); const int tid = tid_, lane = tid & 63, wave = __builtin_amdgcn_readfirstlane(tid >> 6); (void)lane; (void)wave; \
    const int vcu = (G % 8 == 0) ? (bx % 8) * (G / 8) + bx / 8 : bx; (void)vcu; unsigned char* ws = wsp(args); (void)ws; \
    const int gw = vcu * NWAVES + wave, NGW = G * NWAVES; const long gid = (long)vcu * NTHR + tid, NG = (long)G * NTHR; (void)gw; (void)NGW; (void)gid; (void)NG
#define QH ((bf16*)(ws + WS_QH))
#define KH ((bf16*)(ws + WS_KH))
#define VH ((bf16*)(ws + WS_VH))
#define HQ ((bf16*)(ws + WS_HQ))
#define HK ((bf16*)(ws + WS_HK))
#define HGT ((const unsigned char*)(ws + WS_HGT))
#define HV ((bf16*)(ws + WS_HV))
#define OG ((bf16*)(ws + WS_OG))
#define GA ((const unsigned char*)(ws + WS_GA))
#define GH ((const unsigned char*)(ws + WS_GH))
#define OP ((bf16*)(ws + WS_OP))
#define DS ((bf16*)(ws + WS_DS))
#define DEC ((float*)(ws + WS_DEC))
#define GCNT ((unsigned*)(ws + WS_CTL) + CW_CNT)
#define TSTART ((LAS int*)(lds + CTRL_OFF + 256))
#define OUTP outp(args)

    if (IN(0)) { PHASE_LOCALS();
        P0Args a{ARG(0), ARG(1), ARG(2), ARG(3), ARG(4), ARG(5), ARG(8), ARG(11), ARG(13), ARG(15), ARG(17), ARG(6), ARG(7), ws};
        REP(0) p0_prologue(a, lds, vcu, G, tid);
        if (BOTH(0)) GRID_BAR();
    }
    if (IN(1)) { PHASE_LOCALS();
        if (bx < 64) meta_proj(ws, ARG(7), (LAS float*)(lds + XCH_OFF), bx, tid);
        SchedInProj S{G, bx, (const bf16*)(ws + WS_WIN)};
        EpiInProj E{ws, ARG(6), ARG(7), (LAS float*)(lds + XCH_OFF)};
        REP(1) pg8::gemm_phase<EpiInProj, SchedInProj, false>(lds, (const bf16*)(ws + WS_U), DM, S, E, (unsigned)(bx * STAGGER_TICKS) / (unsigned)G);
#if (PROBE_DUP >> 12) & 1
        { EpiNull EN; pg8::gemm_phase<EpiNull, SchedInProj, false>(lds, (const bf16*)(ws + WS_U), DM, S, EN); }
#endif
        if (BOTH(1)) GRID_BAR();
    }
    if (IN(2)) { PHASE_LOCALS();
        REP(11) hgrn_a_phase(HGT, (const float*)(ws + SM_LB), HV, DS, DEC, lds, tid, vcu, G);
        const att::Tensors T{QH, KH, VH, OP, (const float*)(ws + SM_BT)};
        { int fx = __builtin_amdgcn_readfirstlane(*(const int*)(ws + SM_LAM + 4)), g2 = G, c2 = bx; asm volatile("" : "+s"(fx), "+s"(g2), "+s"(c2));
          REP(2) if (fx) att::attn_phase2((char*)lds_raw, T, g2, c2);
          asm volatile("" : "+s"(fx), "+s"(g2), "+s"(c2));
          if (!fx) { const att::Tensors T2{QH, KH, VH, OP, (const float*)(ws + SM_BT)}; att::attn_phase<false>((char*)lds_raw, T2, g2, c2); } }
        if (BOTH(2)) GRID_BAR();
    }
    if (IN(3)) { PHASE_LOCALS(); hgrn_b_scan(DS, DEC, gid, NG); if (BOTH(3)) GRID_BAR(); }
    if (IN(4)) { PHASE_LOCALS();
        const HcArgs A{HQ, HGT, HV, DS, OP, OG, GA, GH, (bf16*)(ws + WS_Y), ARG(9), ARG(10), (const float*)(ws + SM_LB), *(const float*)(ws + SM_LAM)};
        REP(4) for (int u = vcu; u < NB * NCHK * 8; u += G) { const int hp = u & 7, c = ((u >> 3) % NCHK) + 1, b = (u >> 3) / NCHK; hgrn_c_unit(A, b, c, hp, lds, tid); }
        if (BOTH(4)) GRID_BAR();
    }
    if (IN(5)) { PHASE_LOCALS();
        SchedPlain S{G, bx, MTOK / 256, DM / 256, (const bf16*)(ws + WS_WOUT)};
        EpiOutProj E{ARG(0), (bf16*)(ws + WS_H2)};
        REP(5) pg8::gemm_phase<EpiOutProj, SchedPlain, false>(lds, (const bf16*)(ws + WS_Y), DM, S, E);
        if (BOTH(5)) GRID_BAR();
    }
    if (IN(6)) { PHASE_LOCALS();
        const P6Args A{(const bf16*)(ws + WS_H2), ARG(12), ARG(14), (const bf16*)(ws + WS_WR), ws + WS_HG8, (float*)(ws + SM_RSTD), (int*)(ws + SM_AE), (int*)(ws + SM_AR), (float*)(ws + SM_AG), GCNT};
        p6_router(A, lds, lds + CTRL_OFF, vcu, G, tid);
        if (BOTH(6)) GRID_BAR();
    }
    if (IN(7)) { PHASE_LOCALS();
        moe_tstart(GCNT, TSTART, tid);
        const int* ae = (const int*)(ws + SM_AE); const int* ar = (const int*)(ws + SM_AR); const float* ag = (const float*)(ws + SM_AG); const float* rstd2 = (const float*)(ws + SM_RSTD);
        int* slot_tok = (int*)(ws + SM_ST); float* slot_rstd = (float*)(ws + SM_SR); float* slot_gate = (float*)(ws + SM_SG); int* tok_slot = (int*)(ws + SM_TS);
        for (long a = gid; a < NASSIGN; a += NG) { const int e = ae[a], slot = TSTART[e] * 256 + ar[a], t = (int)(a >> 2);
            slot_tok[slot] = t; slot_rstd[slot] = rstd2[t]; slot_gate[slot] = ag[a]; tok_slot[a] = slot; }
        if (BOTH(7)) GRID_BAR();
    }
    if (IN(8)) { PHASE_LOCALS();
        moe_tstart(GCNT, TSTART, tid);
        SchedMoE S{G, bx, DFF / 128, TSTART, ws + WS_WGU, (size_t)2 * DFF * DM, (size_t)256 * DM, (const int*)(ws + SM_ST)};
        EpiGateUp E{ARG(16), (const float*)(ws + SM_SR), ws + WS_ACT, lds + XCH_OFF};
        REP(8) pg8::gemm_phase<EpiGateUp, SchedMoE, true, true>(lds, (const bf16*)(ws + WS_HG8), DM / 2, S, E, (unsigned)(bx * STAGGER_TICKS) / (unsigned)G);
#if (PROBE_DUP >> 15) & 1
        { EpiNull EN; pg8::gemm_phase<EpiNull, SchedMoE, true, true>(lds, (const bf16*)(ws + WS_HG8), DM / 2, S, EN); }
#endif
        if (BOTH(8)) GRID_BAR();
    }
    if (IN(9)) { PHASE_LOCALS();
        moe_tstart(GCNT, TSTART, tid);
        SchedMoE S{G, bx, DM / 256, TSTART, ws + WS_WDN, (size_t)DM * DFF, (size_t)256 * DFF, nullptr};
        EpiDown E{ARG(18), (const float*)(ws + SM_SG), ws + WS_YS, lds + XCH_OFF};
        REP(9) pg8::gemm_phase<EpiDown, SchedMoE, false, true>(lds, (const bf16*)(ws + WS_ACT), DFF / 2, S, E, (unsigned)(bx * STAGGER_TICKS) / (unsigned)G);
#if (PROBE_DUP >> 13) & 1
        { EpiNull EN; pg8::gemm_phase<EpiNull, SchedMoE, false, true>(lds, (const bf16*)(ws + WS_ACT), DFF / 2, S, EN); }
#endif
#if (PROBE_DUP >> 14) & 1
        { EpiStoreOnly<2, 4> ES{(bf16*)(ws + 2171 * MiB)}; pg8::gemm_phase<EpiStoreOnly<2, 4>, SchedMoE, false, true>(lds, (const bf16*)(ws + WS_ACT), DFF / 2, S, ES); }
#endif
#if (PROBE_DUP >> 16) & 1
        { EpiStoreOnly<1, 1> ES{(bf16*)(ws + 2171 * MiB)}; pg8::gemm_phase<EpiStoreOnly<1, 1>, SchedMoE, false, true>(lds, (const bf16*)(ws + WS_ACT), DFF / 2, S, ES); }
#endif
#if (PROBE_DUP >> 17) & 1
        { EpiStoreOnly<1, 4> ES{(bf16*)(ws + 2171 * MiB)}; pg8::gemm_phase<EpiStoreOnly<1, 4>, SchedMoE, false, true>(lds, (const bf16*)(ws + WS_ACT), DFF / 2, S, ES); }
#endif
        if (BOTH(9)) GRID_BAR();
    }
    if (IN(10)) { PHASE_LOCALS();
        const int* tok_slot = (const int*)(ws + SM_TS); const unsigned char* YS = ws + WS_YS;
        float* out = OUTP; const bf16* H2 = (const bf16*)(ws + WS_H2);
        for (int m = gw; m < MTOK; m += NGW) {
            const int s0 = tok_slot[4 * m], s1 = tok_slot[4 * m + 1], s2 = tok_slot[4 * m + 2], s3 = tok_slot[4 * m + 3];
#pragma unroll
            for (int j = 0; j < 4; ++j) { const int col = lane * 8 + 512 * j; float* op = out + (size_t)m * DM + col;
                const v4u hw = *(const v4u*)(H2 + (size_t)m * DM + col); const f32x4 o0 = {bf_lo(hw.x), bf_hi(hw.x), bf_lo(hw.y), bf_hi(hw.y)}, o1 = {bf_lo(hw.z), bf_hi(hw.z), bf_lo(hw.w), bf_hi(hw.w)};
                const v2u y0 = *(const v2u*)(YS + (size_t)s0 * DM + col), y1 = *(const v2u*)(YS + (size_t)s1 * DM + col), y2 = *(const v2u*)(YS + (size_t)s2 * DM + col), y3 = *(const v2u*)(YS + (size_t)s3 * DM + col);
                f32x4 a0 = {0.f, 0.f, 0.f, 0.f}, a1 = {0.f, 0.f, 0.f, 0.f};
#define ADDY(Q_) do { const f32x2_t l0_ = __builtin_amdgcn_cvt_pk_f32_fp8((int)Q_.x, false), h0_ = __builtin_amdgcn_cvt_pk_f32_fp8((int)Q_.x, true), l1_ = __builtin_amdgcn_cvt_pk_f32_fp8((int)Q_.y, false), h1_ = __builtin_amdgcn_cvt_pk_f32_fp8((int)Q_.y, true); \
                    a0[0] += l0_[0]; a0[1] += l0_[1]; a0[2] += h0_[0]; a0[3] += h0_[1]; a1[0] += l1_[0]; a1[1] += l1_[1]; a1[2] += h1_[0]; a1[3] += h1_[1]; } while (0)
                ADDY(y0); ADDY(y1); ADDY(y2); ADDY(y3);
#undef ADDY
                *(f32x4*)op = o0 + a0 * (1.f / YS8_SCALE); *(f32x4*)(op + 4) = o1 + a1 * (1.f / YS8_SCALE); }
        }
    }
#undef IN
#undef BOTH
#undef GRID_BAR
}


#ifdef DBG_DUMP
__global__ void dbg_dump(const unsigned char* ws, float* out, unsigned mask) {
    const size_t offs[16] = {WS_U, WS_WIN, WS_QH, WS_KH, WS_VH, WS_HQ, WS_HK, WS_HGT, WS_HV, WS_OG, WS_GA, WS_GH, WS_OP, WS_DS, WS_Y, WS_WOUT};
    for (size_t i = (size_t)blockIdx.x * blockDim.x + threadIdx.x; i < (size_t)MTOK * DM; i += (size_t)gridDim.x * blockDim.x) {
        float s = 0.f;
        for (int b = 0; b < 16; ++b) if ((mask >> b) & 1u) { size_t j = i; if (b == 15) j = i & (size_t)(DM * DM - 1); if (b == 12 || b == 13) j = i * 2 + ((mask >> 16) & 1u); s += bf2f(((const bf16*)(ws + offs[b]))[j]); }
        out[i] = s;
    }
}
#endif
#ifndef DBG_NLAUNCH
#define DBG_NLAUNCH NPHASE
#endif
extern "C" void kernel_launch(void* const* d_in, const int* in_sizes, int n_in, void* d_out, int out_size, void* d_ws, size_t ws_size, hipStream_t stream) {
    static int grid = 0;
    if (grid == 0) {
        if (n_in != 19 || in_sizes[0] != MTOK * DM || out_size != MTOK * DM || ws_size < WS_END) { fprintf(stderr, "kernel_launch: unexpected shapes (n_in %d, in0 %d, out %d, ws %zu < %zu); nothing launched\n", n_in, n_in > 0 ? in_sizes[0] : -1, out_size, ws_size, (size_t)WS_END); grid = -1; return; }
        int dev = 0, cus = 0, per_cu = 0;
        if (hipGetDevice(&dev) != hipSuccess || hipDeviceGetAttribute(&cus, hipDeviceAttributeMultiprocessorCount, dev) != hipSuccess) { fprintf(stderr, "kernel_launch: device query failed\n"); grid = -1; return; }
        if (hipFuncSetAttribute((const void*)hyb_fwd, hipFuncAttributeMaxDynamicSharedMemorySize, LDS_BYTES) != hipSuccess) { fprintf(stderr, "kernel_launch: hipFuncSetAttribute(%d) failed\n", LDS_BYTES); grid = -1; return; }
        if (hipOccupancyMaxActiveBlocksPerMultiprocessor(&per_cu, (const void*)hyb_fwd, NTHR, LDS_BYTES) != hipSuccess || per_cu < 1) { fprintf(stderr, "kernel_launch: occupancy query says %d workgroups per CU\n", per_cu); (void)hipGetLastError(); if (per_cu < 1) { grid = -1; return; } }
        grid = cus;
    }
    if (grid < 0) return;
    if (hipMemsetAsync((char*)d_ws + WS_CTL, 0, CTL_ZERO_BYTES, stream) != hipSuccess) { fprintf(stderr, "kernel_launch: memset failed\n"); return; }
    Args a{};
    for (int i = 0; i < 19; ++i) a.in[i] = (const float*)d_in[i];
    a.out = (float*)d_out; a.ws = (unsigned char*)d_ws;
    for (int li = 0; li < (N_LAUNCHES == 1 ? 1 : DBG_NLAUNCH); ++li) {
        a.ph_lo = (N_LAUNCHES == 1) ? 0 : li; a.ph_hi = (N_LAUNCHES == 1) ? NPHASE : li + 1; a.li = li; a.pad = 0;
        hipLaunchKernelGGL(hyb_fwd, dim3(grid), dim3(NTHR), LDS_BYTES, stream, a);
        const hipError_t le = hipPeekAtLastError();
        if (le != hipSuccess) { fprintf(stderr, "kernel_launch: launch %d failed: %s\n", li, hipGetErrorName(le)); break; }
    }
#ifdef DBG_DUMP
    hipLaunchKernelGGL(dbg_dump, dim3(2048), dim3(256), 0, stream, (const unsigned char*)d_ws, (float*)d_out, (unsigned)DBG_DUMP);
#endif
}
```

```cpp
#include <hip/hip_runtime.h>
#include <cstdio>
#include <cstdint>

namespace pg8 {
#define PG8_LAS __attribute__((address_space(3)))
typedef unsigned short bf16_t;
typedef short bf16x8 __attribute__((ext_vector_type(8)));
typedef float f32x4 __attribute__((ext_vector_type(4)));
typedef unsigned u32x4 __attribute__((ext_vector_type(4)));
constexpr int BM = 256, BK = 64, HALF = 128, HTB = HALF * BK * 2  , STAGE_BYTES = 8 * HTB;

__host__ __device__ __forceinline__ int lds_byte(int r, int c) { const int st = (r >> 4) * 2 + (c >> 5), rr = r & 15, cc = c & 31, ob = rr * 64 + cc * 2; return st * 1024 + (ob ^ (((ob >> 9) & 1) << 5)); }
__host__ __device__ __forceinline__ void stage_rc(int b, int& R, int& C) { const int st = b / 1024, sb = b % 1024, swz = sb ^ (((sb >> 9) & 1) << 5); R = (st >> 1) * 16 + swz / 64; C = (st & 1) * 32 + (swz % 64) / 2; }
__host__ __device__ __forceinline__ int perm32(int rho) { const int n = rho >> 4, i = rho & 15; return 8 * (i >> 2) + 4 * n + (i & 3); }

struct Unit { int pm, pn, e, aux, par; };

__device__ __forceinline__ unsigned cvt_pk_bf16(float lo, float hi) { unsigned r; asm volatile("v_cvt_pk_bf16_f32 %0, %1, %2" : "=v"(r) : "v"(lo), "v"(hi)); return r; }

typedef int i32x4 __attribute__((ext_vector_type(4)));
typedef int i32x8 __attribute__((ext_vector_type(8)));
template <class Epi, class Sched, bool GATHER, bool FP8 = false>
__device__ __forceinline__ void gemm_phase(PG8_LAS unsigned char* lds, const bf16_t* Abase, const int K, const Sched& S, const Epi& E, const unsigned stagger_ticks = 0u) {
    if (stagger_ticks) { const unsigned long long t0_ = __builtin_amdgcn_s_memrealtime(); while (__builtin_amdgcn_s_memrealtime() - t0_ < stagger_ticks) __builtin_amdgcn_s_sleep(8); }
    const int tid = threadIdx.x, wid = __builtin_amdgcn_readfirstlane(tid >> 6), lane = tid & 63, wr = wid >> 2, wc = wid & 3, fr = lane & 15, fq = lane >> 4;
    const int nt = K / BK;
    int Rr[2]; unsigned cb[2], voffB[2], voffA[2];
#pragma unroll
    for (int i = 0; i < 2; ++i) { int R, C; stage_rc(tid * 16 + i * 8192, R, C); const int Rb = Epi::PERM ? ((R & ~31) + perm32(R & 31)) : R;
        Rr[i] = R; cb[i] = (unsigned)C * 2u; voffB[i] = (unsigned)(Rb * K + C) * 2u; voffA[i] = (unsigned)(R * K + C) * 2u; }
    const unsigned rowB = (unsigned)K * 2u;
    const unsigned kstep = (unsigned)(BK * 2);
    const unsigned hstep = (unsigned)HALF * (unsigned)K * 2u;
    const __amdgpu_buffer_rsrc_t rsA = __builtin_amdgcn_make_buffer_rsrc((void*)Abase, (short)0, -1, 0x00020000), rsB = __builtin_amdgcn_make_buffer_rsrc((void*)S.bbase(), (short)0, -1, 0x00020000);
    const unsigned ldsw = (unsigned)wid * 1024u;
    const int aoff = lds_byte(wr * 64 + fr, fq * 8), boff = lds_byte(wc * 32 + fr, fq * 8);
#define PG8_SA(b, h) (((b) * 2 + (h)) * HTB)
#define PG8_SB(b, h) ((4 + (b) * 2 + (h)) * HTB)
#define PG8_STAGE(bufoff, rs, soff, voff) do { _Pragma("unroll") for (int _i = 0; _i < 2; ++_i) \
        __builtin_amdgcn_raw_ptr_buffer_load_lds((rs), (PG8_LAS unsigned*)(lds + (bufoff) + ldsw + _i * 8192), 16, (int)(voff)[_i], (int)(soff), 0, 0); } while (0)
#define PG8_LD8(off) __builtin_shufflevector(*(const PG8_LAS i32x4*)(lds + (off)), *(const PG8_LAS i32x4*)(lds + (off) + 1024), 0, 1, 2, 3, 4, 5, 6, 7)
#define PG8_LDA(dst, b, h) do { _Pragma("unroll") for (int m = 0; m < 4; ++m) { if constexpr (FP8) dst##8[m] = PG8_LD8(PG8_SA(b, h) + aoff + m * 2048); else { _Pragma("unroll") for (int k = 0; k < 2; ++k) dst[m][k] = *(const PG8_LAS bf16x8*)(lds + PG8_SA(b, h) + aoff + m * 2048 + k * 1024); } } } while (0)
#define PG8_LDB(dst, b, h) do { _Pragma("unroll") for (int n = 0; n < 2; ++n) { if constexpr (FP8) dst##8[n] = PG8_LD8(PG8_SB(b, h) + boff + n * 2048); else { _Pragma("unroll") for (int k = 0; k < 2; ++k) dst[n][k] = *(const PG8_LAS bf16x8*)(lds + PG8_SB(b, h) + boff + n * 2048 + k * 1024); } } } while (0)
#define PG8_MMA(ai, bj, At, Bt) do { __builtin_amdgcn_s_setprio(1); _Pragma("unroll") for (int m = 0; m < 4; ++m) _Pragma("unroll") for (int n = 0; n < 2; ++n) { \
        if constexpr (FP8) asm volatile("v_mfma_scale_f32_16x16x128_f8f6f4 %0, %1, %2, %0, %3, %3 op_sel_hi:[0,0,0]" : "+v"(acc[ai][bj][m][n]) : "v"(Bt##8[n]), "v"(At##8[m]), "v"(sc8)); \
        else { _Pragma("unroll") for (int k = 0; k < 2; ++k) acc[ai][bj][m][n] = __builtin_amdgcn_mfma_f32_16x16x32_bf16(Bt[n][k], At[m][k], acc[ai][bj][m][n], 0, 0, 0); } } __builtin_amdgcn_s_setprio(0); } while (0)
#define PG8_WAIT_V(n) asm volatile("s_waitcnt vmcnt(" #n ")" ::: "memory")
#define PG8_WAIT_L(n) asm volatile("s_waitcnt lgkmcnt(" #n ")" ::: "memory")
#define PG8_BAR __builtin_amdgcn_s_barrier()
#define PG8_SCHED __builtin_amdgcn_sched_barrier(0)
#define PG8_VA(dst, u) do { if constexpr (GATHER) { _Pragma("unroll") for (int _h = 0; _h < 2; ++_h) _Pragma("unroll") for (int _i = 0; _i < 2; ++_i) dst[_h][_i] = S.arow(u, _h * HALF + Rr[_i]) * rowB + cb[_i]; } } while (0)
#define PG8_STAGE_A(bufoff, h, base, vsel) do { if constexpr (GATHER) PG8_STAGE(bufoff, rsA, base, vsel[h]); else PG8_STAGE(bufoff, rsA, (base) + (h) * hstep, voffA); } while (0)
#define PG8_STAGE_B(bufoff, base) PG8_STAGE(bufoff, rsB, base, voffB)
    Unit cur, nxt; int ui = 0;
    if (!S.next(0, cur)) return;
    cur.par = 0; E.prefetch(cur, wid, lane);
    f32x4 acc[2][2][4][2];
#pragma unroll
    for (int a = 0; a < 2; ++a)
#pragma unroll
        for (int b = 0; b < 2; ++b)
#pragma unroll
            for (int m = 0; m < 4; ++m)
#pragma unroll
                for (int n = 0; n < 2; ++n) acc[a][b][m][n] = (f32x4){0.f, 0.f, 0.f, 0.f};
    int sc8 = 0x7f7f7f7f; asm volatile("" : "+v"(sc8));
    bf16x8 At[4][2], B0[2][2], B1[2][2]; i32x8 At8[4], B08[2], B18[2];
    unsigned vAc[2][2], vAn[2][2];
    PG8_VA(vAc, cur);
    unsigned cA = GATHER ? 0u : S.arow(cur, 0) * rowB, cB = S.boff(cur);
    PG8_STAGE_B(PG8_SB(0, 0), cB); PG8_STAGE_B(PG8_SB(0, 1), cB + hstep); PG8_STAGE_A(PG8_SA(0, 0), 0, cA, vAc); PG8_STAGE_A(PG8_SA(0, 1), 1, cA, vAc);
    if (wr == 1) PG8_BAR;
    PG8_WAIT_V(2); PG8_BAR;
    PG8_STAGE_B(PG8_SB(1, 0), cB + kstep); PG8_STAGE_A(PG8_SA(1, 0), 0, cA + kstep, vAc); PG8_STAGE_B(PG8_SB(1, 1), cB + hstep + kstep);
    PG8_WAIT_V(6); PG8_BAR;
    for (;;) {
        const bool has_next = S.next(ui + 1, nxt); nxt.par = (ui + 1) & 1;
        unsigned nB = cB, nA = cA;
        if (has_next) { nB = S.boff(nxt); PG8_VA(vAn, nxt); if constexpr (!GATHER) nA = S.arow(nxt, 0) * rowB; }
        else if constexpr (GATHER) {
#pragma unroll
            for (int h = 0; h < 2; ++h)
#pragma unroll
                for (int i = 0; i < 2; ++i) vAn[h][i] = vAc[h][i];
        }
        for (int t = 0; t < nt; t += 2) {
            const bool last = (t == nt - 2);
            const unsigned a1 = cA + (unsigned)(t + 1) * kstep;
            const unsigned a2 = last ? nA : cA + (unsigned)(t + 2) * kstep, b2 = last ? nB : cB + (unsigned)(t + 2) * kstep;
            const unsigned a3 = a2 + kstep, b3 = b2 + kstep;
            unsigned v2[2][2];
            if constexpr (GATHER) {
#pragma unroll
            for (int h = 0; h < 2; ++h)
#pragma unroll
                for (int i = 0; i < 2; ++i) v2[h][i] = vAc[h][i];
            if (last) {
#pragma unroll
                for (int h = 0; h < 2; ++h)
#pragma unroll
                    for (int i = 0; i < 2; ++i) { unsigned x_ = vAn[h][i]; asm volatile("" : "+v"(x_)); v2[h][i] = x_; } } }
            PG8_LDB(B0, 0, 0); PG8_LDB(B1, 0, 1); PG8_SCHED; PG8_LDA(At, 0, 0); PG8_STAGE_A(PG8_SA(1, 1), 1, a1, vAc);
            PG8_WAIT_V(8); PG8_WAIT_L(0); PG8_BAR; PG8_MMA(0, 0, At, B0); PG8_MMA(0, 1, At, B1); PG8_BAR; PG8_SCHED;
            PG8_LDA(At, 0, 1); PG8_STAGE_B(PG8_SB(0, 0), b2); PG8_STAGE_B(PG8_SB(0, 1), b2 + hstep); PG8_STAGE_A(PG8_SA(0, 0), 0, a2, v2);
            PG8_WAIT_V(8); PG8_WAIT_L(0); PG8_BAR; PG8_MMA(1, 0, At, B0); PG8_MMA(1, 1, At, B1); PG8_BAR; PG8_SCHED;
            PG8_LDB(B0, 1, 0); PG8_LDB(B1, 1, 1); PG8_SCHED; PG8_LDA(At, 1, 0); PG8_STAGE_A(PG8_SA(0, 1), 1, a2, v2);
            PG8_WAIT_V(8); PG8_WAIT_L(0); PG8_BAR; PG8_MMA(0, 0, At, B0); PG8_MMA(0, 1, At, B1); PG8_BAR; PG8_SCHED;
            PG8_LDA(At, 1, 1); PG8_STAGE_B(PG8_SB(1, 0), b3); PG8_STAGE_B(PG8_SB(1, 1), b3 + hstep); PG8_STAGE_A(PG8_SA(1, 0), 0, a3, v2);
            PG8_WAIT_V(8); PG8_WAIT_L(0); PG8_BAR; PG8_MMA(1, 0, At, B0); PG8_MMA(1, 1, At, B1); PG8_BAR; PG8_SCHED;
        }
        if (wr == 0) PG8_BAR;
        if constexpr (FP8) asm volatile("s_nop 15\n\ts_nop 15" ::: "memory");
        E(acc, cur, wr, wc, fr, fq, wid, lane);
        if (!has_next) break;
        E.prefetch(nxt, wid, lane);
#pragma unroll
        for (int a = 0; a < 2; ++a)
#pragma unroll
            for (int b = 0; b < 2; ++b)
#pragma unroll
                for (int m = 0; m < 4; ++m)
#pragma unroll
                    for (int n = 0; n < 2; ++n) acc[a][b][m][n] = (f32x4){0.f, 0.f, 0.f, 0.f};
        cur = nxt; cB = nB; cA = nA; ++ui;
        if constexpr (GATHER) {
#pragma unroll
        for (int h = 0; h < 2; ++h)
#pragma unroll
            for (int i = 0; i < 2; ++i) vAc[h][i] = vAn[h][i]; }
        if (wr == 1) PG8_BAR;
    }
    PG8_WAIT_V(0);
    PG8_BAR;
#undef PG8_SA
#undef PG8_SB
#undef PG8_STAGE
#undef PG8_STAGE_B
#undef PG8_LDA
#undef PG8_LDB
#undef PG8_MMA
#undef PG8_LD8
#undef PG8_WAIT_V
#undef PG8_WAIT_L
#undef PG8_BAR
#undef PG8_SCHED
#undef PG8_VA
#undef PG8_STAGE_A
}
}

namespace att {
constexpr int D = 128, SEQ_ = 8192, PKV_ = 8256;
constexpr float THR = 8.f;
constexpr bool WSKIP = false;
constexpr float SCALE = 0.08838834764831845f;
constexpr int NW = 8, QBLK = 32, KVBLK = 64, QB = NW * QBLK;
constexpr int SHM_V = KVBLK * D * 2, SHM_K = KVBLK * D * 2;
constexpr int LDS_BYTES = 2 * SHM_V + 2 * SHM_K + NW * 64 * 4;
constexpr int BT_LEN = 352, BT_OFF = 96;
typedef unsigned short bf16;
typedef short bf16x8 __attribute__((ext_vector_type(8)));
typedef short s16x4 __attribute__((ext_vector_type(4)));
typedef float f32x16 __attribute__((ext_vector_type(16)));
typedef float f32x4 __attribute__((ext_vector_type(4)));
typedef unsigned u32x4 __attribute__((ext_vector_type(4)));
template <class A, class Bt> struct same_t { static constexpr bool v = false; };
template <class A> struct same_t<A, A> { static constexpr bool v = true; };

#define KSWZ(row, colB) ((row) * 256 + ((colB) ^ (((row) & 7) << 4)))
#define SBAR() __builtin_amdgcn_sched_barrier(0)
__device__ __forceinline__ int v_st(int k, int c) { const int kk = (k & ~0xC) | ((k & 4) << 1) | ((k & 8) >> 1); return ((kk >> 3) * 4 + (c >> 5)) * 512 + ((kk & 7) * 32 + (c & 31)) * 2; }
__device__ __forceinline__ int v_rd_base(int lane) { return ((lane & 3) << 3) | (((lane >> 2) & 3) << 6) | (((lane >> 4) & 1) << 5) | (((lane >> 5) & 1) << 8); }
constexpr int v_rd_off(int d0, int ks, int half) { return d0 * 512 + ks * 4096 + half * 2048; }
__device__ __forceinline__ int crow(int r, int hi) { return (r & 3) + 8 * (r >> 2) + 4 * hi; }
__device__ __forceinline__ unsigned cvtpk(float lo, float hi) {
    unsigned r; asm volatile("v_cvt_pk_bf16_f32 %0, %1, %2" : "=v"(r) : "v"(lo), "v"(hi)); return r;
}
__device__ __forceinline__ bf16x8 pack8(f32x4 a, f32x4 b) {
    u32x4 w = {cvtpk(a[0], a[1]), cvtpk(a[2], a[3]), cvtpk(b[0], b[1]), cvtpk(b[2], b[3])};
    return *reinterpret_cast<bf16x8*>(&w);
}
template <class T> __device__ __forceinline__ bf16x8 load8(const T* p) {
    if constexpr (same_t<T, float>::v) { return pack8(*(const f32x4*)p, *(const f32x4*)(p + 4)); }
    else { return *reinterpret_cast<const bf16x8*>(p); }
}
__device__ __forceinline__ void mask_tile(f32x16& p0, f32x16& p1, int dq, unsigned W) {
    const float NEG = -__builtin_inff();
#pragma unroll
    for (int r = 0; r < 16; ++r) {
        const int c = (r & 3) + 8 * (r >> 2);
        if ((unsigned)(dq - c) >= W) p0[r] = NEG;
        if ((unsigned)(dq - c - 32) >= W) p1[r] = NEG;
    }
}
__device__ __forceinline__ void bias_tile(f32x16& p0, f32x16& p1, int dq, const float* __restrict__ tab) {
    const float* tb = tab + (dq + 96);
#pragma unroll
    for (int r = 0; r < 16; ++r) {
        const int c = (r & 3) + 8 * (r >> 2);
        p0[r] += tb[-c];
        p1[r] += tb[-c - 32];
    }
}
__device__ __forceinline__ void padmask_tile(f32x16& p0, f32x16& p1) {
    const float NEG = -__builtin_inff();
#pragma unroll
    for (int r = 0; r < 16; ++r) p0[r] = NEG;
#pragma unroll
    for (int r = 0; r < 8; ++r) p1[r] = NEG;
}
template <bool FIXM>
__device__ __forceinline__ void partialSM(f32x16& p0, f32x16& p1, float& m_reg, float& mn, float& alpha) {
    if constexpr (FIXM) {
        mn = 0.f; alpha = 1.f;
        for (int r = 0; r < 16; ++r) p0[r] = __builtin_amdgcn_exp2f(p0[r]);
    } else {
    float pmax = p0[0]; for (int r = 1; r < 16; ++r) pmax = fmaxf(pmax, p0[r]); for (int r = 0; r < 16; ++r) pmax = fmaxf(pmax, p1[r]);
    { auto rr = __builtin_amdgcn_permlane32_swap(__float_as_uint(pmax), __float_as_uint(pmax), false, false);
      pmax = fmaxf(__uint_as_float(rr[0]), __uint_as_float(rr[1])); }
    if (__builtin_expect(__all((pmax - m_reg) * 0.6931471805599453f <= THR), 1)) { mn = m_reg; alpha = 1.f; }
    else { mn = fmaxf(m_reg, pmax); alpha = __builtin_amdgcn_exp2f(m_reg - mn); m_reg = mn; }
    for (int r = 0; r < 16; ++r) p0[r] -= mn; for (int r = 0; r < 16; ++r) p1[r] -= mn;
    for (int r = 0; r < 16; ++r) p0[r] = __builtin_amdgcn_exp2f(p0[r]);
    }
}
__device__ __forceinline__ void finishSM(f32x16& p0, f32x16& p1, float alpha, float& l_reg, bf16x8& pa0, bf16x8& pa1, bf16x8& pa2, bf16x8& pa3) {
    for (int r = 0; r < 16; ++r) p1[r] = __builtin_amdgcn_exp2f(p1[r]);
    float ps = 0; for (int r = 0; r < 16; ++r) ps += p0[r]; for (int r = 0; r < 16; ++r) ps += p1[r];
    { auto rr = __builtin_amdgcn_permlane32_swap(__float_as_uint(ps), __float_as_uint(ps), false, false);
      ps = __uint_as_float(rr[0]) + __uint_as_float(rr[1]); }
    l_reg = l_reg * alpha + ps;
#define PK4(P, B_, OUT) do { unsigned a0 = cvtpk(P[B_+0], P[B_+1]), a1 = cvtpk(P[B_+2], P[B_+3]);                          \
        unsigned b0 = cvtpk(P[B_+4], P[B_+5]), b1 = cvtpk(P[B_+6], P[B_+7]);                                             \
        auto r0 = __builtin_amdgcn_permlane32_swap(a0, b0, false, false); auto r1 = __builtin_amdgcn_permlane32_swap(a1, b1, false, false); \
        u32x4 w = {r0[0], r1[0], r0[1], r1[1]}; OUT = *reinterpret_cast<bf16x8*>(&w); } while (0)
    PK4(p0, 0, pa0); PK4(p0, 8, pa1); PK4(p1, 0, pa2); PK4(p1, 8, pa3);
#undef PK4
}
template <int KB, bool SK>
__device__ __forceinline__ void qkt(f32x16& p0, f32x16& p1, const char* K_lds, int r32, int hi, const bf16x8* qr, bool act) {
    if (SK && !act) { const float NEG = -__builtin_inff();
#pragma unroll
        for (int r = 0; r < 16; ++r) { p0[r] = NEG; p1[r] = NEG; } return; }
    p0 = f32x16{}; p1 = f32x16{};
    const char* kb[4];
#pragma unroll
    for (int dd = 0; dd < 4; ++dd) kb[dd] = K_lds + KB * SHM_K + KSWZ(r32, (dd * 16 + hi * 8) * 2);
#pragma unroll
    for (int d0 = 0; d0 < 8; ++d0) { const char* a = kb[d0 & 3] + (d0 >> 2) * 128;
        bf16x8 b0 = *reinterpret_cast<const bf16x8*>(a);
        bf16x8 b1 = *reinterpret_cast<const bf16x8*>(a + 32 * 256);
        p0 = __builtin_amdgcn_mfma_f32_32x32x16_bf16(b0, qr[d0], p0, 0, 0, 0);
        p1 = __builtin_amdgcn_mfma_f32_32x32x16_bf16(b1, qr[d0], p1, 0, 0, 0); }
}
template <int VB, bool SK>
__device__ __forceinline__ void pv_tile(f32x16* o, int vb0, bf16x8 pa0, bf16x8 pa1, bf16x8 pa2, bf16x8 pa3, bool act) {
    if (SK && !act) return;
#define TRRD(dst, off) asm volatile("ds_read_b64_tr_b16 %0, %1 offset:%2" : "=&v"(dst) : "v"(vb0), "i"(off) : "memory")
#define PV_D0(d0) do { s16x4 l0, l1, l2, l3, h0, h1, h2, h3; constexpr int b_ = VB * SHM_V + v_rd_off(d0, 0, 0);     \
        TRRD(l0, b_); TRRD(h0, b_ + 2048); TRRD(l1, b_ + 4096); TRRD(h1, b_ + 6144); TRRD(l2, b_ + 8192); TRRD(h2, b_ + 10240); TRRD(l3, b_ + 12288); TRRD(h3, b_ + 14336); \
        asm volatile("s_waitcnt lgkmcnt(0)" ::: "memory"); SBAR();                 \
        o[d0] = __builtin_amdgcn_mfma_f32_32x32x16_bf16(pa0, (bf16x8){l0[0], l0[1], l0[2], l0[3], h0[0], h0[1], h0[2], h0[3]}, o[d0], 0, 0, 0);   \
        o[d0] = __builtin_amdgcn_mfma_f32_32x32x16_bf16(pa1, (bf16x8){l1[0], l1[1], l1[2], l1[3], h1[0], h1[1], h1[2], h1[3]}, o[d0], 0, 0, 0);   \
        o[d0] = __builtin_amdgcn_mfma_f32_32x32x16_bf16(pa2, (bf16x8){l2[0], l2[1], l2[2], l2[3], h2[0], h2[1], h2[2], h2[3]}, o[d0], 0, 0, 0);   \
        o[d0] = __builtin_amdgcn_mfma_f32_32x32x16_bf16(pa3, (bf16x8){l3[0], l3[1], l3[2], l3[3], h3[0], h3[1], h3[2], h3[3]}, o[d0], 0, 0, 0); } while (0)
    PV_D0(0); PV_D0(1); PV_D0(2); PV_D0(3);
#undef PV_D0
#undef TRRD
}

template <class TIn, class TOut> struct BlockRef { const TIn* Q; const TIn* K; const TIn* V; TOut* O; int P0; const float* bt; };
template <class TIn> struct Seam {
    bf16x8 qr[8];
    bf16x8 st_v0, st_v1, st_k0, st_k1; f32x4 sf0, sf1, sf2, sf3;
    f32x4 tq[16];
};
__device__ __forceinline__ int swa_jlo(int P0, int W) { const int lowk = P0 - W + 1; return lowk > 0 ? lowk / KVBLK : 0; }
#define ROW(p, k0, rr) ((p) + (size_t)((k0) + (rr)) * D + sc)
#define VMW() asm volatile("s_waitcnt vmcnt(0)" ::: "memory")
#define VMWN(n) asm volatile("s_waitcnt vmcnt(%0)" :: "i"(n) : "memory")
#define SLOAD_H(Kp, Vp, k0) do { S.st_v0 = load8<TIn>(ROW(Vp, k0, sr)); S.st_v1 = load8<TIn>(ROW(Vp, k0, 32 + sr));              \
                         S.st_k0 = load8<TIn>(ROW(Kp, k0, sr)); S.st_k1 = load8<TIn>(ROW(Kp, k0, 32 + sr)); } while (0)
#define SWRITE_HK(bf) do { *(bf16x8*)(K_lds + (bf) * SHM_K + kws) = S.st_k0; *(bf16x8*)(K_lds + (bf) * SHM_K + kws + 32 * 256) = S.st_k1; } while (0)
#define SWRITE_HV(bf) do { *(bf16x8*)(V_lds + (bf) * SHM_V + vst0) = S.st_v0; *(bf16x8*)(V_lds + (bf) * SHM_V + vst1) = S.st_v1; } while (0)
#define SWRITE_H(bf) do { SWRITE_HV(bf); SWRITE_HK(bf); } while (0)
#define SLOAD_F(p, k0) do { S.sf0 = *(const f32x4*)ROW(p, k0, sr); S.sf1 = *(const f32x4*)(ROW(p, k0, sr) + 4);                \
                            S.sf2 = *(const f32x4*)ROW(p, k0, 32 + sr); S.sf3 = *(const f32x4*)(ROW(p, k0, 32 + sr) + 4); } while (0)
#define SWRITE_KF(bf) do { *(bf16x8*)(K_lds + (bf) * SHM_K + kws) = pack8(S.sf0, S.sf1); *(bf16x8*)(K_lds + (bf) * SHM_K + kws + 32 * 256) = pack8(S.sf2, S.sf3); } while (0)
#define SWRITE_VF(bf) do { *(bf16x8*)(V_lds + (bf) * SHM_V + vst0) = pack8(S.sf0, S.sf1); *(bf16x8*)(V_lds + (bf) * SHM_V + vst1) = pack8(S.sf2, S.sf3); } while (0)
template <class TIn, class TOut>
__device__ __forceinline__ void causal_swa_prime(const BlockRef<TIn, TOut>& cur, int W, char* lds, Seam<TIn>& S) {
    constexpr bool F32 = same_t<TIn, float>::v;
    int tid_ = threadIdx.x; asm volatile("" : "+v"(tid_)); const int tid = tid_, wid = __builtin_amdgcn_readfirstlane(tid >> 6), lane = tid & 63, r32 = lane & 31, hi = lane >> 5;
    const int sr = tid >> 4, sc = (tid & 15) * 8, kws = KSWZ(sr, sc * 2); char* K_lds = lds + 2 * SHM_V;
    const int kb0 = swa_jlo(cur.P0, W) * KVBLK;
    for (int d0 = 0; d0 < 8; ++d0) S.qr[d0] = load8<TIn>(cur.Q + (size_t)(wid * QBLK + r32) * D + d0 * 16 + hi * 8);
    if constexpr (F32) { SLOAD_F((const float*)cur.K, kb0); VMW(); SWRITE_KF(0); SBAR(); SLOAD_F((const float*)cur.V, kb0); }
    else { SLOAD_H(cur.K, cur.V, kb0); VMW(); SWRITE_HK(0); }
    __syncthreads();
}
template <class TIn, class TOut, bool FIXM>
__device__ __forceinline__ void causal_swa_block(const BlockRef<TIn, TOut>& cur, const BlockRef<TIn, TOut>& nxt, int skv, int W, char* lds, Seam<TIn>& S) {
    constexpr bool F32 = same_t<TIn, float>::v;
    int tid_ = threadIdx.x; asm volatile("" : "+v"(tid_)); const int tid = tid_, wid = __builtin_amdgcn_readfirstlane(tid >> 6), lane = tid & 63, r32 = lane & 31, hi = lane >> 5;
    const int j_lo = swa_jlo(cur.P0, W);
    int j_hi = (cur.P0 + QB - 1) / KVBLK + 1; if (j_hi > skv / KVBLK) j_hi = skv / KVBLK;
    const int NT = j_hi - j_lo;
    const int kbn = swa_jlo(nxt.P0, W) * KVBLK;
    const int qlo = cur.P0 + wid * QBLK, qm = qlo + r32 - 4 * hi;
    char* V_lds = lds; char* K_lds = lds + 2 * SHM_V;
    float* ws = (float*)(lds + 2 * SHM_V + 2 * SHM_K) + wid * 64; float* li_l = ws, * al_l = ws + 32;
    float m_reg = -1e30f, l_reg = 0; f32x16 o[4] = {};
    const int sr = tid >> 4, sc = (tid & 15) * 8, vst0 = v_st(sr, sc), vst1 = v_st(32 + sr, sc), kws = KSWZ(sr, sc * 2);
    const int vb0 = (int)(uintptr_t)V_lds + v_rd_base(lane);
    const TIn* Kh = cur.K; const TIn* Vh = cur.V;
#define RESC(a) do { if (!FIXM && __any((a) < 1.f)) { if (hi == 0) al_l[r32] = (a); asm volatile("s_waitcnt lgkmcnt(0)" ::: "memory");              \
                     for (int d_ = 0; d_ < 4; ++d_) for (int r = 0; r < 16; ++r) o[d_][r] *= al_l[crow(r, hi)]; } } while (0)
#define KBASE(t) ((j_lo + (t)) * KVBLK)
#define ACT(t) (KBASE(t) <= qlo + QBLK - 1 && KBASE(t) + KVBLK - 1 >= qlo - W + 1)
#define MASKT(P0_, P1_, t) do { const int kb_ = KBASE(t); \
        if (kb_ <= qlo + QBLK - 1 && qlo - kb_ <= 190) bias_tile(P0_, P1_, qm - kb_, cur.bt);            \
        if (kb_ == 0) padmask_tile(P0_, P1_);                                                         \
        if ((!SK || ACT(t)) && (kb_ + KVBLK - 1 > qlo || kb_ <= qlo + QBLK - 1 - W)) mask_tile(P0_, P1_, qm - kb_, (unsigned)W); } while (0)
    constexpr int NQL = F32 ? 16 : 8;
    constexpr bool SK = WSKIP && !F32;
#define SEAM_K0() do { VMWN(NQL); if constexpr (F32) { SWRITE_KF(0); SBAR(); SLOAD_F((const float*)nxt.V, kbn); } else { SWRITE_HK(0); } SBAR(); } while (0)
    f32x16 pA0, pA1, pB0, pB1; float mnA, mnB, alA, alB; bf16x8 pa0, pa1, pa2, pa3;
    if constexpr (F32) { VMW(); SWRITE_VF(0); SBAR(); } else { SWRITE_HV(0); SBAR(); }
    if (NT > 1) { if constexpr (F32) SLOAD_F((const float*)Kh, KBASE(1)); else SLOAD_H(Kh, Vh, KBASE(1)); }
    SBAR(); qkt<0, SK>(pA0, pA1, K_lds, r32, hi, S.qr, ACT(0));
    if constexpr (F32) { if (NT > 1) { VMW(); SWRITE_KF(1); SBAR(); SLOAD_F((const float*)Vh, KBASE(1)); } }
    MASKT(pA0, pA1, 0); partialSM<FIXM>(pA0, pA1, m_reg, mnA, alA);
    if (NT > 1) { VMW(); if constexpr (F32) { SWRITE_VF(1); SBAR(); if (NT > 2) SLOAD_F((const float*)Kh, KBASE(2)); } else SWRITE_H(1); }
    __syncthreads();
#define HALF_STEP(PX0, PX1, mnX, alX, PY0, PY1, alY, t, KB, VB, SB) do {                                                      \
        SBAR(); qkt<KB, SK>(PX0, PX1, K_lds, r32, hi, S.qr, ACT(t));                                             \
        finishSM(PY0, PY1, alY, l_reg, pa0, pa1, pa2, pa3); SBAR();                                                           \
        if ((t) + 1 < NT) { if constexpr (F32) { VMW(); SWRITE_KF(SB); SBAR(); SLOAD_F((const float*)Vh, KBASE((t) + 1)); }  \
                            else { SLOAD_H(Kh, Vh, KBASE((t) + 1)); } SBAR(); }                                               \
        pv_tile<VB, SK>(o, vb0, pa0, pa1, pa2, pa3, ACT((t) - 1)); MASKT(PX0, PX1, (t)); partialSM<FIXM>(PX0, PX1, m_reg, mnX, alX);                                        \
        __syncthreads();                                                                                                      \
        if ((t) + 1 < NT) { VMW(); if constexpr (F32) { SWRITE_VF(SB); SBAR(); if ((t) + 2 < NT) SLOAD_F((const float*)Kh, KBASE((t) + 2)); } \
                            else { SWRITE_H(SB); } }                                                                          \
        RESC(alX); __syncthreads(); } while (0)
    for (int t = 1; t + 1 < NT; t += 2) {
        HALF_STEP(pB0, pB1, mnB, alB, pA0, pA1, alA, t, 1, 0, 0);
        HALF_STEP(pA0, pA1, mnA, alA, pB0, pB1, alB, t + 1, 0, 1, 1);
    }
    const bool even = (NT & 1) == 0;
    if (even) { SBAR(); qkt<1, SK>(pB0, pB1, K_lds, r32, hi, S.qr, ACT(NT - 1)); SBAR(); }
#define QROW(e) (nxt.Q + (size_t)(wid * QBLK + r32) * D + ((e) >> 1) * 16 + hi * 8 + ((e) & 1) * 4)
    if constexpr (F32) { SLOAD_F((const float*)nxt.K, kbn); SBAR();
#pragma unroll
        for (int e = 0; e < 8; ++e) S.tq[e] = *(const f32x4*)QROW(e); }
    else { SLOAD_H(nxt.K, nxt.V, kbn); SBAR();
#pragma unroll
        for (int d0 = 0; d0 < 8; ++d0) S.qr[d0] = load8<TIn>(nxt.Q + (size_t)(wid * QBLK + r32) * D + d0 * 16 + hi * 8); }
    SBAR();
    finishSM(pA0, pA1, alA, l_reg, pa0, pa1, pa2, pa3); SBAR();
    if constexpr (F32) {
#pragma unroll
        for (int e = 8; e < 16; ++e) S.tq[e] = *(const f32x4*)QROW(e); SBAR(); }
#undef QROW
    pv_tile<0, SK>(o, vb0, pa0, pa1, pa2, pa3, ACT(even ? NT - 2 : NT - 1));
    if (even) { MASKT(pB0, pB1, NT - 1); partialSM<FIXM>(pB0, pB1, m_reg, mnB, alB); __syncthreads(); RESC(alB);
        finishSM(pB0, pB1, alB, l_reg, pa0, pa1, pa2, pa3); SBAR(); pv_tile<1, SK>(o, vb0, pa0, pa1, pa2, pa3, ACT(NT - 1)); }
    SBAR(); SEAM_K0();
    if (hi == 0) li_l[r32] = l_reg; asm volatile("s_waitcnt lgkmcnt(0)" ::: "memory");
    float rli[16];
#pragma unroll
    for (int r = 0; r < 16; ++r) rli[r] = __builtin_amdgcn_rcpf(li_l[crow(r, hi)]);
    TOut* Ow = cur.O + (size_t)(wid * QBLK) * D;
#pragma unroll
    for (int r = 0; r < 16; ++r) { const int orow = crow(r, hi);
#pragma unroll
        for (int d0 = 0; d0 < 4; ++d0) { const float v = o[d0][r] * rli[r];
            if constexpr (same_t<TOut, float>::v) { Ow[(size_t)orow * D + d0 * 32 + r32] = v; }
            else { const float vn = __shfl_xor(v, 1);
                   if ((r32 & 1) == 0) *(unsigned*)(Ow + (size_t)orow * D + d0 * 32 + r32) = cvtpk(v, vn); } } }
    if constexpr (F32) {
#pragma unroll
        for (int d0 = 0; d0 < 8; ++d0) S.qr[d0] = pack8(S.tq[2 * d0], S.tq[2 * d0 + 1]); }
    __syncthreads();
#undef RESC
#undef KBASE
#undef ACT
#undef MASKT
#undef SEAM_K0
#undef HALF_STEP
}
#undef ROW
#undef VMW
#undef VMWN
#undef SLOAD_H
#undef SWRITE_HK
#undef SWRITE_HV
#undef SWRITE_H
#undef SLOAD_F
#undef SWRITE_KF
#undef SWRITE_VF

typedef float f32x2_b __attribute__((ext_vector_type(2))); typedef __bf16 bf16x2_b __attribute__((ext_vector_type(2)));
__device__ __forceinline__ unsigned cvtpk_b(float lo, float hi) { f32x2_b v = {lo, hi}; bf16x2_b b = __builtin_convertvector(v, bf16x2_b); return __builtin_bit_cast(unsigned, b); }
constexpr int P2_QB = 128;
constexpr int P2_V = 0, P2_K = 4 * SHM_V, P2_XP = P2_K + 2 * SHM_K, P2_L = P2_XP + 2 * 8 * 2048, P2_LDS = P2_L + 8 * 32 * 4;
struct BlockRef2 { const bf16* Q; const bf16* K; const bf16* V; bf16* O; int P0; const float* bt; };
__device__ __forceinline__ void paired_block(const BlockRef2& cur, char* lds) {
    int tid_ = threadIdx.x; asm volatile("" : "+v"(tid_));
    const int tid = tid_, wid = __builtin_amdgcn_readfirstlane(tid >> 6), lane = tid & 63, r32 = lane & 31, hi = lane >> 5, wq = wid & 3, kh = wid >> 2;
    const int NT = (cur.P0 + P2_QB - 1) / KVBLK + 1;
    const int qlo = cur.P0 + wq * QBLK, qm = qlo + r32 - 4 * hi;
    char* V_lds = lds + P2_V; char* K_lds = lds + P2_K; char* XP = lds + P2_XP; float* LS = (float*)(lds + P2_L);
    const int sr = tid >> 4, sc = (tid & 15) * 8, vst0 = v_st(sr, sc), vst1 = v_st(32 + sr, sc), kws = KSWZ(sr, sc * 2);
    const int vb0 = (int)(uintptr_t)V_lds + kh * SHM_V + v_rd_base(lane);
    const bf16* Kh = cur.K; const bf16* V0 = cur.V; const bf16* V1 = cur.V + (size_t)PKV_ * D;
    bf16x8 qr[8];
#pragma unroll
    for (int d0 = 0; d0 < 8; ++d0) qr[d0] = *reinterpret_cast<const bf16x8*>(cur.Q + (size_t)(wq * QBLK + r32) * D + d0 * 16 + hi * 8);
    typedef __attribute__((address_space(3))) unsigned lds_u32;
    unsigned koff[2], voff[2];
#pragma unroll
    for (int i = 0; i < 2; ++i) { const int q = wid * 128 + i * 64 + lane, row = q >> 4, c16 = (q & 15) ^ (row & 7); koff[i] = (unsigned)(row * 256 + c16 * 16);
        const int st = q >> 5, qq = q & 31, kk = (st >> 2) * 8 + (qq >> 2), k = (kk & ~0xC) | ((kk & 4) << 1) | ((kk & 8) >> 1), c = (st & 3) * 32 + (qq & 3) * 8; voff[i] = (unsigned)(k * 256 + c * 2); }
    const unsigned ldsK = (unsigned)(uintptr_t)K_lds + wid * 2048, ldsV = (unsigned)(uintptr_t)V_lds + wid * 2048;
#define P2_DMA(gbase, goff, ldsaddr) __builtin_amdgcn_global_load_lds((const unsigned*)((const char*)(gbase) + (goff)), (lds_u32*)(ldsaddr), 16, 0, 0)
#define P2_DMAK(t, bf) do { const char* g_ = (const char*)Kh + (size_t)(t) * KVBLK * D * 2; P2_DMA(g_, koff[0], ldsK + (bf) * SHM_K); P2_DMA(g_, koff[1], ldsK + (bf) * SHM_K + 1024); } while (0)
#define P2_DMAV(t, bf) do { const char* g0_ = (const char*)V0 + (size_t)(t) * KVBLK * D * 2; const char* g1_ = (const char*)V1 + (size_t)(t) * KVBLK * D * 2;                      \
        P2_DMA(g0_, voff[0], ldsV + (bf) * 2 * SHM_V); P2_DMA(g0_, voff[1], ldsV + (bf) * 2 * SHM_V + 1024); P2_DMA(g1_, voff[0], ldsV + (bf) * 2 * SHM_V + SHM_V); P2_DMA(g1_, voff[1], ldsV + (bf) * 2 * SHM_V + SHM_V + 1024); } while (0)
    P2_DMAK(0, 0); P2_DMAK(1, 1);
    __syncthreads();
    f32x16 pc = f32x16{};
    { const char* kb[4];
#pragma unroll
      for (int dd = 0; dd < 4; ++dd) kb[dd] = K_lds + kh * (32 * 256) + KSWZ(r32, (dd * 16 + hi * 8) * 2);
#pragma unroll
      for (int d0 = 0; d0 < 8; ++d0) pc = __builtin_amdgcn_mfma_f32_32x32x16_bf16(*reinterpret_cast<const bf16x8*>(kb[d0 & 3] + (d0 >> 2) * 128), qr[d0], pc, 0, 0, 0); }
    __syncthreads();
    f32x16 o[4] = {}; float l_reg = 0.f; bf16x8 pa0, pa1, pa2, pa3;
#define P2_TR(dst, off) asm volatile("ds_read_b64_tr_b16 %0, %1 offset:%2" : "=&v"(dst) : "v"(vb0), "i"(off) : "memory")
#define P2_RD(VB_, d0, X) do { constexpr int b_ = (VB_) * 2 * SHM_V + v_rd_off(d0, 0, 0);                                                       \
        P2_TR(X##l0, b_); P2_TR(X##h0, b_ + 2048); P2_TR(X##l1, b_ + 4096); P2_TR(X##h1, b_ + 6144); P2_TR(X##l2, b_ + 8192); P2_TR(X##h2, b_ + 10240); P2_TR(X##l3, b_ + 12288); P2_TR(X##h3, b_ + 14336); } while (0)
#define P2_MM(d0, X) do {                                                                                                                   \
        o[d0] = __builtin_amdgcn_mfma_f32_32x32x16_bf16(pa0, (bf16x8){X##l0[0], X##l0[1], X##l0[2], X##l0[3], X##h0[0], X##h0[1], X##h0[2], X##h0[3]}, o[d0], 0, 0, 0); \
        o[d0] = __builtin_amdgcn_mfma_f32_32x32x16_bf16(pa1, (bf16x8){X##l1[0], X##l1[1], X##l1[2], X##l1[3], X##h1[0], X##h1[1], X##h1[2], X##h1[3]}, o[d0], 0, 0, 0); \
        o[d0] = __builtin_amdgcn_mfma_f32_32x32x16_bf16(pa2, (bf16x8){X##l2[0], X##l2[1], X##l2[2], X##l2[3], X##h2[0], X##h2[1], X##h2[2], X##h2[3]}, o[d0], 0, 0, 0); \
        o[d0] = __builtin_amdgcn_mfma_f32_32x32x16_bf16(pa3, (bf16x8){X##l3[0], X##l3[1], X##l3[2], X##l3[3], X##h3[0], X##h3[1], X##h3[2], X##h3[3]}, o[d0], 0, 0, 0); } while (0)
#define P2_LW(n) do { asm volatile("s_waitcnt lgkmcnt(" #n ")" ::: "memory"); SBAR(); } while (0)
#define P2_PVALL(VB_) do { s16x4 Al0, Al1, Al2, Al3, Ah0, Ah1, Ah2, Ah3, Bl0, Bl1, Bl2, Bl3, Bh0, Bh1, Bh2, Bh3;                                 \
        P2_RD(VB_, 0, A); P2_RD(VB_, 1, B); P2_LW(8); P2_MM(0, A); P2_RD(VB_, 2, A); P2_LW(8); P2_MM(1, B); P2_RD(VB_, 3, B); P2_LW(8); P2_MM(2, A); P2_LW(0); P2_MM(3, B); } while (0)
#define P2_STEP(s, PAR) do { f32x16 p = f32x16{};                                                                                           \
        if ((s) + 1 < NT) P2_DMAK((s) + 1, 1 - (PAR)); if ((s) < NT) P2_DMAV((s), (PAR));     \
        if ((s) < NT) {                                                                                                                    \
            const char* kb[4];                                                                                                             \
            _Pragma("unroll") for (int dd = 0; dd < 4; ++dd) kb[dd] = K_lds + (PAR) * SHM_K + kh * (32 * 256) + KSWZ(r32, (dd * 16 + hi * 8) * 2); \
            _Pragma("unroll") for (int d0 = 0; d0 < 8; ++d0) p = __builtin_amdgcn_mfma_f32_32x32x16_bf16(*reinterpret_cast<const bf16x8*>(kb[d0 & 3] + (d0 >> 2) * 128), qr[d0], p, 0, 0, 0); } \
        if ((s) >= 1) { constexpr int VB_ = 1 - (PAR);                           \
            P2_PVALL(VB_); }                                                                                                          \
        if ((s) < NT) { const int kbase = (s) * KVBLK + 32 * kh, dq = qm - kbase;                    \
            if (kbase <= qlo + QBLK - 1 && qlo - kbase <= 158) { const float* tb = cur.bt + (dq + BT_OFF);                                  \
                _Pragma("unroll") for (int r = 0; r < 16; ++r) p[r] += tb[-((r & 3) + 8 * (r >> 2))]; }                                  \
            if ((s) == 0) { const float NEG_ = -__builtin_inff(); _Pragma("unroll") for (int r = 0; r < 16; ++r) if (kh == 0 || r < 8) p[r] = NEG_; }     \
            if (kbase + 31 > qlo) { const float NEG_ = -__builtin_inff(); _Pragma("unroll") for (int r = 0; r < 16; ++r) if (dq - ((r & 3) + 8 * (r >> 2)) < 0) p[r] = NEG_; } \
            _Pragma("unroll") for (int r = 0; r < 16; ++r) p[r] = __builtin_amdgcn_exp2f(p[r]);                                             \
            float ps = 0.f; _Pragma("unroll") for (int r = 0; r < 16; ++r) ps += p[r];                                                      \
            { auto rr = __builtin_amdgcn_permlane32_swap(__float_as_uint(ps), __float_as_uint(ps), false, false); ps = __uint_as_float(rr[0]) + __uint_as_float(rr[1]); } \
            l_reg += ps;                                                                                                                   \
            bf16x8 fa, fb;                                                                                                                 \
            { unsigned a0 = cvtpk_b(p[0], p[1]), a1 = cvtpk_b(p[2], p[3]), b0 = cvtpk_b(p[4], p[5]), b1 = cvtpk_b(p[6], p[7]);                       \
              auto r0 = __builtin_amdgcn_permlane32_swap(a0, b0, false, false); auto r1 = __builtin_amdgcn_permlane32_swap(a1, b1, false, false); \
              u32x4 w = {r0[0], r1[0], r0[1], r1[1]}; fa = *reinterpret_cast<bf16x8*>(&w); }                                                 \
            { unsigned a0 = cvtpk_b(p[8], p[9]), a1 = cvtpk_b(p[10], p[11]), b0 = cvtpk_b(p[12], p[13]), b1 = cvtpk_b(p[14], p[15]);                 \
              auto r0 = __builtin_amdgcn_permlane32_swap(a0, b0, false, false); auto r1 = __builtin_amdgcn_permlane32_swap(a1, b1, false, false); \
              u32x4 w = {r0[0], r1[0], r0[1], r1[1]}; fb = *reinterpret_cast<bf16x8*>(&w); }                                                 \
            char* xp = XP + (PAR) * (8 * 2048) + wq * 4096 + lane * 16;          \
            *(bf16x8*)(xp + (2 * kh) * 1024) = fa; *(bf16x8*)(xp + (2 * kh + 1) * 1024) = fb;                                              \
            }                                                                                                                              \
        __syncthreads();                                                                                                                   \
        if ((s) < NT) { const char* xp = XP + (PAR) * (8 * 2048) + wq * 4096 + lane * 16;                                                    \
            pa0 = *(const bf16x8*)(xp); pa1 = *(const bf16x8*)(xp + 1024); pa2 = *(const bf16x8*)(xp + 2048); pa3 = *(const bf16x8*)(xp + 3072);   \
            } } while (0)
#define P2_LW2(n, X) do { asm volatile("s_waitcnt lgkmcnt(" #n ")" : "+v"(X##l0), "+v"(X##h0), "+v"(X##l1), "+v"(X##h1), "+v"(X##l2), "+v"(X##h2), "+v"(X##l3), "+v"(X##h3)); SBAR(); } while (0)
#define P2_CH(j) do { _Pragma("unroll") for (int r = 4 * (j); r < 4 * (j) + 4; ++r) { p[r] = __builtin_amdgcn_exp2f(p[r]); ps += p[r]; } } while (0)
#define P2_PACK(B_, OUT) do { unsigned a0 = cvtpk_b(p[B_ + 0], p[B_ + 1]), a1 = cvtpk_b(p[B_ + 2], p[B_ + 3]), b0 = cvtpk_b(p[B_ + 4], p[B_ + 5]), b1 = cvtpk_b(p[B_ + 6], p[B_ + 7]);   \
        auto r0 = __builtin_amdgcn_permlane32_swap(a0, b0, false, false); auto r1 = __builtin_amdgcn_permlane32_swap(a1, b1, false, false); \
        u32x4 w = {r0[0], r1[0], r0[1], r1[1]}; OUT = *reinterpret_cast<bf16x8*>(&w); } while (0)
#define P2_MAIN(s, PAR) do { constexpr int VB_ = 1 - (PAR); f32x16 p = f32x16{};                                                              \
        if ((s) + 1 < NT) P2_DMAK((s) + 1, 1 - (PAR)); P2_DMAV((s), (PAR));                                                                  \
        { const char* kb[4];                                                                                                               \
          _Pragma("unroll") for (int dd = 0; dd < 4; ++dd) kb[dd] = K_lds + (PAR) * SHM_K + kh * (32 * 256) + KSWZ(r32, (dd * 16 + hi * 8) * 2); \
          _Pragma("unroll") for (int d0 = 0; d0 < 8; ++d0) p = __builtin_amdgcn_mfma_f32_32x32x16_bf16(*reinterpret_cast<const bf16x8*>(kb[d0 & 3] + (d0 >> 2) * 128), qr[d0], p, 0, 0, 0); } \
        s16x4 Al0, Al1, Al2, Al3, Ah0, Ah1, Ah2, Ah3, Bl0, Bl1, Bl2, Bl3, Bh0, Bh1, Bh2, Bh3;                                              \
        P2_RD(VB_, 0, A); P2_RD(VB_, 1, B);                                                                                                \
        { const int kbase = (s) * KVBLK + 32 * kh, dq = qm - kbase;                                                                         \
          if (kbase <= qlo + QBLK - 1 && qlo - kbase <= 158) { const float* tb = cur.bt + (dq + BT_OFF);                                    \
              _Pragma("unroll") for (int r = 0; r < 16; ++r) p[r] += tb[-((r & 3) + 8 * (r >> 2))]; }                                    \
          if (kbase + 31 > qlo) { const float NEG_ = -__builtin_inff(); _Pragma("unroll") for (int r = 0; r < 16; ++r) if (dq - ((r & 3) + 8 * (r >> 2)) < 0) p[r] = NEG_; } } \
        float ps = 0.f; bf16x8 fa, fb;                                                                                                     \
        P2_LW2(8, A); P2_MM(0, A); SBAR(); P2_CH(0); SBAR(); P2_RD(VB_, 2, A);                                                               \
        P2_LW2(8, B); P2_MM(1, B); SBAR(); P2_CH(1); P2_PACK(0, fa); SBAR(); P2_RD(VB_, 3, B);                                               \
        P2_LW2(8, A); P2_MM(2, A); SBAR(); P2_CH(2); SBAR();                                                                                 \
        P2_LW2(0, B); P2_MM(3, B); SBAR(); P2_CH(3); P2_PACK(8, fb);                                                                         \
        { auto rr = __builtin_amdgcn_permlane32_swap(__float_as_uint(ps), __float_as_uint(ps), false, false); ps = __uint_as_float(rr[0]) + __uint_as_float(rr[1]); } \
        l_reg += ps;                                                                                                                       \
        { char* xp = XP + (PAR) * (8 * 2048) + wq * 4096 + lane * 16;                                                                       \
          *(bf16x8*)(xp + (2 * kh) * 1024) = fa; *(bf16x8*)(xp + (2 * kh + 1) * 1024) = fb; }                                              \
        __syncthreads();                                                                                                                   \
        { const char* xp = XP + (PAR) * (8 * 2048) + wq * 4096 + lane * 16;                                                                 \
          pa0 = *(const bf16x8*)(xp); pa1 = *(const bf16x8*)(xp + 1024); pa2 = *(const bf16x8*)(xp + 2048); pa3 = *(const bf16x8*)(xp + 3072); } \
        } while (0)
#define P3_QK(i) pn = __builtin_amdgcn_mfma_f32_32x32x16_bf16(*reinterpret_cast<const bf16x8*>(kb[(i) & 3] + ((i) >> 2) * 128), qr[i], pn, 0, 0, 0)
#define P3_GEN(s, PAR, HQ_, HS_, HV_) do { constexpr int VB_ = 1 - (PAR); constexpr bool hq = HQ_, hs = HS_, hv = HV_;                                \
        if (hq && (s) + 2 < NT) P2_DMAK((s) + 2, (PAR)); if (hs) P2_DMAV((s), (PAR));                                                        \
        f32x16 pn = f32x16{}; f32x16 p = pc;                                                                                               \
        const char* kb[4];                                                                                                                 \
        _Pragma("unroll") for (int dd = 0; dd < 4; ++dd) kb[dd] = K_lds + (1 - (PAR)) * SHM_K + kh * (32 * 256) + KSWZ(r32, (dd * 16 + hi * 8) * 2); \
        s16x4 Al0, Al1, Al2, Al3, Ah0, Ah1, Ah2, Ah3, Bl0, Bl1, Bl2, Bl3, Bh0, Bh1, Bh2, Bh3;                                              \
        if (hv) { P2_RD(VB_, 0, A); P2_RD(VB_, 1, B); }                                                                                     \
        if (hs) { const int kbase = (s) * KVBLK + 32 * kh, dq = qm - kbase;                                                                 \
          if (kbase <= qlo + QBLK - 1 && qlo - kbase <= 158) { const float* tb = cur.bt + (dq + BT_OFF);                                    \
              _Pragma("unroll") for (int r = 0; r < 16; ++r) p[r] += tb[-((r & 3) + 8 * (r >> 2))]; }                                    \
          if ((s) == 0) { const float NEG_ = -__builtin_inff(); _Pragma("unroll") for (int r = 0; r < 16; ++r) if (kh == 0 || r < 8) p[r] = NEG_; }     \
          if (kbase + 31 > qlo) { const float NEG_ = -__builtin_inff(); _Pragma("unroll") for (int r = 0; r < 16; ++r) if (dq - ((r & 3) + 8 * (r >> 2)) < 0) p[r] = NEG_; } } \
        float ps = 0.f; bf16x8 fa, fb;                                                                                                     \
        if (hq) { P3_QK(0); P3_QK(1); } if (hv) { P2_LW2(8, A); P2_MM(0, A); } if (hs) { P2_CH(0); } if (hv) P2_RD(VB_, 2, A);                        \
        if (hq) { P3_QK(2); P3_QK(3); } if (hv) { P2_LW2(8, B); P2_MM(1, B); } if (hs) { P2_CH(1); P2_PACK(0, fa); } if (hv) P2_RD(VB_, 3, B);        \
        if (hq) { P3_QK(4); P3_QK(5); } if (hv) { P2_LW2(8, A); P2_MM(2, A); } if (hs) { P2_CH(2); }                                                 \
        if (hq) { P3_QK(6); P3_QK(7); } if (hv) { P2_LW2(0, B); P2_MM(3, B); }                                                                     \
        if (hs) { P2_CH(3); P2_PACK(8, fb);                                                                                                 \
          { auto rr = __builtin_amdgcn_permlane32_swap(__float_as_uint(ps), __float_as_uint(ps), false, false); ps = __uint_as_float(rr[0]) + __uint_as_float(rr[1]); } \
          l_reg += ps;                                                                                                                     \
          char* xp = XP + (PAR) * (8 * 2048) + wq * 4096 + lane * 16;                                                                       \
          *(bf16x8*)(xp + (2 * kh) * 1024) = fa; *(bf16x8*)(xp + (2 * kh + 1) * 1024) = fb; }                                              \
        __syncthreads();                                                                                                                   \
        if (hs) { const char* xp = XP + (PAR) * (8 * 2048) + wq * 4096 + lane * 16;                                                          \
          pa0 = *(const bf16x8*)(xp); pa1 = *(const bf16x8*)(xp + 1024); pa2 = *(const bf16x8*)(xp + 2048); pa3 = *(const bf16x8*)(xp + 3072); } \
        pc = pn; } while (0)
    P3_GEN(0, 0, true, true, false);
    for (int s_ = 1; s_ < NT - 2; s_ += 2) { P3_GEN(s_, 1, true, true, true); P3_GEN(s_ + 1, 0, true, true, true); }
    P3_GEN(NT - 2, 1, true, true, true);
    P3_GEN(NT - 1, 0, false, true, true);
    P3_GEN(NT, 1, false, false, true);
#undef P2_TR
#undef P2_RD
#undef P2_MM
#undef P2_LW
#undef P2_PVALL
#undef P2_STEP
#undef P2_MAIN
#undef P3_GEN
#undef P3_QK
#undef P2_LW2
#undef P2_CH
#undef P2_PACK
#undef P2_DMA
#undef P2_DMAK
#undef P2_DMAV
    if (hi == 0) LS[wid * 32 + r32] = l_reg;
    __syncthreads();
    float rli[16];
#pragma unroll
    for (int r = 0; r < 16; ++r) { const int row = crow(r, hi); rli[r] = __builtin_amdgcn_rcpf(LS[wq * 32 + row] + LS[(wq + 4) * 32 + row]); }
    bf16* Ow = cur.O + (size_t)kh * SEQ_ * D + (size_t)(wq * QBLK) * D;
    char* ot = lds + wid * 8704;
#pragma unroll
    for (int r = 0; r < 16; ++r) { const int orow = crow(r, hi);
#pragma unroll
        for (int d0 = 0; d0 < 4; ++d0) { const float v = o[d0][r] * rli[r]; *(unsigned short*)(ot + orow * 272 + (d0 * 32 + r32) * 2) = (unsigned short)cvtpk_b(v, v); } }
    asm volatile("s_waitcnt lgkmcnt(0)" ::: "memory");
#pragma unroll
    for (int j = 0; j < 8; ++j) { const int row = 4 * j + (lane >> 4), ch = lane & 15;
        *(u32x4*)(Ow + (size_t)row * D + ch * 8) = *(const u32x4*)(ot + row * 272 + ch * 16); }
    __syncthreads();
}
#undef KSWZ
#undef SBAR
}

constexpr int NWAVES = 8, NTHR = NWAVES * 64;
constexpr int DM = 2048, NB = 4, SEQ = 8192, NMETA = 16;
constexpr int MTOK = NB * SEQ;
constexpr int MROWS = MTOK + 256;
constexpr int DIN = 9 * DM;
constexpr int PKV = 64 + SEQ;
constexpr int NCHK = SEQ / 64;
constexpr int NE = 32, TOPK = 4, DFF = 2048;
constexpr int NASSIGN = MTOK * TOPK;
constexpr int RSLOT = NASSIGN + NE * 256;
constexpr float RMS_EPS = 1e-6f;
constexpr float LAMBDA_INIT = 0.2f;

constexpr size_t MiB = 1u << 20, KiB = 1u << 10;
constexpr size_t WS_CTL = 0, CTL_ZERO_BYTES = 1 * MiB;
constexpr size_t WS_SM = 1 * MiB;
constexpr size_t SM_LB = WS_SM, SM_LAM = WS_SM + 8 * KiB, SM_BT = WS_SM + 9 * KiB, SM_RSTD = WS_SM + 32 * KiB;
constexpr size_t SM_AE = WS_SM + 256 * KiB, SM_AR = WS_SM + 768 * KiB, SM_AG = WS_SM + 1280 * KiB, SM_TS = WS_SM + 1792 * KiB;
constexpr size_t SM_ST = WS_SM + 2304 * KiB, SM_SR = WS_SM + 2848 * KiB, SM_SG = WS_SM + 3392 * KiB;
static_assert(SM_SG + (size_t)RSLOT * 4 <= 5 * MiB && SM_RSTD + (size_t)MTOK * 4 <= SM_AE && SM_BT + 8 * 352 * 4 <= SM_RSTD, "small tables");
constexpr size_t WS_WOUT = 5 * MiB, WS_WR = 13 * MiB, WS_WGU = 14 * MiB, WS_WDN = 270 * MiB, WS_HG8 = 398 * MiB;
constexpr size_t WS_WIN = 782 * MiB, WS_U = 854 * MiB;
constexpr size_t WS_Y = WS_U;
constexpr size_t WS_QH = 983 * MiB, WS_KH = 1111 * MiB, WS_VH = 1240 * MiB, WS_HQ = 1369 * MiB, WS_HK = 1498 * MiB, WS_HGT = 1627 * MiB, WS_HV = 1756 * MiB;
constexpr size_t WS_OG = 1885 * MiB, WS_GA = 2013 * MiB, WS_GH = 2141 * MiB;
constexpr size_t WS_OP = 2269 * MiB, WS_DS = 2525 * MiB, WS_DEC = 2781 * MiB, WS_END = 2785 * MiB;
constexpr size_t WS_H2 = WS_HK;
constexpr size_t WS_ACT = WS_QH, WS_YS = WS_HGT;
constexpr float W8_SCALE = 64.f, ACT8_SCALE = 4.f, YS8_SCALE = 16.f;
static_assert(WS_ACT + (size_t)RSLOT * DM * 2 <= WS_HGT && WS_YS + (size_t)RSLOT * DM * 2 <= WS_OP && WS_HG8 + (size_t)MROWS * DM <= 782 * MiB, "MoE overlays");
static_assert(WS_KH + (size_t)NB * 16 * PKV * 128 * 2 <= WS_VH && WS_U + (size_t)MROWS * DM * 2 <= WS_QH && WS_WIN + (size_t)DIN * DM * 2 <= WS_U, "d_ws map");
constexpr int CW_CNT = 64;
constexpr int CW_BAR = 4096;

constexpr int RING_BYTES = 131072;
constexpr int XCH_OFF = 131072;
constexpr int CTRL_OFF = 147456;
constexpr int LDS_BYTES = 151552;
constexpr int NPHASE = 11;
#ifndef MK_N_LAUNCHES
#define MK_N_LAUNCHES 1
#endif
constexpr int N_LAUNCHES = MK_N_LAUNCHES;
static_assert(N_LAUNCHES == 1 || N_LAUNCHES == NPHASE, "launch cuts");

#define GAS __attribute__((address_space(1)))
#define LAS __attribute__((address_space(3)))
typedef unsigned short bf16;
typedef unsigned v4u __attribute__((ext_vector_type(4)));
typedef unsigned v2u __attribute__((ext_vector_type(2)));
typedef float f32x4 __attribute__((ext_vector_type(4)));
typedef float f32x16 __attribute__((ext_vector_type(16)));
typedef short bf16x8 __attribute__((ext_vector_type(8)));
#define LDS_WAIT() asm volatile("s_waitcnt lgkmcnt(0)" ::: "memory")
#define VM_WAIT() asm volatile("s_waitcnt vmcnt(0)" ::: "memory")
__device__ __forceinline__ unsigned f2bf(float f) { unsigned u = __builtin_bit_cast(unsigned, f); return (u + 0x7fffu + ((u >> 16) & 1u)) >> 16; }
typedef float f32x2_t __attribute__((ext_vector_type(2))); typedef __bf16 bf16x2_t __attribute__((ext_vector_type(2)));
__device__ __forceinline__ unsigned pk2(float lo, float hi) { f32x2_t v = {lo, hi}; bf16x2_t b = __builtin_convertvector(v, bf16x2_t); return __builtin_bit_cast(unsigned, b); }
__device__ __forceinline__ unsigned pk4_fp8(float a, float b, float c, float d) { unsigned w = 0u; w = __builtin_amdgcn_cvt_pk_fp8_f32(a, b, w, false); w = __builtin_amdgcn_cvt_pk_fp8_f32(c, d, w, true); return w; }
__device__ __forceinline__ float bf_lo(unsigned u) { return __builtin_bit_cast(float, u << 16); }
__device__ __forceinline__ float bf_hi(unsigned u) { return __builtin_bit_cast(float, u & 0xffff0000u); }
__device__ __forceinline__ float bf2f(bf16 h) { return __builtin_bit_cast(float, (unsigned)h << 16); }
__device__ __forceinline__ float sigmoidf_(float x) { return __builtin_amdgcn_rcpf(1.f + __expf(-x)); }
__device__ __forceinline__ float wave_sum(float v) {
#pragma unroll
    for (int o = 1; o < 64; o <<= 1) v += __shfl_xor(v, o);
    return v;
}
#define XB_TMO      128
#define XB_XCNT(j)  (256  + 64 * (j))
#define XB_XSUB(j)  (1280 + 64 * (j))
#define XB_XGEN(j)  (2304 + 64 * (j))
#define XB_TOP      3328
#define XB_TOPGEN   3392
#define XCD_BAR_WORDS 3456
#define XB_SPIN_CAP (1u << 18)

__device__ __forceinline__ unsigned xb_ld(unsigned* p)              { return __hip_atomic_load(p, __ATOMIC_RELAXED, __HIP_MEMORY_SCOPE_AGENT); }
__device__ __forceinline__ unsigned xb_add(unsigned* p, unsigned v) { return __hip_atomic_fetch_add(p, v, __ATOMIC_RELAXED, __HIP_MEMORY_SCOPE_AGENT); }
__device__ __forceinline__ unsigned xb_xcc_id() { return (unsigned)__builtin_amdgcn_s_getreg((3 << 11) | 20) & 0xFu; }
#define XB_SPIN(cond, bar) do { unsigned _sp = 0; while (cond) { __builtin_amdgcn_s_sleep(1); \
    if ((++_sp & 255u) == 0u) { if (xb_ld(&(bar)[XB_TMO])) break; if (_sp > XB_SPIN_CAP) { atomicAdd(&(bar)[XB_TMO], 1u); break; } } } } while (0)

struct XcdBarrier {
    unsigned* bar; unsigned x;
    volatile LAS unsigned* st;
};

__device__ __forceinline__ XcdBarrier xcd_barrier_post(unsigned* bar, volatile LAS unsigned* st) {
    XcdBarrier b; b.bar = bar; b.x = xb_xcc_id(); b.st = st;
    if (threadIdx.x == 0) (void)xb_add(&bar[XB_XCNT(b.x)], 1u);
    return b;
}
__device__ __forceinline__ void xcd_barrier_complete(unsigned* bar, unsigned x, unsigned& nloc, unsigned& nx) {
    const unsigned G = gridDim.x * gridDim.y * gridDim.z;
    unsigned sum, cnt, mine, sp = 0u;
    for (;;) {
        sum = 0u; cnt = 0u; mine = 0u;
#pragma unroll
        for (unsigned j = 0; j < 16; ++j) { const unsigned c = xb_ld(&bar[XB_XCNT(j)]); sum += c; cnt += (c > 0u) ? 1u : 0u; mine = (j == x) ? c : mine; }
        if (sum == G) break;
        __builtin_amdgcn_s_sleep(1);
        if ((++sp & 255u) == 0u) { if (xb_ld(&bar[XB_TMO])) break; if (sp > XB_SPIN_CAP) { atomicAdd(&bar[XB_TMO], 1u); break; } }
    }
    nloc = mine > 0u ? mine : 1u; nx = cnt > 0u ? cnt : 1u;
}

__device__ __forceinline__ void xcd_barrier(const XcdBarrier& b) {
    asm volatile("s_waitcnt vmcnt(0)" ::: "memory");
    __syncthreads();
    if (threadIdx.x == 0) {
        unsigned* bar = b.bar;
        __builtin_amdgcn_s_waitcnt(0);
        unsigned nloc = b.st[0], nx = b.st[1];
        if (nloc == 0u) { xcd_barrier_complete(bar, b.x, nloc, nx); b.st[0] = nloc; b.st[1] = nx; }
        const unsigned old = xb_add(&bar[XB_XSUB(b.x)], 1u);
        const unsigned gen = old / nloc;
        if (old + 1u == (gen + 1u) * nloc) {
            __builtin_amdgcn_fence(__ATOMIC_RELEASE, "agent");
            asm volatile("s_waitcnt vmcnt(0)" ::: "memory");
            const unsigned og = xb_add(&bar[XB_TOP], 1u);
            const unsigned tg = og / nx;
            if (og + 1u == (tg + 1u) * nx) xb_add(&bar[XB_TOPGEN], 1u);
            else XB_SPIN(xb_ld(&bar[XB_TOPGEN]) == tg, bar);
            __builtin_amdgcn_fence(__ATOMIC_ACQUIRE, "agent");
            xb_add(&bar[XB_XGEN(b.x)], 1u);
            asm volatile("s_waitcnt vmcnt(0)" ::: "memory");
        } else {
            XB_SPIN(xb_ld(&bar[XB_XGEN(b.x)]) == gen, bar);
            __builtin_amdgcn_fence(__ATOMIC_ACQUIRE, "agent");
            asm volatile("s_waitcnt vmcnt(0)" ::: "memory");
        }
    }
    __syncthreads();
}


__device__ __forceinline__ void static_order(int L, int nM, int nN, int& pm, int& pn) {
    const int nwg = nM * nN, q = nwg / 8, xcd = L & 7, off = L >> 3; const int wgid = xcd * q + off;
    const int nig = 8 * nN, gid = wgid / nig, fm = gid * 8; pm = fm + ((wgid % nig) & 7); pn = (wgid % nig) >> 3;
}
struct SchedInProj {
    int G, c; const bf16* Bt;
    __device__ __forceinline__ bool next(int i, pg8::Unit& u) const {
        u.e = 0;
        const long L = (long)i * G + c; if (L >= 128 * 72) return false;
        static_order((int)L, 128, 72, u.pm, u.pn); u.aux = 0; return true;
    }
    __device__ __forceinline__ unsigned arow(const pg8::Unit& u, int r) const { return (unsigned)(u.pm * 256 + r); }
    __device__ __forceinline__ const void* bbase() const { return Bt; }
    __device__ __forceinline__ unsigned boff(const pg8::Unit& u) const { return (unsigned)u.pn * (256u * DM * 2u); }
};
struct SchedPlain {
    int G, c, nM, nN; const bf16* Bt;
    __device__ __forceinline__ bool next(int i, pg8::Unit& u) const {
        const long L = (long)i * G + c; if (L >= (long)nM * nN) return false;
        static_order((int)L, nM, nN, u.pm, u.pn); u.e = 0; u.aux = 0; return true;
    }
    __device__ __forceinline__ unsigned arow(const pg8::Unit& u, int r) const { return (unsigned)(u.pm * 256 + r); }
    __device__ __forceinline__ const void* bbase() const { return Bt; }
    __device__ __forceinline__ unsigned boff(const pg8::Unit& u) const { return (unsigned)u.pn * (256u * DM * 2u); }
};
struct SchedMoE {
    int G, c, npn; const LAS int* tstart; const unsigned char* W; size_t wstride, tilebytes; const int* slot_tok;
    __device__ __forceinline__ bool next(int i, pg8::Unit& u) const {
        const int L = i * G + c; if (L >= tstart[32] * npn) return false;
        int e = 0;
#pragma unroll 8
        for (int j = 1; j <= 32; ++j) e += (L >= tstart[j] * npn) ? 1 : 0;
        e = __builtin_amdgcn_readfirstlane(e);
        const int t0 = __builtin_amdgcn_readfirstlane(tstart[e]), t1 = __builtin_amdgcn_readfirstlane(tstart[e + 1]), w = L - t0 * npn, ne = t1 - t0;
        u.pn = w / ne; u.pm = t0 + w % ne; u.e = e; u.aux = 0; return true;
    }
    __device__ __forceinline__ unsigned arow(const pg8::Unit& u, int r) const { const int slot = u.pm * 256 + r; return slot_tok ? (unsigned)slot_tok[slot] : (unsigned)slot; }
    __device__ __forceinline__ const void* bbase() const { return W; }
    __device__ __forceinline__ unsigned boff(const pg8::Unit& u) const { return (unsigned)u.e * (unsigned)wstride + (unsigned)u.pn * (unsigned)tilebytes; }
};

__device__ __forceinline__ v4u rowperm(v4u w, int src4) { v4u r; r.x = (unsigned)__builtin_amdgcn_ds_bpermute(src4, (int)w.x); r.y = (unsigned)__builtin_amdgcn_ds_bpermute(src4, (int)w.y); r.z = (unsigned)__builtin_amdgcn_ds_bpermute(src4, (int)w.z); r.w = (unsigned)__builtin_amdgcn_ds_bpermute(src4, (int)w.w); return r; }
__device__ __forceinline__ v2u rowperm2(v2u w, int src4) { v2u r; r.x = (unsigned)__builtin_amdgcn_ds_bpermute(src4, (int)w.x); r.y = (unsigned)__builtin_amdgcn_ds_bpermute(src4, (int)w.y); return r; }
__device__ __forceinline__ f32x4 rowpermf(f32x4 w, int src4) { return __builtin_bit_cast(f32x4, rowperm(__builtin_bit_cast(v4u, w), src4)); }
#define ROWPERM_SETUP() const int src4_ = (((lane >> 2) + 16 * (lane & 3)) << 2), frp = lane >> 2, fqp = lane & 3; (void)src4_; (void)frp; (void)fqp

struct EpiInProj {
    static constexpr bool PERM = true;
    unsigned char* ws; const float *qg, *kg; LAS float* xch;
    __device__ __forceinline__ void st_hm(bf16* base, int slen, int poff, bool meta, int b, int s, int rl, int head16, int d0, v4u w) const {
        if (!meta) { *(v4u*)(base + ((size_t)(b * 16 + head16) * slen + poff + s) * 128 + d0) = w; }
        else if (rl < 16) {
#pragma unroll
            for (int bb = 0; bb < NB; ++bb) *(v4u*)(base + ((size_t)(bb * 16 + head16) * slen + 48 + rl) * 128 + d0) = w; }
    }
    __device__ __forceinline__ void prefetch(const pg8::Unit&, int, int) const {}
    __device__ __forceinline__ void operator()(const pg8::f32x4 (&acc)[2][2][4][2], const pg8::Unit& u, int wr, int wc, int fr, int fq, int wid, int lane) const {
        asm volatile("" : "+v"(fr), "+v"(fq));
        const int grp = u.pn >> 3, pl = u.pn & 7; const bool meta = u.aux != 0;
        const int d0 = 32 * wc + 8 * fq, b = u.pm >> 5, sb = (u.pm & 31) * 256;
        ROWPERM_SETUP(); const int d0p = 32 * wc + 8 * fqp;
        if (grp <= 1) {
            f32x4 g0, g1;
            if (grp == 0) { g0 = *(const f32x4*)(qg + d0); g1 = *(const f32x4*)(qg + d0 + 4); } else { g0 = *(const f32x4*)(kg + d0); g1 = *(const f32x4*)(kg + d0 + 4); }
            bf16* const QH = (bf16*)(ws + WS_QH); bf16* const KH = (bf16*)(ws + WS_KH);
#pragma unroll
            for (int ai = 0; ai < 2; ++ai)
#pragma unroll
                for (int m = 0; m < 4; ++m)
#pragma unroll
                    for (int bj = 0; bj < 2; ++bj) {
                        const f32x4 a = acc[ai][bj][m][0], c = acc[ai][bj][m][1];
                        float s = (a[0] * a[0] + a[1] * a[1]) + (a[2] * a[2] + a[3] * a[3]) + (c[0] * c[0] + c[1] * c[1]) + (c[2] * c[2] + c[3] * c[3]);
                        s += __shfl_xor(s, 16); s += __shfl_xor(s, 32);
                        const int rl = 128 * ai + 64 * wr + 16 * m + fr;
                        if (fq == 0) xch[(rl * 2 + bj) * 4 + wc] = s;
                    }
            LDS_WAIT(); __builtin_amdgcn_s_barrier(); asm volatile("" ::: "memory");
#pragma unroll
            for (int ai = 0; ai < 2; ++ai)
#pragma unroll
                for (int m = 0; m < 4; ++m)
#pragma unroll
                    for (int bj = 0; bj < 2; ++bj) {
                        const int rl = 128 * ai + 64 * wr + 16 * m + fr;
                        const f32x4 p = *(const LAS f32x4*)(xch + (rl * 2 + bj) * 4);
                        const float rs = __builtin_amdgcn_rsqf(((p[0] + p[1]) + (p[2] + p[3])) * (1.f / 128.f) + RMS_EPS);
                        const float rq = grp == 0 ? rs * (att::SCALE * 1.4426950408889634f) : rs;
                        const f32x4 a = acc[ai][bj][m][0] * rq * g0, c = acc[ai][bj][m][1] * rq * g1;
                        v4u w; w.x = pk2(a[0], a[1]); w.y = pk2(a[2], a[3]); w.z = pk2(c[0], c[1]); w.w = pk2(c[2], c[3]);
                        w = rowperm(w, src4_); const int rlp = 128 * ai + 64 * wr + 16 * m + frp;
                        if (grp == 0) { if (!meta) *(v4u*)(QH + ((size_t)(b * 16 + 2 * pl + bj) * SEQ + sb + rlp) * 128 + d0p) = w; }
                        else st_hm(KH, PKV, 64, meta, b, sb + rlp, rlp, 2 * pl + bj, d0p, w);
                    }
        } else if (grp == 4) {
            unsigned char* dst = ws + WS_HGT;
#pragma unroll
            for (int ai = 0; ai < 2; ++ai)
#pragma unroll
                for (int m = 0; m < 4; ++m)
#pragma unroll
                    for (int bj = 0; bj < 2; ++bj) {
                        const int rlp = 128 * ai + 64 * wr + 16 * m + frp; const f32x4 a = acc[ai][bj][m][0], c = acc[ai][bj][m][1];
                        unsigned q[8];
#pragma unroll
                        for (int j = 0; j < 4; ++j) { q[j] = (unsigned)(sigmoidf_(a[j]) * 255.f + 0.5f); q[4 + j] = (unsigned)(sigmoidf_(c[j]) * 255.f + 0.5f); }
                        const v2u w = rowperm2((v2u){q[0] | (q[1] << 8) | (q[2] << 16) | (q[3] << 24), q[4] | (q[5] << 8) | (q[6] << 16) | (q[7] << 24)}, src4_);
                        if (!meta) *(v2u*)(dst + ((size_t)(b * 16 + 2 * pl + bj) * PKV + 64 + sb + rlp) * 128 + d0p) = w;
                        else if (rlp < 16) {
#pragma unroll
                            for (int bb = 0; bb < NB; ++bb) *(v2u*)(dst + ((size_t)(bb * 16 + 2 * pl + bj) * PKV + 48 + rlp) * 128 + d0p) = w; }
                    }
        } else if (grp <= 5) {
            if (!(meta && grp == 3)) {
            bf16* dst = (bf16*)(ws + (grp == 2 ? WS_VH : grp == 3 ? WS_HQ : WS_HV));
#pragma unroll
            for (int ai = 0; ai < 2; ++ai)
#pragma unroll
                for (int m = 0; m < 4; ++m)
#pragma unroll
                    for (int bj = 0; bj < 2; ++bj) {
                        const int rlp = 128 * ai + 64 * wr + 16 * m + frp; const f32x4 a = acc[ai][bj][m][0], c = acc[ai][bj][m][1];
                        v4u w; w.x = pk2(a[0], a[1]); w.y = pk2(a[2], a[3]); w.z = pk2(c[0], c[1]); w.w = pk2(c[2], c[3]);
                        w = rowperm(w, src4_);
                        st_hm(dst, PKV, 64, meta, b, sb + rlp, rlp, 2 * pl + bj, d0p, w);
                    }
            }
        } else if (!meta && grp == 6) {
            bf16* dst = (bf16*)(ws + WS_OG);
#pragma unroll
            for (int ai = 0; ai < 2; ++ai)
#pragma unroll
                for (int m = 0; m < 4; ++m)
#pragma unroll
                    for (int bj = 0; bj < 2; ++bj) {
                        const int rlp = 128 * ai + 64 * wr + 16 * m + frp; const f32x4 a = acc[ai][bj][m][0], c = acc[ai][bj][m][1];
                        v4u w; w.x = pk2(a[0], a[1]); w.y = pk2(a[2], a[3]); w.z = pk2(c[0], c[1]); w.w = pk2(c[2], c[3]);
                        w = rowperm(w, src4_);
                        *(v4u*)(dst + (size_t)(u.pm * 256 + rlp) * DM + 256 * pl + 128 * bj + d0p) = w;
                    }
        } else if (!meta) {
            unsigned char* dst = ws + (grp == 7 ? WS_GA : WS_GH);
#pragma unroll
            for (int ai = 0; ai < 2; ++ai)
#pragma unroll
                for (int m = 0; m < 4; ++m)
#pragma unroll
                    for (int bj = 0; bj < 2; ++bj) {
                        const int rlp = 128 * ai + 64 * wr + 16 * m + frp; const f32x4 a = acc[ai][bj][m][0], c = acc[ai][bj][m][1];
                        unsigned q[8];
#pragma unroll
                        for (int j = 0; j < 4; ++j) { q[j] = (unsigned)(sigmoidf_(a[j]) * 255.f + 0.5f); q[4 + j] = (unsigned)(sigmoidf_(c[j]) * 255.f + 0.5f); }
                        const v2u w = rowperm2((v2u){q[0] | (q[1] << 8) | (q[2] << 16) | (q[3] << 24), q[4] | (q[5] << 8) | (q[6] << 16) | (q[7] << 24)}, src4_);
                        *(v2u*)(dst + (size_t)(u.pm * 256 + rlp) * DM + 256 * pl + 128 * bj + d0p) = w;
                    }
        }
    }
};
struct EpiOutProj {
    static constexpr bool PERM = true;
    const float* x; bf16* h2;
    __device__ __forceinline__ void prefetch(const pg8::Unit&, int, int) const {}
    __device__ __forceinline__ void operator()(const pg8::f32x4 (&acc)[2][2][4][2], const pg8::Unit& u, int wr, int wc, int fr, int fq, int wid, int lane) const {
        asm volatile("" : "+v"(fr), "+v"(fq));
        ROWPERM_SETUP();
        const int row0 = u.pm * 256 + wr * 64 + frp, col0 = u.pn * 256 + wc * 32 + 8 * fqp;
#pragma unroll
        for (int ai = 0; ai < 2; ++ai) {
            f32x4 xv[4][2][2];
#pragma unroll
            for (int m = 0; m < 4; ++m) { const size_t off = (size_t)(row0 + ai * 128 + m * 16) * DM + col0;
#pragma unroll
                for (int bj = 0; bj < 2; ++bj) { xv[m][bj][0] = *(const f32x4*)(x + off + bj * 128); xv[m][bj][1] = *(const f32x4*)(x + off + bj * 128 + 4); } }
#pragma unroll
            for (int m = 0; m < 4; ++m) { const size_t off = (size_t)(row0 + ai * 128 + m * 16) * DM + col0;
#pragma unroll
                for (int bj = 0; bj < 2; ++bj) {
                    const f32x4 a = xv[m][bj][0] + rowpermf(acc[ai][bj][m][0], src4_), c = xv[m][bj][1] + rowpermf(acc[ai][bj][m][1], src4_);
                    *(v4u*)(h2 + off + bj * 128) = (v4u){pk2(a[0], a[1]), pk2(a[2], a[3]), pk2(c[0], c[1]), pk2(c[2], c[3])}; } }
            asm volatile("" ::: "memory"); }
    }
};
struct EpiGateUp {
    static constexpr bool PERM = true;
    const float* bgu; const float* slot_rstd; unsigned char* ACT; LAS unsigned char* xch;
    __device__ __forceinline__ void prefetch(const pg8::Unit& u, int wid, int lane) const {
        const float* src = wid < 4 ? slot_rstd + u.pm * 256 + wid * 64 : bgu + (size_t)u.e * (2 * DFF) + 128 * u.pn + (wid < 6 ? (wid - 4) * 64 : DFF + (wid - 6) * 64);
        __builtin_amdgcn_global_load_lds((const unsigned*)(src + lane), (LAS unsigned*)(xch + u.par * 2048 + wid * 256), 4, 0, 0);
    }
    __device__ __forceinline__ void operator()(const pg8::f32x4 (&acc)[2][2][4][2], const pg8::Unit& u, int wr, int wc, int fr, int fq, int wid, int lane) const {
        asm volatile("" : "+v"(fr), "+v"(fq));
        ROWPERM_SETUP();
        const int d0 = 32 * wc + 8 * fq; const LAS float* xp = (const LAS float*)(xch + u.par * 2048);
        const f32x4 bg0 = *(const LAS f32x4*)(xp + 256 + d0), bg1 = *(const LAS f32x4*)(xp + 256 + d0 + 4), bl0 = *(const LAS f32x4*)(xp + 384 + d0), bl1 = *(const LAS f32x4*)(xp + 384 + d0 + 4);
#pragma unroll
        for (int ai = 0; ai < 2; ++ai)
#pragma unroll
            for (int m = 0; m < 4; ++m) {
                const float rs = xp[128 * ai + 64 * wr + 16 * m + fr] * (1.f / W8_SCALE);
                f32x4 o[2];
#pragma unroll
                for (int n = 0; n < 2; ++n) { const f32x4 g = acc[ai][0][m][n] * rs + (n ? bg1 : bg0), l = acc[ai][1][m][n] * rs + (n ? bl1 : bl0);
#pragma unroll
                    for (int j = 0; j < 4; ++j) { const float xg = fminf(g[j], 7.f), xl = fminf(fmaxf(l[j], -7.f), 7.f);
                        o[n][j] = (xg * __builtin_amdgcn_rcpf(1.f + __builtin_amdgcn_exp2f(xg * (-1.702f * 1.4426950408889634f)))) * __builtin_fmaf(xl, ACT8_SCALE, ACT8_SCALE); } }
                const v2u w8 = rowperm2((v2u){pk4_fp8(o[0][0], o[0][1], o[0][2], o[0][3]), pk4_fp8(o[1][0], o[1][1], o[1][2], o[1][3])}, src4_);
                *(v2u*)(ACT + (size_t)(u.pm * 256 + 128 * ai + 64 * wr + 16 * m + frp) * DFF + 128 * u.pn + 32 * wc + 8 * fqp) = w8;
            }
    }
};
struct EpiDown {
    static constexpr bool PERM = true;
    const float* bdn; const float* slot_gate; unsigned char* YS; LAS unsigned char* xch;
    __device__ __forceinline__ void prefetch(const pg8::Unit& u, int wid, int lane) const {
        const float* src = wid < 4 ? slot_gate + u.pm * 256 + wid * 64 : bdn + (size_t)u.e * DM + 256 * u.pn + (wid - 4) * 64;
        __builtin_amdgcn_global_load_lds((const unsigned*)(src + lane), (LAS unsigned*)(xch + u.par * 2048 + wid * 256), 4, 0, 0);
    }
    __device__ __forceinline__ void operator()(const pg8::f32x4 (&acc)[2][2][4][2], const pg8::Unit& u, int wr, int wc, int fr, int fq, int wid, int lane) const {
        asm volatile("" : "+v"(fr), "+v"(fq));
        ROWPERM_SETUP();
        const int d0 = 32 * wc + 8 * fq; const LAS float* xp = (const LAS float*)(xch + u.par * 2048);
        f32x4 bv[2][2];
#pragma unroll
        for (int bj = 0; bj < 2; ++bj) { bv[bj][0] = *(const LAS f32x4*)(xp + 256 + 128 * bj + d0); bv[bj][1] = *(const LAS f32x4*)(xp + 256 + 128 * bj + d0 + 4); }
#pragma unroll
        for (int ai = 0; ai < 2; ++ai)
#pragma unroll
            for (int m = 0; m < 4; ++m) {
                const float gt = xp[128 * ai + 64 * wr + 16 * m + fr] * YS8_SCALE;
#pragma unroll
                for (int bj = 0; bj < 2; ++bj) { const f32x4 a = (acc[ai][bj][m][0] * (1.f / (W8_SCALE * ACT8_SCALE)) + bv[bj][0]) * gt, c = (acc[ai][bj][m][1] * (1.f / (W8_SCALE * ACT8_SCALE)) + bv[bj][1]) * gt;
                    const v2u w = {pk4_fp8(a[0], a[1], a[2], a[3]), pk4_fp8(c[0], c[1], c[2], c[3])};
                    *(v2u*)(YS + (size_t)(u.pm * 256 + 128 * ai + 64 * wr + 16 * m + frp) * DM + 256 * u.pn + 128 * bj + 32 * wc + 8 * fqp) = rowperm2(w, src4_); }
            }
    }
};

template <int NAI, int NM>
struct EpiStoreOnly {
    static constexpr bool PERM = true;
    bf16* O;
    __device__ __forceinline__ void prefetch(const pg8::Unit&, int, int) const {}
    __device__ __forceinline__ void operator()(const pg8::f32x4 (&acc)[2][2][4][2], const pg8::Unit& u, int wr, int wc, int fr, int fq, int wid, int lane) const {
        asm volatile("" : "+v"(fr), "+v"(fq));
        ROWPERM_SETUP();
#pragma unroll
        for (int ai = 0; ai < 2; ++ai)
#pragma unroll
            for (int m = 0; m < 4; ++m) {
#pragma unroll
                for (int bj = 0; bj < 2; ++bj) { const f32x4 a = acc[ai][bj][m][0], c = acc[ai][bj][m][1];
                    if (ai < NAI && m < NM) { v4u w; w.x = pk2(a[0], a[1]); w.y = pk2(a[2], a[3]); w.z = pk2(c[0], c[1]); w.w = pk2(c[2], c[3]);
                        *(v4u*)(O + (size_t)(u.pm * 256 + 128 * ai + 64 * wr + 16 * m + frp) * DM + 256 * u.pn + 128 * bj + 32 * wc + 8 * fqp) = rowperm(w, src4_); }
                    else { asm volatile("" :: "v"(a), "v"(c)); } }
            }
    }
};
struct EpiNull {
    static constexpr bool PERM = true;
    __device__ __forceinline__ void prefetch(const pg8::Unit&, int, int) const {}
    __device__ __forceinline__ void operator()(const pg8::f32x4 (&acc)[2][2][4][2], const pg8::Unit& u, int wr, int wc, int fr, int fq, int wid, int lane) const {
#pragma unroll
        for (int ai = 0; ai < 2; ++ai)
#pragma unroll
            for (int bj = 0; bj < 2; ++bj)
#pragma unroll
                for (int m = 0; m < 4; ++m)
#pragma unroll
                    for (int n = 0; n < 2; ++n) asm volatile("" :: "v"(acc[ai][bj][m][n]));
    }
};

__device__ __forceinline__ void p0_transpose_item(const float* W, int ldw, bf16* WT, int k0, int n0, size_t dst_row0, LAS float* scr, int lane) {
    float v[32];
#pragma unroll
    for (int i = 0; i < 32; ++i) { const int kk = 2 * i + (lane >> 5); v[i] = W[(size_t)(k0 + kk) * ldw + n0 + (lane & 31)]; }
#pragma unroll
    for (int i = 0; i < 32; ++i) { const int kk = 2 * i + (lane >> 5); scr[kk * 33 + (lane & 31)] = v[i]; }
    LDS_WAIT(); asm volatile("" ::: "memory");
    const int c = lane & 7;
#pragma unroll
    for (int j = 0; j < 4; ++j) { const int n = (lane >> 3) + 8 * j; const LAS float* s = scr + (8 * c) * 33 + n;
        v4u o; o.x = pk2(s[0 * 33], s[1 * 33]); o.y = pk2(s[2 * 33], s[3 * 33]); o.z = pk2(s[4 * 33], s[5 * 33]); o.w = pk2(s[6 * 33], s[7 * 33]);
        *(v4u*)(WT + (dst_row0 + n) * DM + k0 + 8 * c) = o; }
    LDS_WAIT(); asm volatile("" ::: "memory");
}
__device__ __forceinline__ void p0_transpose_item_fp8(const float* W, int ldw, unsigned char* WT, int k0, int n0, size_t dst_row0, float scale, LAS float* scr, int lane) {
    float v[32];
#pragma unroll
    for (int i = 0; i < 32; ++i) { const int kk = 2 * i + (lane >> 5); v[i] = W[(size_t)(k0 + kk) * ldw + n0 + (lane & 31)]; }
#pragma unroll
    for (int i = 0; i < 32; ++i) { const int kk = 2 * i + (lane >> 5); scr[kk * 33 + (lane & 31)] = v[i] * scale; }
    LDS_WAIT(); asm volatile("" ::: "memory");
    const int c = lane & 7;
#pragma unroll
    for (int j = 0; j < 4; ++j) { const int n = (lane >> 3) + 8 * j; const LAS float* s = scr + (8 * c) * 33 + n;
        *(v2u*)(WT + (dst_row0 + n) * DM + k0 + 8 * c) = (v2u){pk4_fp8(s[0 * 33], s[1 * 33], s[2 * 33], s[3 * 33]), pk4_fp8(s[4 * 33], s[5 * 33], s[6 * 33], s[7 * 33])}; }
    LDS_WAIT(); asm volatile("" ::: "memory");
}
__device__ __forceinline__ void rms_row_to_bf16(const float* xrow, const float* gain, bf16* orow, int lane) {
    const f32x4* xr = (const f32x4*)xrow + lane; const f32x4* gr = (const f32x4*)gain + lane;
    f32x4 v[8]; float s = 0.f;
#pragma unroll
    for (int j = 0; j < 8; ++j) { v[j] = xr[64 * j]; s += (v[j][0] * v[j][0] + v[j][1] * v[j][1]) + (v[j][2] * v[j][2] + v[j][3] * v[j][3]); }
    const float rs = __builtin_amdgcn_rsqf(wave_sum(s) * (1.f / DM) + RMS_EPS);
    v2u* o8 = (v2u*)orow + lane;
#pragma unroll
    for (int j = 0; j < 8; ++j) { const f32x4 g = gr[64 * j]; v2u w; w.x = pk2(v[j][0] * rs * g[0], v[j][1] * rs * g[1]); w.y = pk2(v[j][2] * rs * g[2], v[j][3] * rs * g[3]); o8[64 * j] = w; }
}
__device__ __forceinline__ int t5_bucket(int n) {
    if (n < 16) return n;
    const int l = 16 + (int)(__builtin_logf((float)n / 16.f) / 2.0794415416798357f * 16.f);
    return l < 31 ? l : 31;
}
struct P0Args { const float *x, *meta, *rel_bias, *lb_logits, *norm1, *w_in, *diff_lambda, *w_out, *router_w, *w_gu, *w_dn, *qg, *kg; unsigned char* ws; };
__device__ __forceinline__ void p0_prologue(const P0Args& a, LAS unsigned char* lds, int vcu, int G, int tid) {
    const int lane = tid & 63, wave = __builtin_amdgcn_readfirstlane(tid >> 6);
    const int gw = vcu * NWAVES + wave, NGW = G * NWAVES; const long gid = (long)vcu * NTHR + tid, NG = (long)G * NTHR;
    unsigned char* ws = a.ws;
    float* lbp = (float*)(ws + SM_LB);
    for (long i = gid; i < DM; i += NG) lbp[i] = sigmoidf_(a.lb_logits[i] - a.lb_logits[DM + i]);
    if (gw == 0) { const float* lv = a.diff_lambda; float s1 = lv[lane] * lv[128 + lane] + lv[64 + lane] * lv[192 + lane], s2 = lv[256 + lane] * lv[384 + lane] + lv[320 + lane] * lv[448 + lane];
        s1 = wave_sum(s1); s2 = wave_sum(s2); if (lane == 0) *(float*)(ws + SM_LAM) = __expf(s1) - __expf(s2) + LAMBDA_INIT;
        float qm = fmaxf(fabsf(a.qg[lane]), fabsf(a.qg[64 + lane])), km = fmaxf(fabsf(a.kg[lane]), fabsf(a.kg[64 + lane])), bm = 0.f;
#pragma unroll
        for (int j = 0; j < 4; ++j) { const int e = lane + 64 * j; bm = fmaxf(bm, fabsf(a.rel_bias[e] - a.rel_bias[31 * 8 + (e & 7)])); }
#pragma unroll
        for (int o = 1; o < 64; o <<= 1) { qm = fmaxf(qm, __shfl_xor(qm, o)); km = fmaxf(km, __shfl_xor(km, o)); bm = fmaxf(bm, __shfl_xor(bm, o)); }
        if (lane == 0) *(int*)(ws + SM_LAM + 4) = (11.3137085f * qm * km + bm < 60.f) ? 1 : 0; }
    { float* bt = (float*)(ws + SM_BT);
      for (long i = gid; i < 8 * att::BT_LEN; i += NG) { const int h = (int)i / att::BT_LEN, rel = (int)i % att::BT_LEN - att::BT_OFF;
          bt[i] = (rel >= 0 && rel < 113) ? (a.rel_bias[t5_bucket(rel) * 8 + h] - a.rel_bias[31 * 8 + h]) * 1.4426950408889634f : 0.f; } }
    { int* st = (int*)(ws + SM_ST); float* sr = (float*)(ws + SM_SR); float* sg = (float*)(ws + SM_SG);
      for (long i = gid; i < RSLOT; i += NG) { st[i] = MTOK; sr[i] = 0.f; sg[i] = 0.f; } }
    { const v4u z = {0u, 0u, 0u, 0u}, big = {0xffffffffu, 0xffffffffu, 0xffffffffu, 0xffffffffu};
      for (long i = gid; i < 4L * 64 * 768; i += NG) { const int tsel = (int)(i / (64 * 768)), r = (int)(i % (64 * 768)), bh = r / 768, q = r % 768;
          const size_t base = tsel == 0 ? WS_KH : tsel == 1 ? WS_VH : tsel == 2 ? WS_HGT : WS_HV;
          if (tsel != 2) *(v4u*)(ws + base + ((size_t)bh * PKV * 128) * 2 + (size_t)q * 16) = z;
          else if (q < 384) *(v4u*)(ws + base + (size_t)bh * PKV * 128 + (size_t)q * 16) = big; }
      for (long i = gid; i < 240L * 256; i += NG) *(v4u*)(ws + WS_U + (size_t)(MTOK + 16) * DM * 2 + (size_t)i * 16) = z; }
    for (int m = gw; m < MTOK + NMETA; m += NGW) rms_row_to_bf16(m < MTOK ? a.x + (size_t)m * DM : a.meta + (size_t)(m - MTOK) * DM, a.norm1, (bf16*)(ws + WS_U) + (size_t)m * DM, lane);
    LAS float* scr = (LAS float*)(lds + wave * 17408);
    constexpr int I_IN = 16 * (DIN / 32), I_OUT = 16 * 64, I_R = 16, I_GU = 16 * 128, I_DN = 16 * 64;
    constexpr int NITEMS = I_IN + I_OUT + I_R + NE * (I_GU + I_DN);
#define P0_DECODE(it_, src_, ldw_, dst_, f8_) do { int r = (it_); \
        if (r < I_IN) { const int nb = r % (DIN / 32), kb = r / (DIN / 32); src_ = a.w_in + (size_t)(128 * kb) * DIN + 32 * nb; ldw_ = DIN; dst_ = ws + WS_WIN + ((size_t)32 * nb * DM + 128 * kb) * 2; f8_ = false; } \
        else if ((r -= I_IN) < I_OUT) { const int nb = r % 64, kb = r / 64; src_ = a.w_out + (size_t)(128 * kb) * DM + 32 * nb; ldw_ = DM; dst_ = ws + WS_WOUT + ((size_t)32 * nb * DM + 128 * kb) * 2; f8_ = false; } \
        else if ((r -= I_OUT) < I_R) { src_ = a.router_w + (size_t)(128 * r) * NE; ldw_ = NE; dst_ = ws + WS_WR + (size_t)(128 * r) * 2; f8_ = false; } \
        else { r -= I_R; const int e = r / (I_GU + I_DN); r -= e * (I_GU + I_DN); \
            if (r < I_GU) { const int nb = r % 128, kb = r / 128, n0 = 32 * nb, nn = n0 & (DFF - 1); const size_t drow = (size_t)e * (2 * DFF) + (size_t)(nn >> 7) * 256 + (n0 >= DFF ? 128 : 0) + (nn & 127);     \
                src_ = a.w_gu + (size_t)e * DM * 2 * DFF + (size_t)(128 * kb) * (2 * DFF) + n0; ldw_ = 2 * DFF; dst_ = ws + WS_WGU + drow * DM + 128 * kb; f8_ = true; } \
            else { r -= I_GU; const int nb = r % 64, kb = r / 64; src_ = a.w_dn + (size_t)e * DFF * DM + (size_t)(128 * kb) * DM + 32 * nb; ldw_ = DM; dst_ = ws + WS_WDN + ((size_t)e * DM + 32 * nb) * DM + 128 * kb; f8_ = true; } } } while (0)
#define P0_LOAD(v_, src_, ldw_) do { _Pragma("unroll") for (int i = 0; i < 16; ++i) { const f32x4 t_ = *(const f32x4*)((src_) + (size_t)(8 * i + (lane >> 3)) * (ldw_) + 4 * (lane & 7)); v_[4 * i] = t_[0]; v_[4 * i + 1] = t_[1]; v_[4 * i + 2] = t_[2]; v_[4 * i + 3] = t_[3]; } } while (0)
    int it = gw;
    if (it < NITEMS) {
        const float* csrc; int cldw; unsigned char* cdst; bool cf8; float v[64];
        P0_DECODE(it, csrc, cldw, cdst, cf8); P0_LOAD(v, csrc, cldw);
        for (;;) {
            const int itn = it + NGW; const bool more = itn < NITEMS;
            const float* nsrc = csrc; int nldw = cldw; unsigned char* ndst = cdst; bool nf8 = cf8; float vn[64];
            if (more) { P0_DECODE(itn, nsrc, nldw, ndst, nf8); P0_LOAD(vn, nsrc, nldw); }
            const float sc = cf8 ? W8_SCALE : 1.f;
#pragma unroll
            for (int i = 0; i < 64; ++i) scr[(8 * (i >> 2) + (lane >> 3)) * 33 + (i >> 2) * 4 + 4 * (lane & 7) + (i & 3)] = v[i] * sc;
            LDS_WAIT(); asm volatile("" ::: "memory");
            const int c = lane >> 2;
#pragma unroll
            for (int j = 0; j < 8; ++j) { const int n = (lane & 3) + 4 * j; const LAS float* q = scr + (8 * c) * 33 + c * 4 + n;
                const float x0 = q[0], x1 = q[33], x2 = q[66], x3 = q[99], x4 = q[132], x5 = q[165], x6 = q[198], x7 = q[231];
                if (cf8) *(v2u*)(cdst + (size_t)n * DM + 8 * c) = (v2u){pk4_fp8(x0, x1, x2, x3), pk4_fp8(x4, x5, x6, x7)};
                else *(v4u*)(cdst + ((size_t)n * DM + 8 * c) * 2) = (v4u){pk2(x0, x1), pk2(x2, x3), pk2(x4, x5), pk2(x6, x7)}; }
            LDS_WAIT(); asm volatile("" ::: "memory");
            if (!more) break;
            it = itn; csrc = nsrc; cldw = nldw; cdst = ndst; cf8 = nf8;
#pragma unroll
            for (int i = 0; i < 64; ++i) v[i] = vn[i];
        }
    }
#undef P0_DECODE
#undef P0_LOAD
}

typedef LAS bf16x8 lbf8; typedef LAS v4u lv4u;
#define MFMA32(a, b, c) __builtin_amdgcn_mfma_f32_32x32x16_bf16(a, b, c, 0, 0, 0)
#define MFMA16(a, b, c) __builtin_amdgcn_mfma_f32_16x16x32_bf16(a, b, c, 0, 0, 0)
__device__ __forceinline__ int crow32(int r, int hi) { return (r & 3) + 8 * (r >> 2) + 4 * hi; }
__device__ __forceinline__ void hgrn_a_dma(const unsigned char* HF, const bf16* HV, int bh, int c, LAS unsigned char* raw, int wid, int lane) {
    typedef __attribute__((address_space(3))) unsigned lds_u32;
    const size_t t0 = ((size_t)bh * PKV + 64 * c) * 128; const int q = (wid * 128 + lane) * 8;
    __builtin_amdgcn_global_load_lds((const unsigned*)(HF + t0 + (wid * 64 + lane) * 16), (lds_u32*)(raw + wid * 1024), 16, 0, 0);
#pragma unroll
    for (int i = 0; i < 2; ++i)
        __builtin_amdgcn_global_load_lds((const unsigned*)(HV + t0 + q + i * 512), (lds_u32*)(raw + 16384 + wid * 2048 + i * 1024), 16, 0, 0);
}
__device__ __forceinline__ void hgrn_a_phase(const unsigned char* HF, const float* lbv, const bf16* HV, bf16* DS, float* DEC, LAS unsigned char* lds, int tid, int vcu, int G) {
    LAS float* part = (LAS float*)lds; LAS bf16* KT = (LAS bf16*)(lds + 2048); LAS bf16* VT = (LAS bf16*)(lds + 2048 + 18432);
    LAS unsigned char* raw = lds + 40960;
    LAS unsigned char* ot = lds + 73728;
    const int k = tid & 127, sq = tid >> 7, lane = tid & 63, w = __builtin_amdgcn_readfirstlane(tid >> 6);
    int u = vcu; if (u >= 64 * NCHK) return;
    hgrn_a_dma(HF, HV, u / NCHK, u % NCHK, raw, w, lane);
    for (;;) {
        const int bh = u / NCHK, c = u % NCHK, un = u + G; const bool more = un < 64 * NCHK;
        __syncthreads();
        float g[16], kv[16]; unsigned vv[16];
        const float lbk = lbv[(bh & 15) * 128 + k];
#pragma unroll
        for (int i = 0; i < 16; ++i) { const float sg = (float)raw[(16 * sq + i) * 128 + k] * (1.f / 255.f); g[i] = lbk + (1.f - lbk) * sg; kv[i] = (1.f - lbk) * (1.f - sg);
            vv[i] = *(const LAS bf16*)(raw + 16384 + ((16 * sq + i) * 128 + k) * 2); }
        float run = 1.f;
#pragma unroll
        for (int i = 15; i >= 0; --i) { const float f = g[i]; g[i] = run; run *= f; }
        part[sq * 128 + k] = run;
        __syncthreads();
        float suf = 1.f, tot = 1.f;
#pragma unroll
        for (int j = 0; j < 4; ++j) { const float p = part[j * 128 + k]; tot *= p; suf *= (j > sq) ? p : 1.f; }
        unsigned kw[8], vw[8];
#pragma unroll
        for (int i = 0; i < 8; ++i) { kw[i] = pk2(kv[2 * i] * (suf * g[2 * i]), kv[2 * i + 1] * (suf * g[2 * i + 1])); vw[i] = vv[2 * i] | (vv[2 * i + 1] << 16); }
        *(lv4u*)(KT + k * 72 + 16 * sq) = (v4u){kw[0], kw[1], kw[2], kw[3]}; *(lv4u*)(KT + k * 72 + 16 * sq + 8) = (v4u){kw[4], kw[5], kw[6], kw[7]};
        *(lv4u*)(VT + k * 72 + 16 * sq) = (v4u){vw[0], vw[1], vw[2], vw[3]}; *(lv4u*)(VT + k * 72 + 16 * sq + 8) = (v4u){vw[4], vw[5], vw[6], vw[7]};
        if (sq == 0) DEC[((size_t)bh * NCHK + c) * 128 + k] = tot;
        __syncthreads();
        if (more) hgrn_a_dma(HF, HV, un / NCHK, un % NCHK, raw, w, lane);
        const int k0 = 32 * (w & 3), vb = 64 * (w >> 2), li = lane & 31, hi = lane >> 5;
        f32x16 a0 = {}, a1 = {};
#pragma unroll
        for (int ks = 0; ks < 4; ++ks) { const bf16x8 av = *(const lbf8*)(KT + (k0 + li) * 72 + 16 * ks + 8 * hi);
            const bf16x8 b0 = *(const lbf8*)(VT + (vb + li) * 72 + 16 * ks + 8 * hi), b1 = *(const lbf8*)(VT + (vb + 32 + li) * 72 + 16 * ks + 8 * hi);
            a0 = MFMA32(av, b0, a0); a1 = MFMA32(av, b1, a1); }
        LAS unsigned char* ow = ot + w * 5120;
#pragma unroll
        for (int j = 0; j < 4; ++j) { *(LAS v2u*)(ow + li * 80 + (8 * j + 4 * hi) * 2) = (v2u){pk2(a0[4 * j], a0[4 * j + 1]), pk2(a0[4 * j + 2], a0[4 * j + 3])};
            *(LAS v2u*)(ow + (32 + li) * 80 + (8 * j + 4 * hi) * 2) = (v2u){pk2(a1[4 * j], a1[4 * j + 1]), pk2(a1[4 * j + 2], a1[4 * j + 3])}; }
        LDS_WAIT();
        bf16* dst = DS + ((size_t)bh * NCHK + c) * 16384 + (size_t)vb * 128 + k0;
#pragma unroll
        for (int j = 0; j < 4; ++j) { const int v = 16 * j + (lane >> 2), ch = lane & 3; *(v4u*)(dst + (size_t)v * 128 + ch * 8) = *(const LAS v4u*)(ow + v * 80 + ch * 16); }
        if (!more) break;
        u = un;
    }
    __syncthreads();
}
__device__ __forceinline__ void hgrn_b_scan(bf16* DS, const float* DEC, long gid, long NG) {
    for (long idx = gid; idx < 64L * 128 * 16; idx += NG) {
        const int bh = (int)(idx >> 11), rem = (int)(idx & 2047), v = rem >> 4, k8 = (rem & 15) * 8;
        float S[8];
#pragma unroll
        for (int j = 0; j < 8; ++j) S[j] = 0.f;
        bf16* p = DS + ((size_t)bh * NCHK * 128 + v) * 128 + k8; const float* dp = DEC + (size_t)bh * NCHK * 128 + k8;
        for (int c = 0; c < NCHK; c += 4) {
            v4u d[4]; f32x4 e0[4], e1[4];
#pragma unroll
            for (int u = 0; u < 4; ++u) { d[u] = *(const v4u*)(p + (size_t)(c + u) * 16384); e0[u] = *(const f32x4*)(dp + (c + u) * 128); e1[u] = *(const f32x4*)(dp + (c + u) * 128 + 4); }
#pragma unroll
            for (int u = 0; u < 4; ++u) {
                S[0] = e0[u][0] * S[0] + bf_lo(d[u].x); S[1] = e0[u][1] * S[1] + bf_hi(d[u].x); S[2] = e0[u][2] * S[2] + bf_lo(d[u].y); S[3] = e0[u][3] * S[3] + bf_hi(d[u].y);
                S[4] = e1[u][0] * S[4] + bf_lo(d[u].z); S[5] = e1[u][1] * S[5] + bf_hi(d[u].z); S[6] = e1[u][2] * S[6] + bf_lo(d[u].w); S[7] = e1[u][3] * S[7] + bf_hi(d[u].w);
                *(v4u*)(p + (size_t)(c + u) * 16384) = (v4u){pk2(S[0], S[1]), pk2(S[2], S[3]), pk2(S[4], S[5]), pk2(S[6], S[7])}; }
        }
    }
}
struct HcArgs { const bf16 *HQ; const unsigned char* HF; const bf16 *HV, *DS, *OP, *OG; const unsigned char *GA, *GH; bf16* Y; const float *subln, *hgn, *lbv; float lam; };
#define LDS_BARRIER() do { asm volatile("s_waitcnt lgkmcnt(0)" ::: "memory"); __builtin_amdgcn_s_barrier(); asm volatile("" ::: "memory"); } while (0)
__device__ __forceinline__ void hgrn_c_unit(const HcArgs& A, int b, int c, int hp, LAS unsigned char* lds, int tid) {
    LAS bf16* QI = (LAS bf16*)lds;
    LAS bf16* VT = (LAS bf16*)(lds + 17408);
    LAS bf16* AT = (LAS bf16*)(lds + 35840);
    LAS bf16* ST = (LAS bf16*)(lds + 45056);
    LAS bf16* QR = (LAS bf16*)(lds + 79872);
    LAS bf16* KR = (LAS bf16*)(lds + 97280);
    LAS float* OT = (LAS float*)(lds + 79872);
    LAS float* part = (LAS float*)(lds + 140800);
    const int lane = tid & 63, w = __builtin_amdgcn_readfirstlane(tid >> 6);
    const int t8 = tid >> 3, j8 = tid & 7;
    const size_t m = (size_t)b * SEQ + 64 * (c - 1) + t8;
    unsigned rf[16], rq[16], rv[16]; v4u rsp[4]; float rlb;
#define HC_LOAD_A(HH_) do { const int bh_ = b * 16 + (HH_); const size_t r0_ = ((size_t)bh_ * PKV + 64 * c + 16 * (tid >> 7)) * 128 + (tid & 127); rlb = A.lbv[(HH_) * 128 + (tid & 127)]; \
        _Pragma("unroll") for (int i = 0; i < 16; ++i) { rf[i] = A.HF[r0_ + i * 128]; rq[i] = A.HQ[r0_ + i * 128]; rv[i] = A.HV[r0_ + i * 128]; } \
        const bf16* sp0_ = A.DS + ((size_t)bh_ * NCHK + (c - 1)) * 16384; \
        _Pragma("unroll") for (int j = 0; j < 4; ++j) rsp[j] = *(const v4u*)(sp0_ + (size_t)(tid + 512 * j) * 8); } while (0)
    HC_LOAD_A(2 * hp);
    asm volatile("" ::: "memory");
    float an[32];
    { float ss = 0.f;
#pragma unroll
      for (int half = 0; half < 2; ++half) {
          const bf16* p0 = A.OP + ((size_t)(b * 32 + (2 * hp) * 2 + half) * SEQ + 64 * (c - 1) + t8) * 128 + 16 * j8;
          const bf16* p1 = A.OP + ((size_t)(b * 32 + (2 * hp + 1) * 2 + half) * SEQ + 64 * (c - 1) + t8) * 128 + 16 * j8;
          const v4u x0 = *(const v4u*)p0, x1 = *(const v4u*)(p0 + 8), y0 = *(const v4u*)p1, y1 = *(const v4u*)(p1 + 8);
          const unsigned xs[8] = {x0.x, x0.y, x0.z, x0.w, x1.x, x1.y, x1.z, x1.w}, ys[8] = {y0.x, y0.y, y0.z, y0.w, y1.x, y1.y, y1.z, y1.w};
#pragma unroll
          for (int i = 0; i < 8; ++i) { const float a0 = bf_lo(xs[i]) - A.lam * bf_lo(ys[i]), a1 = bf_hi(xs[i]) - A.lam * bf_hi(ys[i]); an[16 * half + 2 * i] = a0; an[16 * half + 2 * i + 1] = a1; ss += a0 * a0 + a1 * a1; } }
      ss += __shfl_xor(ss, 1); ss += __shfl_xor(ss, 2); ss += __shfl_xor(ss, 4);
      const float rs = __builtin_amdgcn_rsqf(ss * (1.f / 256.f) + RMS_EPS) * (1.f - LAMBDA_INIT);
#pragma unroll
      for (int half = 0; half < 2; ++half)
#pragma unroll
          for (int q = 0; q < 4; ++q) { const f32x4 g = *(const f32x4*)(A.subln + 128 * half + 16 * j8 + 4 * q);
#pragma unroll
              for (int i = 0; i < 4; ++i) an[16 * half + 4 * q + i] *= rs * g[i]; } }
#pragma unroll
    for (int hi2 = 0; hi2 < 2; ++hi2) {
        const int hh = 2 * hp + hi2, bh = b * 16 + hh;
        const int k = tid & 127, sq = tid >> 7;
        float g[16], qv[16], kv[16]; unsigned vv[16];
        const float lbk = rlb;
#pragma unroll
        for (int i = 0; i < 16; ++i) { const float sg = (float)rf[i] * (1.f / 255.f), qx = bf2f((bf16)rq[i]);
            g[i] = lbk + (1.f - lbk) * sg; kv[i] = (1.f - lbk) * (1.f - sg); qv[i] = qx * sigmoidf_(qx); vv[i] = rv[i]; }
        v4u sp[4];
#pragma unroll
        for (int j = 0; j < 4; ++j) sp[j] = rsp[j];
        float run = 1.f;
#pragma unroll
        for (int i = 0; i < 16; ++i) { run *= g[i]; g[i] = run; }
        part[sq * 128 + k] = run;
        *(lv4u*)(AT + t8 * 72 + 8 * j8) = (v4u){0u, 0u, 0u, 0u};
        LDS_BARRIER();
        const float p0 = part[k], p1 = part[128 + k], p2 = part[256 + k];
        const float offp = sq == 0 ? 1.f : sq == 1 ? p0 : sq == 2 ? p0 * p1 : p0 * p1 * p2;
        const float m0 = sq == 0 ? p0 : sq == 1 ? p1 : p2, m1 = sq == 0 ? p1 : p2;
        const float rat1 = m0, rat2 = m0 * m1, rat3 = m0 * m1 * p2;
#pragma unroll
        for (int i = 0; i < 16; i += 2) { const int t = 16 * sq + i;
            const float r0 = qv[i] * g[i], r1 = qv[i + 1] * g[i + 1];
            const unsigned wr_ = pk2(r0, r1), wi_ = pk2(r0 * offp, r1 * offp);
            QR[t * 136 + k] = (bf16)wr_; QR[(t + 1) * 136 + k] = (bf16)(wr_ >> 16);
            QI[t * 136 + k] = (bf16)wi_; QI[(t + 1) * 136 + k] = (bf16)(wi_ >> 16); }
#pragma unroll
        for (int i = 0; i < 16; ++i) kv[i] *= __builtin_amdgcn_rcpf(g[i]);
#pragma unroll
        for (int ip = 0; ip < 4; ++ip) if (ip >= sq) {
            const int d = ip - sq; const float rt = d == 0 ? 1.f : d == 1 ? rat1 : d == 2 ? rat2 : rat3; const int rb = ip == 0 ? 0 : ip == 1 ? 16 : ip == 2 ? 48 : 96;
#pragma unroll
            for (int i = 0; i < 16; i += 2) { const unsigned w_ = pk2(kv[i] * rt, kv[i + 1] * rt);
                KR[(rb + 16 * sq + i) * 136 + k] = (bf16)w_; KR[(rb + 16 * sq + i + 1) * 136 + k] = (bf16)(w_ >> 16); } }
        { unsigned vw[8];
#pragma unroll
          for (int i = 0; i < 8; ++i) vw[i] = vv[2 * i] | (vv[2 * i + 1] << 16);
          *(lv4u*)(VT + k * 72 + 16 * sq) = (v4u){vw[0], vw[1], vw[2], vw[3]}; *(lv4u*)(VT + k * 72 + 16 * sq + 8) = (v4u){vw[4], vw[5], vw[6], vw[7]}; }
#pragma unroll
        for (int j = 0; j < 4; ++j) { const int q4 = tid + 512 * j; *(lv4u*)(ST + (q4 >> 4) * 136 + (q4 & 15) * 8) = sp[j]; }
        LDS_BARRIER();
        const size_t idx = m * DM + 256 * hp + 128 * hi2 + 16 * j8;
        const v4u og0 = *(const v4u*)(A.OG + idx), og1 = *(const v4u*)(A.OG + idx + 8), ga0 = *(const v4u*)(A.GA + idx), gh0 = *(const v4u*)(A.GH + idx);
        if (hi2 == 0) HC_LOAD_A(hh + 1);
#pragma unroll
        for (int rep = 0; rep < 2; ++rep) { const int tl = w + 8 * rep;
            if (tl < 10) { const int ip = tl >= 6 ? 3 : tl >= 3 ? 2 : tl >= 1 ? 1 : 0, jp = tl - (ip == 3 ? 6 : ip == 2 ? 3 : ip == 1 ? 1 : 0), rb = ip == 0 ? 0 : ip == 1 ? 16 : ip == 2 ? 48 : 96;
                const int r = lane & 15, q = lane >> 4; f32x4 sa = {0.f, 0.f, 0.f, 0.f};
#pragma unroll
                for (int ks = 0; ks < 4; ++ks) { const bf16x8 av = *(const lbf8*)(QR + (16 * ip + r) * 136 + 32 * ks + 8 * q), bv = *(const lbf8*)(KR + (rb + 16 * jp + r) * 136 + 32 * ks + 8 * q); sa = MFMA16(av, bv, sa); }
#pragma unroll
                for (int i = 0; i < 4; ++i) { const float val = (jp == ip && r > 4 * q + i) ? 0.f : sa[i]; AT[(16 * ip + 4 * q + i) * 72 + 16 * jp + r] = (bf16)f2bf(val); } } }
        LDS_BARRIER();
        { const int t0 = 32 * (w & 1), v0 = 32 * (w >> 1), li = lane & 31, hi = lane >> 5; f32x16 o = {};
#pragma unroll
          for (int ks = 0; ks < 8; ++ks) o = MFMA32(*(const lbf8*)(QI + (t0 + li) * 136 + 16 * ks + 8 * hi), *(const lbf8*)(ST + (v0 + li) * 136 + 16 * ks + 8 * hi), o);
#pragma unroll
          for (int ks = 0; ks < 4; ++ks) o = MFMA32(*(const lbf8*)(AT + (t0 + li) * 72 + 16 * ks + 8 * hi), *(const lbf8*)(VT + (v0 + li) * 72 + 16 * ks + 8 * hi), o);
#pragma unroll
          for (int r = 0; r < 16; ++r) OT[(t0 + crow32(r, hi)) * 132 + v0 + li] = o[r]; }
        LDS_BARRIER();
        { f32x4 ov[4]; float ss = 0.f;
#pragma unroll
          for (int q = 0; q < 4; ++q) { ov[q] = *(const LAS f32x4*)(OT + t8 * 132 + 16 * j8 + 4 * q); ss += (ov[q][0] * ov[q][0] + ov[q][1] * ov[q][1]) + (ov[q][2] * ov[q][2] + ov[q][3] * ov[q][3]); }
          ss += __shfl_xor(ss, 1); ss += __shfl_xor(ss, 2); ss += __shfl_xor(ss, 4);
          const float rs = __builtin_amdgcn_rsqf(ss * (1.f / 128.f) + RMS_EPS);
          const unsigned ogs[8] = {og0.x, og0.y, og0.z, og0.w, og1.x, og1.y, og1.z, og1.w}, gas[4] = {ga0.x, ga0.y, ga0.z, ga0.w}, ghs[4] = {gh0.x, gh0.y, gh0.z, gh0.w};
          unsigned yw[8];
#pragma unroll
          for (int i = 0; i < 8; ++i) { const f32x4 gn = *(const f32x4*)(A.hgn + 16 * j8 + 4 * (i >> 1));
              const float o0 = ov[i >> 1][(2 * i) & 3] * rs * gn[(2 * i) & 3], o1 = ov[i >> 1][(2 * i + 1) & 3] * rs * gn[(2 * i + 1) & 3];
              const float og0_ = bf_lo(ogs[i]), og1_ = bf_hi(ogs[i]);
              const float sa0 = (float)((gas[i >> 1] >> (16 * (i & 1))) & 0xffu) * (1.f / 255.f), sa1 = (float)((gas[i >> 1] >> (16 * (i & 1) + 8)) & 0xffu) * (1.f / 255.f);
              const float sh0 = (float)((ghs[i >> 1] >> (16 * (i & 1))) & 0xffu) * (1.f / 255.f), sh1 = (float)((ghs[i >> 1] >> (16 * (i & 1) + 8)) & 0xffu) * (1.f / 255.f);
              const float y0 = sa0 * an[16 * hi2 + 2 * i] + sh0 * o0 * (og0_ * sigmoidf_(og0_)), y1 = sa1 * an[16 * hi2 + 2 * i + 1] + sh1 * o1 * (og1_ * sigmoidf_(og1_));
              yw[i] = pk2(y0, y1); }
          *(v4u*)(A.Y + idx) = (v4u){yw[0], yw[1], yw[2], yw[3]}; *(v4u*)(A.Y + idx + 8) = (v4u){yw[4], yw[5], yw[6], yw[7]}; }
        LDS_BARRIER();
    }
}

__device__ __forceinline__ void meta_proj(unsigned char* ws, const float* kg, LAS float* xch, int j, int tid) {
    const int lane = tid & 63, w = __builtin_amdgcn_readfirstlane(tid >> 6), r = lane & 15, q = lane >> 4;
    const int gi = j >> 4, head16 = j & 15, grp = gi == 0 ? 1 : gi == 1 ? 2 : gi == 2 ? 4 : 5;
    const bf16* Wr = (const bf16*)(ws + WS_WIN) + (size_t)(grp * DM + head16 * 128 + w * 16 + r) * DM + 8 * q;
    const bf16* Ur = (const bf16*)(ws + WS_U) + (size_t)(MTOK + r) * DM + 8 * q;
    f32x4 acc = {0.f, 0.f, 0.f, 0.f};
#pragma unroll 16
    for (int ks = 0; ks < 64; ++ks) acc = MFMA16(*(const bf16x8*)(Wr + 32 * ks), *(const bf16x8*)(Ur + 32 * ks), acc);
    const int d = w * 16 + 4 * q;
    if (gi == 0) {
        float ss = (acc[0] * acc[0] + acc[1] * acc[1]) + (acc[2] * acc[2] + acc[3] * acc[3]);
        ss += __shfl_xor(ss, 16); ss += __shfl_xor(ss, 32);
        if (q == 0) xch[w * 16 + r] = ss;
        __syncthreads();
        float tot = 0.f;
#pragma unroll
        for (int i = 0; i < 8; ++i) tot += xch[i * 16 + r];
        const float rs = __builtin_amdgcn_rsqf(tot * (1.f / 128.f) + RMS_EPS); const f32x4 g = *(const f32x4*)(kg + d);
        acc = acc * rs * g; }
    if (gi == 2) {
        unsigned qv[4];
#pragma unroll
        for (int i = 0; i < 4; ++i) qv[i] = (unsigned)(sigmoidf_(acc[i]) * 255.f + 0.5f);
        const unsigned wv = qv[0] | (qv[1] << 8) | (qv[2] << 16) | (qv[3] << 24);
#pragma unroll
        for (int bb = 0; bb < NB; ++bb) *(unsigned*)(ws + WS_HGT + ((size_t)(bb * 16 + head16) * PKV + 48 + r) * 128 + d) = wv;
    } else {
        bf16* dst = (bf16*)(ws + (gi == 0 ? WS_KH : gi == 1 ? WS_VH : WS_HV));
        const v2u wv = {pk2(acc[0], acc[1]), pk2(acc[2], acc[3])};
#pragma unroll
        for (int bb = 0; bb < NB; ++bb) *(v2u*)(dst + ((size_t)(bb * 16 + head16) * PKV + 48 + r) * 128 + d) = wv; }
}
struct P6Args { const bf16* h2; const float *norm2, *router_b; const bf16* WR; unsigned char* HG8; float* rstd2; int *assign_e, *assign_rank; float* assign_gate; unsigned* gcnt; };
__device__ __forceinline__ void p6_router(const P6Args& A, LAS unsigned char* lds, LAS unsigned char* ctrl, int vcu, int G, int tid) {
    LAS unsigned* lcount = (LAS unsigned*)(ctrl + 512); LAS unsigned* lbase = (LAS unsigned*)(ctrl + 640);
    const int lane = tid & 63, w = __builtin_amdgcn_readfirstlane(tid >> 6), r = lane & 15, q = lane >> 4;
    if (vcu == 0 && tid < 128) *(v4u*)(A.HG8 + (size_t)MTOK * DM + tid * 16) = (v4u){0u, 0u, 0u, 0u};
    LAS unsigned char* wl = lds; LAS unsigned char* gl = lds + 135168;
    if (vcu < MTOK / 128) {
        for (int i = tid; i < 32 * 256; i += NTHR) { const int row = i >> 8, c16 = i & 255; *(LAS v4u*)(wl + row * 4112 + c16 * 16) = *(const v4u*)(A.WR + (size_t)row * DM + c16 * 8); }
        for (int i = tid; i < 512; i += NTHR) *(LAS v4u*)(gl + i * 16) = *(const v4u*)((const unsigned char*)A.norm2 + i * 16);
    }
    for (int grp = vcu; grp < MTOK / 128; grp += G) {
        if (tid < 32) lcount[tid] = 0u;
        __syncthreads();
        const int m0 = grp * 128 + w * 16; const size_t rowoff = (size_t)(m0 + r) * DM;
        f32x4 acc0 = {0.f, 0.f, 0.f, 0.f}, acc1 = {0.f, 0.f, 0.f, 0.f}; float ss = 0.f;
        v4u hc[8], hn[8];
#pragma unroll
        for (int i = 0; i < 8; ++i) hc[i] = *(const v4u*)(A.h2 + rowoff + 32 * i + 8 * q);
        for (int kb = 0; kb < 8; ++kb) {
            { const int kn = kb < 7 ? kb + 1 : kb;
#pragma unroll
              for (int i = 0; i < 8; ++i) hn[i] = *(const v4u*)(A.h2 + rowoff + 32 * (8 * kn + i) + 8 * q); }
            asm volatile("" ::: "memory");
#pragma unroll
            for (int i = 0; i < 8; ++i) { const int k = 32 * (8 * kb + i) + 8 * q; const v4u hw = hc[i];
                const f32x4 h0 = {bf_lo(hw.x), bf_hi(hw.x), bf_lo(hw.y), bf_hi(hw.y)}, h1 = {bf_lo(hw.z), bf_hi(hw.z), bf_lo(hw.w), bf_hi(hw.w)}, g0 = *(const LAS f32x4*)(gl + k * 4), g1 = *(const LAS f32x4*)(gl + k * 4 + 16);
                const bf16x8 b0 = *(const lbf8*)(wl + r * 4112 + k * 2), b1 = *(const lbf8*)(wl + (16 + r) * 4112 + k * 2);
                ss += (h0[0] * h0[0] + h0[1] * h0[1]) + (h0[2] * h0[2] + h0[3] * h0[3]) + (h1[0] * h1[0] + h1[1] * h1[1]) + (h1[2] * h1[2] + h1[3] * h1[3]);
                const v4u xw = {pk2(h0[0] * g0[0], h0[1] * g0[1]), pk2(h0[2] * g0[2], h0[3] * g0[3]), pk2(h1[0] * g1[0], h1[1] * g1[1]), pk2(h1[2] * g1[2], h1[3] * g1[3])};
                *(v2u*)(A.HG8 + rowoff + k) = (v2u){pk4_fp8(h0[0] * g0[0], h0[1] * g0[1], h0[2] * g0[2], h0[3] * g0[3]), pk4_fp8(h1[0] * g1[0], h1[1] * g1[1], h1[2] * g1[2], h1[3] * g1[3])};
                const bf16x8 xa = __builtin_bit_cast(bf16x8, xw);
                acc0 = MFMA16(b0, xa, acc0); acc1 = MFMA16(b1, xa, acc1);
                if (i & 1) asm volatile("" ::: "memory"); }
#pragma unroll
            for (int i = 0; i < 8; ++i) hc[i] = hn[i];
        }
        ss += __shfl_xor(ss, 16); ss += __shfl_xor(ss, 32);
        const float rs = __builtin_amdgcn_rsqf(ss * (1.f / DM) + RMS_EPS);
        if (q == 0) A.rstd2[m0 + r] = rs;
        float l[8];
        { const f32x4 rb0 = *(const f32x4*)(A.router_b + 4 * q), rb1 = *(const f32x4*)(A.router_b + 16 + 4 * q);
#pragma unroll
          for (int i = 0; i < 4; ++i) { l[i] = acc0[i] * rs + rb0[i]; l[4 + i] = acc1[i] * rs + rb1[i]; } }
        unsigned used = 0u; float tv[4]; int te[4];
#pragma unroll
        for (int kk = 0; kk < 4; ++kk) {
            float bv = -__builtin_inff(); int be = 64;
#pragma unroll
            for (int j = 0; j < 8; ++j) { const int ej = (j < 4 ? 0 : 16) + 4 * q + (j & 3); const bool ok = !((used >> j) & 1u) && l[j] > bv; bv = ok ? l[j] : bv; be = ok ? ej : be; }
#pragma unroll
            for (int o = 16; o <= 32; o <<= 1) { const float ov = __shfl_xor(bv, o); const int oe = __shfl_xor(be, o); const bool tk = ov > bv || (ov == bv && oe < be); bv = tk ? ov : bv; be = tk ? oe : be; }
            tv[kk] = bv; te[kk] = be;
            if (((be & 15) >> 2) == q) used |= 1u << (((be >> 4) << 2) + (be & 3));
        }
        const float e1 = __expf(tv[1] - tv[0]), e2 = __expf(tv[2] - tv[0]), e3 = __expf(tv[3] - tv[0]), inv = 1.f / (1.f + e1 + e2 + e3);
        const int es = q == 0 ? te[0] : q == 1 ? te[1] : q == 2 ? te[2] : te[3];
        const float gs = (q == 0 ? 1.f : q == 1 ? e1 : q == 2 ? e2 : e3) * inv;
        const unsigned lrank = __hip_atomic_fetch_add((unsigned*)(lcount + es), 1u, __ATOMIC_RELAXED, __HIP_MEMORY_SCOPE_WORKGROUP);
        __syncthreads();
        if (tid < 32) lbase[tid] = __hip_atomic_fetch_add(A.gcnt + tid, (unsigned)lcount[tid], __ATOMIC_RELAXED, __HIP_MEMORY_SCOPE_AGENT);
        __syncthreads();
        const int a = (m0 + r) * 4 + q;
        A.assign_e[a] = es; A.assign_rank[a] = (int)(lbase[es] + lrank); A.assign_gate[a] = gs;
        __syncthreads();
    }
}
__device__ __forceinline__ void moe_tstart(const unsigned* gcnt, LAS int* tstart, int tid) {
    if (tid == 0) { int s = 0;
        for (int e = 0; e < NE; ++e) { tstart[e] = s; s += (int)((__hip_atomic_load(gcnt + e, __ATOMIC_RELAXED, __HIP_MEMORY_SCOPE_AGENT) + 255u) >> 8); }
        tstart[NE] = s; }
    __syncthreads();
}

namespace att {
struct Tensors { const bf16* Q; const bf16* K; const bf16* V; bf16* O; const float* bt; };
__device__ __forceinline__ BlockRef<bf16, bf16> mkref(const Tensors& T, int id, int pass) {
    const int grp = id >> 6, w = id & 63, b = grp >> 3, h = grp & 7, sub = w >> 4, map = sub >> 1, half = sub & 1, y = w & 15, qb = pass ? 31 - y : y;
    BlockRef<bf16, bf16> r;
    r.Q = T.Q + ((size_t)(b * 16 + 2 * h + map) * SEQ_ + (size_t)qb * QB) * D;
    r.K = T.K + (size_t)(b * 16 + 2 * h + map) * PKV_ * D;
    r.V = T.V + (size_t)(b * 16 + 2 * h + half) * PKV_ * D;
    r.O = T.O + ((size_t)(b * 32 + (2 * h + map) * 2 + half) * SEQ_ + (size_t)qb * QB) * D;
    r.P0 = 64 + qb * QB; r.bt = T.bt + h * BT_LEN;
    return r;
}
__device__ __forceinline__ int item_id(int i, int c, int G) {
    if (G == 256) return i < 8 ? (c & 7) * 256 + i * 32 + (c >> 3) : -1;
    const long L = (long)i * G + c; return L < 2048 ? (int)L : -1;
}
template <bool FIXM>
__device__ __forceinline__ void attn_phase(char* lds, const Tensors& T, int G, int c) {
    constexpr int W = 1 << 30;
    int i = 0, id = item_id(0, c, G); if (id < 0) return;
    int pass = 0;
    BlockRef<bf16, bf16> cur = mkref(T, id, 0);
    Seam<bf16> S;
    causal_swa_prime<bf16, bf16>(cur, W, lds, S);
    for (;;) {
        const int idn = item_id(i + 1, c, G);
        const bool more_pass = pass == 0, more_item = idn >= 0, last = !more_pass && !more_item;
        const BlockRef<bf16, bf16> nxt = last ? cur : (more_pass ? mkref(T, id, 1) : mkref(T, idn, 0));
        causal_swa_block<bf16, bf16, FIXM>(cur, nxt, PKV_, W, lds, S);
        if (last) break;
        cur = nxt; if (more_pass) pass = 1; else { pass = 0; id = idn; ++i; }
    }
}
__device__ __forceinline__ BlockRef2 mkref2(const Tensors& T, int id, int pass) {
    const int mi = id >> 5, y = id & 31, qb = pass ? 63 - y : y, b = mi >> 4, hm = mi & 15, h = hm >> 1;
    BlockRef2 r;
    r.Q = T.Q + ((size_t)mi * SEQ_ + (size_t)qb * P2_QB) * D;
    r.K = T.K + (size_t)mi * PKV_ * D;
    r.V = T.V + (size_t)(b * 16 + 2 * h) * PKV_ * D;
    r.O = T.O + ((size_t)(b * 32 + hm * 2) * SEQ_ + (size_t)qb * P2_QB) * D;
    r.P0 = 64 + qb * P2_QB; r.bt = T.bt + h * BT_LEN;
    return r;
}
__device__ __forceinline__ void attn_phase2(char* lds, const Tensors& T, int G, int c) {
    for (int j = 0;; ++j) { const int id = item_id(j >> 1, c, G); if (id < 0) break;
        paired_block(mkref2(T, id, j & 1), lds); }
}
}

struct Args { const float* in[19]; float* out; unsigned char* ws; int ph_lo, ph_hi, li, pad; };
#define ARG(k) argp(args, k)
__device__ __forceinline__ unsigned char* wsp(const Args& a) { int k = 0; asm volatile("" : "+s"(k)); return (&a.ws)[k]; }
__device__ __forceinline__ float* outp(const Args& a) { int k = 0; asm volatile("" : "+s"(k)); return (&a.out)[k]; }
__device__ __forceinline__ const float* argp(const Args& a, int k) { asm volatile("" : "+s"(k)); return a.in[k]; }
__global__ void __launch_bounds__(NTHR, 2) hyb_fwd(Args args) {
    extern __shared__ __attribute__((aligned(16))) unsigned char lds_raw[];
    LAS unsigned char* lds = (LAS unsigned char*)lds_raw;
    const int G = gridDim.x, bx = blockIdx.x;
    { unsigned char* ws0 = args.ws;
      int t0_ = threadIdx.x; asm volatile("" : "+v"(t0_));
      for (int u = t0_; u < (LDS_BYTES - CTRL_OFF) / 4; u += NTHR) ((LAS unsigned*)(lds + CTRL_OFF))[u] = 0u;
      __syncthreads(); (void)ws0; }
    XcdBarrier bar; bar.bar = (unsigned*)(args.ws + WS_CTL) + CW_BAR; bar.x = 0; bar.st = nullptr;
    if (N_LAUNCHES == 1) bar = xcd_barrier_post((unsigned*)(args.ws + WS_CTL) + CW_BAR, (volatile LAS unsigned*)(lds + CTRL_OFF));
#define GRID_BAR() do { if (N_LAUNCHES == 1) xcd_barrier(bar); } while (0)
    const int lo = args.ph_lo, hi = args.ph_hi;
#ifndef PH_MASK
#define PH_MASK 0x7ff
#endif
#define IN(k) (((PH_MASK >> (k)) & 1) && lo <= (k) && (k) < hi)
#define BOTH(k) (IN(k) && IN((k) + 1))
#ifndef PROBE_DUP
#define PROBE_DUP 0
#endif
#ifndef STAGGER_TICKS
#define STAGGER_TICKS 0
#endif
#define REP(k) for (int rep_ = 0; rep_ < 1 + ((PROBE_DUP >> (k)) & 1); ++rep_)
#define PHASE_LOCALS() int tid_ = threadIdx.x; asm volatile("" : "+v"(tid_)); const int tid = tid_, lane = tid & 63, wave = __builtin_amdgcn_readfirstlane(tid >> 6); (void)lane; (void)wave; \
    const int vcu = (G % 8 == 0) ? (bx % 8) * (G / 8) + bx / 8 : bx; (void)vcu; unsigned char* ws = wsp(args); (void)ws; \
    const int gw = vcu * NWAVES + wave, NGW = G * NWAVES; const long gid = (long)vcu * NTHR + tid, NG = (long)G * NTHR; (void)gw; (void)NGW; (void)gid; (void)NG
#define QH ((bf16*)(ws + WS_QH))
#define KH ((bf16*)(ws + WS_KH))
#define VH ((bf16*)(ws + WS_VH))
#define HQ ((bf16*)(ws + WS_HQ))
#define HK ((bf16*)(ws + WS_HK))
#define HGT ((const unsigned char*)(ws + WS_HGT))
#define HV ((bf16*)(ws + WS_HV))
#define OG ((bf16*)(ws + WS_OG))
#define GA ((const unsigned char*)(ws + WS_GA))
#define GH ((const unsigned char*)(ws + WS_GH))
#define OP ((bf16*)(ws + WS_OP))
#define DS ((bf16*)(ws + WS_DS))
#define DEC ((float*)(ws + WS_DEC))
#define GCNT ((unsigned*)(ws + WS_CTL) + CW_CNT)
#define TSTART ((LAS int*)(lds + CTRL_OFF + 256))
#define OUTP outp(args)

    if (IN(0)) { PHASE_LOCALS();
        P0Args a{ARG(0), ARG(1), ARG(2), ARG(3), ARG(4), ARG(5), ARG(8), ARG(11), ARG(13), ARG(15), ARG(17), ARG(6), ARG(7), ws};
        REP(0) p0_prologue(a, lds, vcu, G, tid);
        if (BOTH(0)) GRID_BAR();
    }
    if (IN(1)) { PHASE_LOCALS();
        SchedInProj S{G, bx, (const bf16*)(ws + WS_WIN)};
        EpiInProj E{ws, ARG(6), ARG(7), (LAS float*)(lds + XCH_OFF)};
        REP(1) pg8::gemm_phase<EpiInProj, SchedInProj, false>(lds, (const bf16*)(ws + WS_U), DM, S, E, (unsigned)(bx * STAGGER_TICKS) / (unsigned)G);
        if (bx < 64) meta_proj(ws, ARG(7), (LAS float*)(lds + XCH_OFF), bx, tid);
#if (PROBE_DUP >> 12) & 1
        { EpiNull EN; pg8::gemm_phase<EpiNull, SchedInProj, false>(lds, (const bf16*)(ws + WS_U), DM, S, EN); }
#endif
        if (BOTH(1)) GRID_BAR();
    }
    if (IN(2)) { PHASE_LOCALS();
        REP(11) hgrn_a_phase(HGT, (const float*)(ws + SM_LB), HV, DS, DEC, lds, tid, vcu, G);
        const att::Tensors T{QH, KH, VH, OP, (const float*)(ws + SM_BT)};
        { int fx = __builtin_amdgcn_readfirstlane(*(const int*)(ws + SM_LAM + 4)), g2 = G, c2 = bx; asm volatile("" : "+s"(fx), "+s"(g2), "+s"(c2));
          REP(2) if (fx) att::attn_phase2((char*)lds_raw, T, g2, c2);
          asm volatile("" : "+s"(fx), "+s"(g2), "+s"(c2));
          if (!fx) { const att::Tensors T2{QH, KH, VH, OP, (const float*)(ws + SM_BT)}; att::attn_phase<false>((char*)lds_raw, T2, g2, c2); } }
        if (BOTH(2)) GRID_BAR();
    }
    if (IN(3)) { PHASE_LOCALS(); hgrn_b_scan(DS, DEC, gid, NG); if (BOTH(3)) GRID_BAR(); }
    if (IN(4)) { PHASE_LOCALS();
        const HcArgs A{HQ, HGT, HV, DS, OP, OG, GA, GH, (bf16*)(ws + WS_Y), ARG(9), ARG(10), (const float*)(ws + SM_LB), *(const float*)(ws + SM_LAM)};
        REP(4) for (int u = vcu; u < NB * NCHK * 8; u += G) { const int hp = u & 7, c = ((u >> 3) % NCHK) + 1, b = (u >> 3) / NCHK; hgrn_c_unit(A, b, c, hp, lds, tid); }
        if (BOTH(4)) GRID_BAR();
    }
    if (IN(5)) { PHASE_LOCALS();
        SchedPlain S{G, bx, MTOK / 256, DM / 256, (const bf16*)(ws + WS_WOUT)};
        EpiOutProj E{ARG(0), (bf16*)(ws + WS_H2)};
        REP(5) pg8::gemm_phase<EpiOutProj, SchedPlain, false>(lds, (const bf16*)(ws + WS_Y), DM, S, E);
        if (BOTH(5)) GRID_BAR();
    }
    if (IN(6)) { PHASE_LOCALS();
        const P6Args A{(const bf16*)(ws + WS_H2), ARG(12), ARG(14), (const bf16*)(ws + WS_WR), ws + WS_HG8, (float*)(ws + SM_RSTD), (int*)(ws + SM_AE), (int*)(ws + SM_AR), (float*)(ws + SM_AG), GCNT};
        p6_router(A, lds, lds + CTRL_OFF, vcu, G, tid);
        if (BOTH(6)) GRID_BAR();
    }
    if (IN(7)) { PHASE_LOCALS();
        moe_tstart(GCNT, TSTART, tid);
        const int* ae = (const int*)(ws + SM_AE); const int* ar = (const int*)(ws + SM_AR); const float* ag = (const float*)(ws + SM_AG); const float* rstd2 = (const float*)(ws + SM_RSTD);
        int* slot_tok = (int*)(ws + SM_ST); float* slot_rstd = (float*)(ws + SM_SR); float* slot_gate = (float*)(ws + SM_SG); int* tok_slot = (int*)(ws + SM_TS);
        for (long a = gid; a < NASSIGN; a += NG) { const int e = ae[a], slot = TSTART[e] * 256 + ar[a], t = (int)(a >> 2);
            slot_tok[slot] = t; slot_rstd[slot] = rstd2[t]; slot_gate[slot] = ag[a]; tok_slot[a] = slot; }
        if (BOTH(7)) GRID_BAR();
    }
    if (IN(8)) { PHASE_LOCALS();
        moe_tstart(GCNT, TSTART, tid);
        SchedMoE S{G, bx, DFF / 128, TSTART, ws + WS_WGU, (size_t)2 * DFF * DM, (size_t)256 * DM, (const int*)(ws + SM_ST)};
        EpiGateUp E{ARG(16), (const float*)(ws + SM_SR), ws + WS_ACT, lds + XCH_OFF};
        REP(8) pg8::gemm_phase<EpiGateUp, SchedMoE, true, true>(lds, (const bf16*)(ws + WS_HG8), DM / 2, S, E, (unsigned)(bx * STAGGER_TICKS) / (unsigned)G);
#if (PROBE_DUP >> 15) & 1
        { EpiNull EN; pg8::gemm_phase<EpiNull, SchedMoE, true, true>(lds, (const bf16*)(ws + WS_HG8), DM / 2, S, EN); }
#endif
        if (BOTH(8)) GRID_BAR();
    }
    if (IN(9)) { PHASE_LOCALS();
        moe_tstart(GCNT, TSTART, tid);
        SchedMoE S{G, bx, DM / 256, TSTART, ws + WS_WDN, (size_t)DM * DFF, (size_t)256 * DFF, nullptr};
        EpiDown E{ARG(18), (const float*)(ws + SM_SG), ws + WS_YS, lds + XCH_OFF};
        REP(9) pg8::gemm_phase<EpiDown, SchedMoE, false, true>(lds, (const bf16*)(ws + WS_ACT), DFF / 2, S, E, (unsigned)(bx * STAGGER_TICKS) / (unsigned)G);
#if (PROBE_DUP >> 13) & 1
        { EpiNull EN; pg8::gemm_phase<EpiNull, SchedMoE, false, true>(lds, (const bf16*)(ws + WS_ACT), DFF / 2, S, EN); }
#endif
#if (PROBE_DUP >> 14) & 1
        { EpiStoreOnly<2, 4> ES{(bf16*)(ws + 2171 * MiB)}; pg8::gemm_phase<EpiStoreOnly<2, 4>, SchedMoE, false, true>(lds, (const bf16*)(ws + WS_ACT), DFF / 2, S, ES); }
#endif
#if (PROBE_DUP >> 16) & 1
        { EpiStoreOnly<1, 1> ES{(bf16*)(ws + 2171 * MiB)}; pg8::gemm_phase<EpiStoreOnly<1, 1>, SchedMoE, false, true>(lds, (const bf16*)(ws + WS_ACT), DFF / 2, S, ES); }
#endif
#if (PROBE_DUP >> 17) & 1
        { EpiStoreOnly<1, 4> ES{(bf16*)(ws + 2171 * MiB)}; pg8::gemm_phase<EpiStoreOnly<1, 4>, SchedMoE, false, true>(lds, (const bf16*)(ws + WS_ACT), DFF / 2, S, ES); }
#endif
        if (BOTH(9)) GRID_BAR();
    }
    if (IN(10)) { PHASE_LOCALS();
        const int* tok_slot = (const int*)(ws + SM_TS); const unsigned char* YS = ws + WS_YS;
        float* out = OUTP; const bf16* H2 = (const bf16*)(ws + WS_H2);
        for (int m = gw; m < MTOK; m += NGW) {
            const int s0 = tok_slot[4 * m], s1 = tok_slot[4 * m + 1], s2 = tok_slot[4 * m + 2], s3 = tok_slot[4 * m + 3];
#pragma unroll
            for (int j = 0; j < 4; ++j) { const int col = lane * 8 + 512 * j; float* op = out + (size_t)m * DM + col;
                const v4u hw = *(const v4u*)(H2 + (size_t)m * DM + col); const f32x4 o0 = {bf_lo(hw.x), bf_hi(hw.x), bf_lo(hw.y), bf_hi(hw.y)}, o1 = {bf_lo(hw.z), bf_hi(hw.z), bf_lo(hw.w), bf_hi(hw.w)};
                const v2u y0 = *(const v2u*)(YS + (size_t)s0 * DM + col), y1 = *(const v2u*)(YS + (size_t)s1 * DM + col), y2 = *(const v2u*)(YS + (size_t)s2 * DM + col), y3 = *(const v2u*)(YS + (size_t)s3 * DM + col);
                f32x4 a0 = {0.f, 0.f, 0.f, 0.f}, a1 = {0.f, 0.f, 0.f, 0.f};
#define ADDY(Q_) do { const f32x2_t l0_ = __builtin_amdgcn_cvt_pk_f32_fp8((int)Q_.x, false), h0_ = __builtin_amdgcn_cvt_pk_f32_fp8((int)Q_.x, true), l1_ = __builtin_amdgcn_cvt_pk_f32_fp8((int)Q_.y, false), h1_ = __builtin_amdgcn_cvt_pk_f32_fp8((int)Q_.y, true); \
                    a0[0] += l0_[0]; a0[1] += l0_[1]; a0[2] += h0_[0]; a0[3] += h0_[1]; a1[0] += l1_[0]; a1[1] += l1_[1]; a1[2] += h1_[0]; a1[3] += h1_[1]; } while (0)
                ADDY(y0); ADDY(y1); ADDY(y2); ADDY(y3);
#undef ADDY
                *(f32x4*)op = o0 + a0 * (1.f / YS8_SCALE); *(f32x4*)(op + 4) = o1 + a1 * (1.f / YS8_SCALE); }
        }
    }
#undef IN
#undef BOTH
#undef GRID_BAR
}


#ifdef DBG_DUMP
__global__ void dbg_dump(const unsigned char* ws, float* out, unsigned mask) {
    const size_t offs[16] = {WS_U, WS_WIN, WS_QH, WS_KH, WS_VH, WS_HQ, WS_HK, WS_HGT, WS_HV, WS_OG, WS_GA, WS_GH, WS_OP, WS_DS, WS_Y, WS_WOUT};
    for (size_t i = (size_t)blockIdx.x * blockDim.x + threadIdx.x; i < (size_t)MTOK * DM; i += (size_t)gridDim.x * blockDim.x) {
        float s = 0.f;
        for (int b = 0; b < 16; ++b) if ((mask >> b) & 1u) { size_t j = i; if (b == 15) j = i & (size_t)(DM * DM - 1); if (b == 12 || b == 13) j = i * 2 + ((mask >> 16) & 1u); s += bf2f(((const bf16*)(ws + offs[b]))[j]); }
        out[i] = s;
    }
}
#endif
#ifndef DBG_NLAUNCH
#define DBG_NLAUNCH NPHASE
#endif
extern "C" void kernel_launch(void* const* d_in, const int* in_sizes, int n_in, void* d_out, int out_size, void* d_ws, size_t ws_size, hipStream_t stream) {
    static int grid = 0;
    if (grid == 0) {
        if (n_in != 19 || in_sizes[0] != MTOK * DM || out_size != MTOK * DM || ws_size < WS_END) { fprintf(stderr, "kernel_launch: unexpected shapes (n_in %d, in0 %d, out %d, ws %zu < %zu); nothing launched\n", n_in, n_in > 0 ? in_sizes[0] : -1, out_size, ws_size, (size_t)WS_END); grid = -1; return; }
        int dev = 0, cus = 0, per_cu = 0;
        if (hipGetDevice(&dev) != hipSuccess || hipDeviceGetAttribute(&cus, hipDeviceAttributeMultiprocessorCount, dev) != hipSuccess) { fprintf(stderr, "kernel_launch: device query failed\n"); grid = -1; return; }
        if (hipFuncSetAttribute((const void*)hyb_fwd, hipFuncAttributeMaxDynamicSharedMemorySize, LDS_BYTES) != hipSuccess) { fprintf(stderr, "kernel_launch: hipFuncSetAttribute(%d) failed\n", LDS_BYTES); grid = -1; return; }
        if (hipOccupancyMaxActiveBlocksPerMultiprocessor(&per_cu, (const void*)hyb_fwd, NTHR, LDS_BYTES) != hipSuccess || per_cu < 1) { fprintf(stderr, "kernel_launch: occupancy query says %d workgroups per CU\n", per_cu); (void)hipGetLastError(); if (per_cu < 1) { grid = -1; return; } }
        grid = cus;
    }
    if (grid < 0) return;
    if (hipMemsetAsync((char*)d_ws + WS_CTL, 0, CTL_ZERO_BYTES, stream) != hipSuccess) { fprintf(stderr, "kernel_launch: memset failed\n"); return; }
    Args a{};
    for (int i = 0; i < 19; ++i) a.in[i] = (const float*)d_in[i];
    a.out = (float*)d_out; a.ws = (unsigned char*)d_ws;
    for (int li = 0; li < (N_LAUNCHES == 1 ? 1 : DBG_NLAUNCH); ++li) {
        a.ph_lo = (N_LAUNCHES == 1) ? 0 : li; a.ph_hi = (N_LAUNCHES == 1) ? NPHASE : li + 1; a.li = li; a.pad = 0;
        hipLaunchKernelGGL(hyb_fwd, dim3(grid), dim3(NTHR), LDS_BYTES, stream, a);
        const hipError_t le = hipPeekAtLastError();
        if (le != hipSuccess) { fprintf(stderr, "kernel_launch: launch %d failed: %s\n", li, hipGetErrorName(le)); break; }
    }
#ifdef DBG_DUMP
    hipLaunchKernelGGL(dbg_dump, dim3(2048), dim3(256), 0, stream, (const unsigned char*)d_ws, (float*)d_out, (unsigned)DBG_DUMP);
#endif
}
```
